# Optimizing an MI355X kernel written in HIP

```python
import math
import jax
import jax.numpy as jnp
from jax import lax
import numpy as np

D_MODEL = 2048
BATCH = 8
SEQ = 2048
DEPTH = 4

A_HEADS = 4
A_NOPE = 128
A_ROPE = 64
A_V = 128
A_KV_RANK = 256
IDX_HEADS = 8
IDX_DIM = 64
INDEX_TOPK = 256
B_HEADS = 4
B_QK = 64
B_V = 128
RET_CHUNK = 128
C_HEADS = 4
C_DH = 64
D_HEADS = 4
D_K = 128
D_V = 128
CONV_K = 4
GDN_CHUNK = 64
N_EXPERTS = 32
TOP_K = 4
D_FF = 512
SWIGLU_ALPHA = 1.702
SWIGLU_LIMIT = 7.0
MOE_BLOCK = 256

ROPE_THETA = 10000.0
Q_BLOCK = 128
MAX_POS_OFFSET = 4096
DEEPNORM_ALPHA = (2 * DEPTH) ** 0.25
DEEPNORM_BETA = (8 * DEPTH) ** -0.25
LN_EPS = 1e-5
RMS_EPS = 1e-6

D_MIX = A_HEADS * A_V + B_HEADS * B_V + C_HEADS * 2 * C_DH + D_HEADS * D_V
IN_WIDTHS = (
    A_HEADS * (A_NOPE + A_ROPE), A_KV_RANK, A_ROPE, IDX_HEADS * IDX_DIM, IDX_DIM, IDX_HEADS,
    B_HEADS * B_QK, B_HEADS * B_QK, B_HEADS * B_V, B_HEADS * B_V,
    C_HEADS * 2 * C_DH, C_HEADS * 2 * C_DH, C_HEADS * 2 * C_DH,
    D_HEADS * (2 * D_K + D_V), D_HEADS * D_V, D_HEADS, D_HEADS,
)
IN_TOTAL = sum(IN_WIDTHS)

kernel_name = 'hybrid_dsa_ret_diff_gdn_moe_deepnorm'


def layer_norm(t, g, b):
    tf = t.astype(jnp.float32)
    mu = jnp.mean(tf, -1, keepdims=True)
    var = jnp.mean(jnp.square(tf - mu), -1, keepdims=True)
    return ((tf - mu) * lax.rsqrt(var + LN_EPS) * g + b).astype(t.dtype)


def rms_normalize(t):
    tf = t.astype(jnp.float32)
    return tf * lax.rsqrt(jnp.mean(tf * tf, -1, keepdims=True) + RMS_EPS)


def rms_norm(t, g):
    return (rms_normalize(t) * g).astype(t.dtype)


def l2_normalize(t):
    tf = t.astype(jnp.float32)
    return tf * lax.rsqrt(jnp.sum(tf * tf, -1, keepdims=True) + RMS_EPS)


def rotary(t, positions):
    half = t.shape[-1] // 2
    inv_freq = ROPE_THETA ** (-jnp.arange(half, dtype=jnp.float32) / half)
    ang = positions.astype(jnp.float32)[:, :, None, None] * inv_freq
    cos, sin = jnp.cos(ang), jnp.sin(ang)
    tf = t.astype(jnp.float32)
    t1, t2 = tf[..., :half], tf[..., half:]
    return jnp.concatenate([t1 * cos - t2 * sin, t2 * cos + t1 * sin], -1).astype(t.dtype)


def to_chunks(t, c):
    return jnp.moveaxis(t.reshape((t.shape[0], t.shape[1] // c, c) + t.shape[2:]), 2, 3)


def from_chunks(t):
    t = jnp.moveaxis(t, 3, 2)
    return t.reshape((t.shape[0], t.shape[1] * t.shape[2]) + t.shape[3:])


def to_qblocks(t):
    return jnp.moveaxis(t.reshape((t.shape[0], t.shape[1] // Q_BLOCK, Q_BLOCK) + t.shape[2:]), 1, 0)


def from_qblocks(t):
    t = jnp.moveaxis(t, 0, 1)
    return t.reshape((t.shape[0], t.shape[1] * t.shape[2]) + t.shape[3:])


def dsa_mla_mixer(a_q, a_ckv, a_kr, a_iq, a_ik, a_iw, positions, kv_norm, w_uk, w_uv):
    bsz, seq = a_q.shape[:2]
    q = a_q.reshape(bsz, seq, A_HEADS, A_NOPE + A_ROPE)
    q_rope = rotary(q[..., A_NOPE:], positions)
    q_lat = jnp.einsum('bshd,rhd->bshr', q[..., :A_NOPE], w_uk)
    q_all = jnp.concatenate([q_lat, q_rope], -1)
    c_kv = rms_norm(a_ckv, kv_norm)
    k_rope = rotary(a_kr[:, :, None, :], positions)[:, :, 0]
    kv_lat = jnp.concatenate([c_kv, k_rope], -1)
    iq = rotary(a_iq.reshape(bsz, seq, IDX_HEADS, IDX_DIM), positions)
    ik = rotary(a_ik[:, :, None, :], positions)[:, :, 0]
    iw = a_iw * (IDX_HEADS * IDX_DIM) ** -0.5
    n_keep = min(INDEX_TOPK, seq // 4)
    key_pos = jnp.arange(seq)
    scale = (A_NOPE + A_ROPE) ** -0.5

    def block(args):
        qb, iqb, iwb, qpos = args
        idx_logits = jnp.einsum('bqhd,bsd->bqhs', iqb, ik)
        index = jnp.einsum('bqhs,bqh->bqs', jax.nn.relu(idx_logits), iwb).astype(jnp.float32)
        index = jnp.where(key_pos[None, None, :] <= qpos[None, :, None], index, -jnp.inf)
        _, sel = lax.top_k(index, n_keep)
        valid = sel <= qpos[None, :, None]
        kv_sel = jax.vmap(lambda kv, ix: kv[ix])(kv_lat, sel)
        logits = jnp.einsum('bqhr,bqkr->bqhk', qb, kv_sel).astype(jnp.float32) * scale
        logits = jnp.where(valid[:, :, None, :], logits, -jnp.inf)
        p = jax.nn.softmax(logits, axis=-1).astype(kv_sel.dtype)
        return jnp.einsum('bqhk,bqkr->bqhr', p, kv_sel[..., :A_KV_RANK])

    qpos_blocks = jnp.arange(seq).reshape(seq // Q_BLOCK, Q_BLOCK)
    o_lat = from_qblocks(lax.map(block, (to_qblocks(q_all), to_qblocks(iq), to_qblocks(iw), qpos_blocks)))
    o = jnp.einsum('bshr,rhd->bshd', o_lat, w_uv)
    return o.reshape(bsz, seq, A_HEADS * A_V)


def retention_mixer(b_q, b_k, b_v, b_g, positions):
    bsz, seq = b_q.shape[:2]
    f32 = jnp.float32
    q = rotary(b_q.reshape(bsz, seq, B_HEADS, B_QK), positions).astype(f32)
    k = rotary(b_k.reshape(bsz, seq, B_HEADS, B_QK), positions).astype(f32) * B_QK ** -0.5
    v = b_v.reshape(bsz, seq, B_HEADS, B_V).astype(f32)
    log_gamma = jnp.log(1.0 - 2.0 ** (-5.0 - jnp.arange(B_HEADS, dtype=f32)))
    c = RET_CHUNK
    qc, kc, vc = to_chunks(q, c), to_chunks(k, c), to_chunks(v, c)
    i = jnp.arange(c, dtype=f32)
    rel = i[:, None] - i[None, :]
    intra_decay = jnp.where(rel >= 0, jnp.exp(log_gamma[:, None, None] * jnp.maximum(rel, 0.0)), 0.0)
    scores = jnp.einsum('bnhid,bnhjd->bnhij', qc, kc) * intra_decay
    o_intra = jnp.einsum('bnhij,bnhje->bnhie', scores, vc)
    k_to_end = kc * jnp.exp(log_gamma[:, None] * (c - 1 - i))[:, :, None]
    chunk_kv = jnp.einsum('bnhcd,bnhce->bnhde', k_to_end, vc)
    chunk_decay = jnp.exp(log_gamma * c)[None, :, None, None]

    def step(state, kv_n):
        return state * chunk_decay + kv_n, state

    _, prev = lax.scan(step, jnp.zeros((bsz, B_HEADS, B_QK, B_V), f32), jnp.moveaxis(chunk_kv, 1, 0))
    prev = jnp.moveaxis(prev, 0, 1)
    q_from_start = qc * jnp.exp(log_gamma[:, None] * (i + 1.0))[:, :, None]
    o = o_intra + jnp.einsum('bnhid,bnhde->bnhie', q_from_start, prev)
    o = rms_normalize(from_chunks(o))
    gate = jax.nn.silu(b_g.astype(f32)).reshape(bsz, seq, B_HEADS, B_V)
    return (o * gate).reshape(bsz, seq, B_HEADS * B_V).astype(b_q.dtype)


def diff_attention_mixer(c_q, c_k, c_v, positions, lam, subln_g, lambda_init):
    bsz, seq = c_q.shape[:2]
    q = rotary(c_q.reshape(bsz, seq, C_HEADS * 2, C_DH), positions).reshape(bsz, seq, C_HEADS, 2, C_DH)
    k = rotary(c_k.reshape(bsz, seq, C_HEADS * 2, C_DH), positions).reshape(bsz, seq, C_HEADS, 2, C_DH)
    v = c_v.reshape(bsz, seq, C_HEADS, 2 * C_DH)
    lf = lam.astype(jnp.float32)
    lam_full = jnp.exp(jnp.sum(lf[0] * lf[1])) - jnp.exp(jnp.sum(lf[2] * lf[3])) + lambda_init
    key_pos = jnp.arange(seq)
    scale = C_DH ** -0.5

    def block(args):
        qb, qpos = args
        logits = jnp.einsum('bqhmd,bshmd->bhmqs', qb, k).astype(jnp.float32) * scale
        logits = jnp.where(key_pos[None, :] <= qpos[:, None], logits, -jnp.inf)
        p = jax.nn.softmax(logits, axis=-1)
        diff = (p[:, :, 0] - lam_full * p[:, :, 1]).astype(v.dtype)
        return jnp.einsum('bhqs,bshe->bqhe', diff, v)

    qpos_blocks = jnp.arange(seq).reshape(seq // Q_BLOCK, Q_BLOCK)
    o = from_qblocks(lax.map(block, (to_qblocks(q), qpos_blocks)))
    o = rms_norm(o, subln_g) * (1.0 - lambda_init)
    return o.reshape(bsz, seq, C_HEADS * 2 * C_DH)


def causal_depthwise_conv(t, w):
    return lax.conv_general_dilated(t, w[:, None, :], window_strides=(1,), padding=((CONV_K - 1, 0),),
                                    dimension_numbers=('NWC', 'WIO', 'NWC'), feature_group_count=t.shape[-1])


def chunk_gated_delta_rule(q, k, v, g, beta):
    f32 = jnp.float32
    bsz = q.shape[0]
    c = GDN_CHUNK
    qc, kc, vc = (to_chunks(t.astype(f32), c) for t in (q, k, v))
    gc, bc = to_chunks(g.astype(f32), c), to_chunks(beta.astype(f32), c)
    G = jnp.cumsum(gc, axis=-1)
    idx = jnp.arange(c)
    tril = idx[:, None] >= idx[None, :]
    strict = idx[:, None] > idx[None, :]
    diffG = G[..., :, None] - G[..., None, :]
    gam = jnp.where(tril, jnp.exp(jnp.where(tril, diffG, 0.0)), 0.0)
    kb = kc * bc[..., None]
    lower = jnp.where(strict, jnp.einsum('bnhid,bnhjd->bnhij', kb, kc) * gam, 0.0)
    rhs = jnp.concatenate([vc * bc[..., None], kb * jnp.exp(G)[..., None]], -1)
    sol = lax.linalg.triangular_solve(lower + jnp.eye(c, dtype=f32), rhs, left_side=True, lower=True,
                                      unit_diagonal=True)
    u, w = sol[..., :D_V], sol[..., D_V:]
    attn = jnp.where(tril, jnp.einsum('bnhid,bnhjd->bnhij', qc, kc) * gam, 0.0)
    qg = qc * jnp.exp(G)[..., None]
    kd = kc * jnp.exp(G[..., -1:] - G)[..., None]
    decay_last = jnp.exp(G[..., -1])

    def step(state, xs):
        qg_n, w_n, u_n, a_n, kd_n, dl_n = xs
        v_new = u_n - jnp.einsum('bhcd,bhde->bhce', w_n, state)
        o_n = jnp.einsum('bhcd,bhde->bhce', qg_n, state) + jnp.einsum('bhij,bhje->bhie', a_n, v_new)
        state = state * dl_n[..., None, None] + jnp.einsum('bhcd,bhce->bhde', kd_n, v_new)
        return state, o_n

    xs = tuple(jnp.moveaxis(t, 1, 0) for t in (qg, w, u, attn, kd, decay_last))
    _, o = lax.scan(step, jnp.zeros((bsz, D_HEADS, D_K, D_V), f32), xs)
    return from_chunks(jnp.moveaxis(o, 0, 1))


def gated_deltanet_mixer(d_qkv, d_z, d_b, d_a, conv_w, a_log, dt_bias, norm_g):
    bsz, seq = d_qkv.shape[:2]
    qkv = jax.nn.silu(causal_depthwise_conv(d_qkv, conv_w))
    q, k, v = jnp.split(qkv, [D_HEADS * D_K, 2 * D_HEADS * D_K], axis=-1)
    q = l2_normalize(q.reshape(bsz, seq, D_HEADS, D_K)) * D_K ** -0.5
    k = l2_normalize(k.reshape(bsz, seq, D_HEADS, D_K))
    v = v.reshape(bsz, seq, D_HEADS, D_V)
    beta = jax.nn.sigmoid(d_b.astype(jnp.float32))
    g = -jnp.exp(a_log.astype(jnp.float32)) * jax.nn.softplus(d_a.astype(jnp.float32) + dt_bias.astype(jnp.float32))
    o = chunk_gated_delta_rule(q, k, v, g, beta)
    o = rms_norm(o, norm_g) * jax.nn.silu(d_z.reshape(bsz, seq, D_HEADS, D_V).astype(jnp.float32))
    return o.reshape(bsz, seq, D_HEADS * D_V).astype(d_qkv.dtype)


def clamped_swiglu(hg):
    glu, lin = hg[..., :D_FF], hg[..., D_FF:]
    glu = jnp.minimum(glu, SWIGLU_LIMIT)
    lin = jnp.clip(lin, -SWIGLU_LIMIT, SWIGLU_LIMIT)
    return glu * jax.nn.sigmoid(SWIGLU_ALPHA * glu) * (lin + 1.0)


def moe_ffn(h, w_router, b_router, w_gu, b_gu, w_dn, b_dn):
    bsz, seq, d = h.shape
    n_tok = bsz * seq
    hf = h.reshape(n_tok, d)
    logits = hf @ w_router + b_router
    top_logits, top_e = lax.top_k(logits, TOP_K)
    gates = jax.nn.softmax(top_logits.astype(jnp.float32), axis=-1).astype(h.dtype)
    n_assign = n_tok * TOP_K
    e_flat = top_e.reshape(n_assign)
    order = jnp.argsort(e_flat)
    e_sorted = e_flat[order]
    tok_sorted = (order // TOP_K).astype(jnp.int32)
    gate_sorted = gates.reshape(n_assign)[order]
    counts = jnp.bincount(e_flat, length=N_EXPERTS)
    padded = (counts + MOE_BLOCK - 1) // MOE_BLOCK * MOE_BLOCK
    pad_end = jnp.cumsum(padded)
    pad_start = pad_end - padded
    start = jnp.cumsum(counts) - counts
    row = pad_start[e_sorted] + jnp.arange(n_assign) - start[e_sorted]
    n_blocks = -(-n_assign // MOE_BLOCK) + N_EXPERTS
    n_rows = n_blocks * MOE_BLOCK
    row_tok = jnp.zeros((n_rows,), jnp.int32).at[row].set(tok_sorted)
    row_gate = jnp.zeros((n_rows,), h.dtype).at[row].set(gate_sorted)
    block_e = jnp.minimum(jnp.searchsorted(pad_end, jnp.arange(n_blocks) * MOE_BLOCK, side='right'), N_EXPERTS - 1)

    def expert_block(args):
        tok, gate, e = args
        act = clamped_swiglu(hf[tok] @ w_gu[e] + b_gu[e])
        return (act @ w_dn[e] + b_dn[e]) * gate[:, None]

    y_rows = lax.map(expert_block, (row_tok.reshape(n_blocks, MOE_BLOCK), row_gate.reshape(n_blocks, MOE_BLOCK), block_e))
    y = jnp.zeros_like(hf).at[row_tok].add(y_rows.reshape(n_rows, d))
    return y.reshape(bsz, seq, d)


def setup_inputs(seed: int = 0) -> dict:
    key = jax.random.key(seed)
    ks = jax.random.split(key, 24)
    f32 = jnp.float32
    L, D = DEPTH, D_MODEL

    def nrm(k, shape, scale):
        return jax.random.normal(k, shape, f32) * scale

    x = nrm(ks[0], (BATCH, SEQ, D), 1.0)
    offsets = jax.random.randint(ks[1], (BATCH, 1), 0, MAX_POS_OFFSET, dtype=jnp.int32)
    positions = (offsets + jnp.arange(SEQ, dtype=jnp.int32)[None, :]).astype(jnp.int32)
    dt = jnp.exp(jax.random.uniform(ks[11], (L, D_HEADS), f32, math.log(1e-3), math.log(1e-1)))
    return {
        'x': x,
        'positions': positions,
        'w_in': nrm(ks[2], (L, D, IN_TOTAL), D ** -0.5),
        'w_out': nrm(ks[3], (L, D_MIX, D), D_MIX ** -0.5 * DEEPNORM_BETA),
        'a_kv_norm': 1.0 + nrm(ks[4], (L, A_KV_RANK), 0.02),
        'a_w_uk': nrm(ks[5], (L, A_KV_RANK, A_HEADS, A_NOPE), A_KV_RANK ** -0.5),
        'a_w_uv': nrm(ks[6], (L, A_KV_RANK, A_HEADS, A_V), A_KV_RANK ** -0.5),
        'c_lambda': nrm(ks[7], (L, 4, C_DH), 0.1),
        'c_subln': 1.0 + nrm(ks[8], (L, 2 * C_DH), 0.02),
        'd_conv': nrm(ks[9], (L, CONV_K, D_HEADS * (2 * D_K + D_V)), CONV_K ** -0.5),
        'd_a_log': jnp.log(jax.random.uniform(ks[10], (L, D_HEADS), f32, 1.0, 16.0)),
        'd_dt_bias': dt + jnp.log(-jnp.expm1(-dt)),
        'd_norm': 1.0 + nrm(ks[12], (L, D_V), 0.02),
        'ln1_g': 1.0 + nrm(ks[13], (L, D), 0.02),
        'ln1_b': nrm(ks[14], (L, D), 0.02),
        'w_router': nrm(ks[15], (L, D, N_EXPERTS), D ** -0.5),
        'b_router': nrm(ks[16], (L, N_EXPERTS), 0.01),
        'w_gu': nrm(ks[17], (L, N_EXPERTS, D, 2 * D_FF), D ** -0.5),
        'b_gu': nrm(ks[18], (L, N_EXPERTS, 2 * D_FF), 0.01),
        'w_dn': nrm(ks[19], (L, N_EXPERTS, D_FF, D), D_FF ** -0.5 * DEEPNORM_BETA),
        'b_dn': nrm(ks[20], (L, N_EXPERTS, D), 0.01),
        'ln2_g': 1.0 + nrm(ks[21], (L, D), 0.02),
        'ln2_b': nrm(ks[22], (L, D), 0.02),
    }


def reference(x, positions, w_in, w_out, a_kv_norm, a_w_uk, a_w_uv, c_lambda, c_subln, d_conv, d_a_log,
              d_dt_bias, d_norm, ln1_g, ln1_b, w_router, b_router, w_gu, b_gu, w_dn, b_dn, ln2_g, ln2_b):
    splits = np.cumsum(IN_WIDTHS)[:-1].tolist()
    for l in range(DEPTH):
        (a_q, a_ckv, a_kr, a_iq, a_ik, a_iw, b_q, b_k, b_v, b_g, c_q, c_k, c_v,
         d_qkv, d_z, d_b, d_a) = jnp.split(x @ w_in[l], splits, axis=-1)
        lambda_init = 0.8 - 0.6 * math.exp(-0.3 * l)
        heads = jnp.concatenate([
            dsa_mla_mixer(a_q, a_ckv, a_kr, a_iq, a_ik, a_iw, positions, a_kv_norm[l], a_w_uk[l], a_w_uv[l]),
            retention_mixer(b_q, b_k, b_v, b_g, positions),
            diff_attention_mixer(c_q, c_k, c_v, positions, c_lambda[l], c_subln[l], lambda_init),
            gated_deltanet_mixer(d_qkv, d_z, d_b, d_a, d_conv[l], d_a_log[l], d_dt_bias[l], d_norm[l]),
        ], axis=-1)
        h = layer_norm(DEEPNORM_ALPHA * x + heads @ w_out[l], ln1_g[l], ln1_b[l])
        y = moe_ffn(h, w_router[l], b_router[l], w_gu[l], b_gu[l], w_dn[l], b_dn[l])
        x = layer_norm(DEEPNORM_ALPHA * h + y, ln2_g[l], ln2_b[l])
    return x
```

```cpp
#include <hip/hip_runtime.h>
#include <cstdio>
#include <cstdint>

#ifndef ONE_LAUNCH
#define ONE_LAUNCH 1
#endif
#ifndef PHASE_MASK
#define PHASE_MASK 0xfffff
#endif
#define NO_MOE 0
#define PHON(k) ((PHASE_MASK >> (k)) & 1)
#ifndef HALF_MMA
#define HALF_MMA 1
#endif
#ifndef HALF_EPI
#define HALF_EPI 1
#endif
#ifndef REP_MASK
#define REP_MASK 0
#endif
#define REP2(k) ((REP_MASK >> (k)) & 1)

#define LAS __attribute__((address_space(3)))
#define GAS __attribute__((address_space(1)))
typedef unsigned short bf16;
typedef short bf16x8 __attribute__((ext_vector_type(8)));
typedef float f32x4 __attribute__((ext_vector_type(4)));
typedef float f32x2 __attribute__((ext_vector_type(2)));
typedef unsigned u32x4 __attribute__((ext_vector_type(4)));
typedef unsigned u32x2 __attribute__((ext_vector_type(2)));

constexpr int DM = 2048, NBATCH = 8, SEQ = 2048, NTOK = NBATCH * SEQ, DEPTH = 4;
constexpr int INTOT = 6800, NP = 6912;
constexpr int NE = 32, TOPK = 4, DFF = 512;
constexpr int NWAVES = 8, NTHR = 512;
constexpr float LN_EPS = 1e-5f, RMS_EPS = 1e-6f;
constexpr float DN_ALPHA = 1.681792830507429f;
constexpr float LOG2E = 1.4426950408889634f;
constexpr int MAXROWS = NTOK * TOPK + NE * 256;

constexpr int PC_AQN = 0, PC_AQR = 512, PC_CKV = 768, PC_AKR = 1024, PC_AIK = 1088, PC_AIQ = 1152, PC_AIW = 1664;
constexpr int PC_BQ = 1728, PC_BK = 1984, PC_BV = 2240, PC_BG = 2752;
constexpr int PC_CQ = 3264, PC_CK = 3776, PC_CV = 4288;
constexpr int PC_DQKV = 4800, PC_DZ = 6336, PC_DBA = 6848;
constexpr int SC_AQ = 0, SC_CKV = 768, SC_AKR = 1024, SC_AIQ = 1088, SC_AIK = 1600, SC_AIW = 1664, SC_BQ = 1672, SC_BK = 1928, SC_BV = 2184, SC_BG = 2696;
constexpr int SC_CQ = 3208, SC_CK = 3720, SC_CV = 4232, SC_DQKV = 4744, SC_DZ = 6280, SC_DB = 6792;

constexpr size_t MiB = 1u << 20;
constexpr size_t WS_CTL = 0, CTL_ZERO_BYTES = 1 * MiB;
constexpr size_t WS_CS = 1 * MiB;
constexpr size_t WS_WIN = 8 * MiB;
constexpr size_t WS_WKV = WS_WIN + 108 * MiB;
constexpr size_t WS_WOUT = WS_WKV + 2 * MiB;
constexpr size_t WS_WGU = WS_WOUT + 32 * MiB;
constexpr size_t WS_WDN = WS_WGU + 512 * MiB;
constexpr size_t WS_X = WS_WDN + 256 * MiB;
constexpr size_t WS_XB = WS_X + 128 * MiB;
constexpr size_t WS_P = WS_XB + 64 * MiB;
constexpr size_t WS_SIDE = WS_P + 216 * MiB;
constexpr size_t WS_GB = WS_SIDE, WS_IW = WS_SIDE + 512 * 1024, WS_SSQ = WS_SIDE + 1024 * 1024;
constexpr size_t WS_KN = WS_SIDE + 2 * MiB;
constexpr size_t WS_VAT = WS_KN + 16 * MiB;
constexpr size_t WS_HEADS = WS_VAT + 16 * MiB;
constexpr size_t WS_R = WS_HEADS + 64 * MiB;
constexpr size_t WS_H = WS_R + 128 * MiB;
constexpr size_t WS_HB = WS_H + 128 * MiB;
constexpr size_t WS_ACT = WS_HB + 64 * MiB;
constexpr size_t WS_Y = WS_ACT + 72 * MiB;
constexpr size_t WS_LTOK = WS_Y + 288 * MiB;
constexpr size_t WS_LGATE = WS_LTOK + 2 * MiB;
constexpr size_t WS_TSLOT = WS_LGATE + 2 * MiB;
constexpr size_t WS_MIX = WS_TSLOT + 1 * MiB;
constexpr size_t WS_BKV = WS_MIX;
constexpr size_t WS_CVT = WS_BKV + 16 * MiB;
constexpr size_t WS_MASK = WS_CVT + 16 * MiB;
constexpr size_t WS_DPRE = WS_MASK + 4 * MiB;
constexpr size_t WS_DW = WS_DPRE;
constexpr size_t WS_DQG = WS_DW + 16 * MiB;
constexpr size_t WS_DKDT = WS_DQG + 16 * MiB;
constexpr size_t WS_DATT = WS_DKDT + 16 * MiB;
constexpr size_t WS_DUT = WS_DATT + 8 * MiB;
constexpr size_t WS_DDL = WS_DUT + 32 * MiB;
constexpr size_t WS_END = WS_MIX + 512 * MiB;

constexpr int CW_BAR = 4096;
constexpr int CW_ECNT = 16384;
constexpr int CW_QUEUE = 20480;

constexpr int RING_BYTES = 131072;
constexpr int MISC_OFF = 135168;
constexpr int LDS_BYTES = 147456;

#define RLX_AGENT __ATOMIC_RELAXED, __HIP_MEMORY_SCOPE_AGENT
__device__ __forceinline__ unsigned f2bf(float f) { unsigned u = __builtin_bit_cast(unsigned, f); return (u + 0x7fffu + ((u >> 16) & 1u)) >> 16; }
typedef __bf16 bf16x2_t __attribute__((ext_vector_type(2)));
__device__ __forceinline__ unsigned pk2(float lo, float hi) { const f32x2 v = {lo, hi}; const bf16x2_t b = __builtin_convertvector(v, bf16x2_t); return __builtin_bit_cast(unsigned, b); }
__device__ __forceinline__ float bf2f(unsigned short h) { return __builtin_bit_cast(float, (unsigned)h << 16); }
__device__ __forceinline__ float bflo(unsigned w) { return __builtin_bit_cast(float, w << 16); }
__device__ __forceinline__ float bfhi(unsigned w) { return __builtin_bit_cast(float, w & 0xffff0000u); }
#define DPP_ADDF(v, ctrl, rmask) v += __builtin_bit_cast(float, __builtin_amdgcn_update_dpp(0, __builtin_bit_cast(int, v), ctrl, rmask, 0xf, false))
__device__ __forceinline__ float wave_sum(float v) {
    DPP_ADDF(v, 0x111, 0xf); DPP_ADDF(v, 0x112, 0xf); DPP_ADDF(v, 0x114, 0xf); DPP_ADDF(v, 0x118, 0xf);
    DPP_ADDF(v, 0x142, 0xa); DPP_ADDF(v, 0x143, 0xc);
    return __builtin_bit_cast(float, __builtin_amdgcn_readlane(__builtin_bit_cast(int, v), 63));
}
__device__ __forceinline__ void swap16(float& a, float& b) { asm volatile("s_nop 1\n\tv_permlane16_swap_b32 %0, %1\n\ts_nop 1" : "+v"(a), "+v"(b)); }
__device__ __forceinline__ void swap32(float& a, float& b) { asm volatile("s_nop 1\n\tv_permlane32_swap_b32 %0, %1\n\ts_nop 1" : "+v"(a), "+v"(b)); }
__device__ __forceinline__ float sum_x16_x32(float x) {
    float a = x, b = x; swap16(a, b); x = a + b;
    a = x; b = x; swap32(a, b); return a + b;
}
__device__ __forceinline__ float fast_exp2(float x) { return __builtin_amdgcn_exp2f(x); }
__device__ __forceinline__ float sigmoidf_(float x) { return 1.0f / (1.0f + __expf(-x)); }

#define XB_TMO      128
#define XB_XCNT(j)  (256  + 64 * (j))
#define XB_XSUB(j)  (1280 + 64 * (j))
#define XB_XGEN(j)  (2304 + 64 * (j))
#define XB_TOP      3328
#define XB_TOPGEN   3392
#define XCD_BAR_WORDS 3456
#define XB_SPIN_CAP (1u << 22)
__device__ __forceinline__ unsigned xb_ld(unsigned* p)              { return __hip_atomic_load(p, __ATOMIC_RELAXED, __HIP_MEMORY_SCOPE_AGENT); }
__device__ __forceinline__ unsigned xb_add(unsigned* p, unsigned v) { return __hip_atomic_fetch_add(p, v, __ATOMIC_RELAXED, __HIP_MEMORY_SCOPE_AGENT); }
__device__ __forceinline__ unsigned xb_xcc_id() { return (unsigned)__builtin_amdgcn_s_getreg((3 << 11) | 20) & 0xFu; }
#define XB_SPIN(cond, bar) do { unsigned _sp = 0; while (cond) { __builtin_amdgcn_s_sleep(1); \
    if ((++_sp & 255u) == 0u) { if (xb_ld(&(bar)[XB_TMO])) break; if (_sp > XB_SPIN_CAP) { atomicAdd(&(bar)[XB_TMO], 1u); break; } } } } while (0)
__device__ __forceinline__ int lane_now() { int l; asm volatile("v_mbcnt_lo_u32_b32 %0, -1, 0\n\tv_mbcnt_hi_u32_b32 %0, -1, %0" : "=v"(l)); return l; }
struct XcdBarrier { unsigned* bar; unsigned x; volatile LAS unsigned* st; int wv; };
__device__ __forceinline__ XcdBarrier xcd_barrier_post(unsigned* bar, volatile LAS unsigned* st) {
    XcdBarrier b; b.bar = bar; b.x = xb_xcc_id(); b.st = st; b.wv = __builtin_amdgcn_readfirstlane((int)threadIdx.x >> 6);
    if (threadIdx.x == 0) (void)xb_add(&bar[XB_XCNT(b.x)], 1u);
    return b;
}
__device__ __forceinline__ void xcd_barrier_complete(unsigned* bar, unsigned x, unsigned& nloc, unsigned& nx) {
    const unsigned G = gridDim.x * gridDim.y * gridDim.z;
    unsigned sum, cnt, mine, sp = 0u;
    for (;;) {
        sum = 0u; cnt = 0u; mine = 0u;
#pragma unroll
        for (unsigned j = 0; j < 16; ++j) { const unsigned c = xb_ld(&bar[XB_XCNT(j)]); sum += c; cnt += (c > 0u) ? 1u : 0u; mine = (j == x) ? c : mine; }
        if (sum == G) break;
        __builtin_amdgcn_s_sleep(1);
        if ((++sp & 255u) == 0u) { if (xb_ld(&bar[XB_TMO])) break; if (sp > XB_SPIN_CAP) { atomicAdd(&bar[XB_TMO], 1u); break; } }
    }
    nloc = mine > 0u ? mine : 1u; nx = cnt > 0u ? cnt : 1u;
}
__device__ __forceinline__ void xcd_barrier(const XcdBarrier& b) {
    asm volatile("s_waitcnt vmcnt(0)" ::: "memory");
    __syncthreads();
    if (b.wv == 0 && lane_now() == 0) {
        unsigned* bar = b.bar;
        __builtin_amdgcn_s_waitcnt(0);
        unsigned nloc = b.st[0], nx = b.st[1];
        if (nloc == 0u) { xcd_barrier_complete(bar, b.x, nloc, nx); b.st[0] = nloc; b.st[1] = nx; }
        const unsigned old = xb_add(&bar[XB_XSUB(b.x)], 1u);
        const unsigned gen = old / nloc;
        if (old + 1u == (gen + 1u) * nloc) {
            __builtin_amdgcn_fence(__ATOMIC_RELEASE, "agent");
            asm volatile("s_waitcnt vmcnt(0)" ::: "memory");
            const unsigned og = xb_add(&bar[XB_TOP], 1u);
            const unsigned tg = og / nx;
            if (og + 1u == (tg + 1u) * nx) xb_add(&bar[XB_TOPGEN], 1u);
            else XB_SPIN(xb_ld(&bar[XB_TOPGEN]) == tg, bar);
            __builtin_amdgcn_fence(__ATOMIC_ACQUIRE, "agent");
            xb_add(&bar[XB_XGEN(b.x)], 1u);
            asm volatile("s_waitcnt vmcnt(0)" ::: "memory");
        } else {
            XB_SPIN(xb_ld(&bar[XB_XGEN(b.x)]) == gen, bar);
            __builtin_amdgcn_fence(__ATOMIC_ACQUIRE, "agent");
            asm volatile("s_waitcnt vmcnt(0)" ::: "memory");
        }
    }
    __syncthreads();
}

namespace pg8 {
constexpr int BM = 256, BK = 64, HALF = 128, HTB = HALF * BK * 2, STAGE_BYTES = 8 * HTB;
__host__ __device__ __forceinline__ int lds_byte(int r, int c) { const int st = (r >> 4) * 2 + (c >> 5), rr = r & 15, cc = c & 31, ob = rr * 64 + cc * 2; return st * 1024 + (ob ^ (((ob >> 9) & 1) << 5)); }
__host__ __device__ __forceinline__ void stage_rc(int b, int& R, int& C) { const int st = b / 1024, sb = b % 1024, swz = sb ^ (((sb >> 9) & 1) << 5); R = (st >> 1) * 16 + swz / 64; C = (st & 1) * 32 + (swz % 64) / 2; }
__host__ __device__ __forceinline__ int perm32(int rho) { const int n = rho >> 4, i = rho & 15; return 8 * (i >> 2) + 4 * n + (i & 3); }

struct Unit { int pm, pn, e, hf; };
struct Gemm { const bf16* A; const bf16* Bt; int lda; int K; size_t b_estride; };

template <bool GATHER, class Epi, class Sched>
__device__ __forceinline__ void gemm_phase(LAS unsigned char* lds, const Gemm g, const Sched& S, const Epi& E, int wv) {
    int tid_ = wv * 64 + lane_now(); asm volatile("" : "+v"(tid_));
    const int tid = tid_, wid = __builtin_amdgcn_readfirstlane(tid >> 6), lane = tid & 63, wr = wid >> 2, wc = wid & 3, fr = lane & 15, fq = lane >> 4;
    const int K = g.K, nt = K / BK;
    int Rst[2], Cst[2]; unsigned voffB[2], voffA[2];
#pragma unroll
    for (int i = 0; i < 2; ++i) { int R, C; stage_rc(tid * 16 + i * 8192, R, C); Rst[i] = R; Cst[i] = C; const int Rb = Epi::PERM ? ((R & ~31) + perm32(R & 31)) : R; voffB[i] = (unsigned)(Rb * K + C) * 2u; voffA[i] = (unsigned)(R * g.lda + C) * 2u; }
    const size_t kstep = (size_t)(BK * 2);
    const size_t hstepB = (size_t)HALF * K * 2, hstepA = (size_t)HALF * g.lda * 2;
    const unsigned ldsw = (unsigned)wid * 1024u;
    const int aoff = lds_byte(wr * 64 + fr, fq * 8), boff = lds_byte(wc * 32 + fr, fq * 8);
#define PG8_SA(b, h) (((b) * 2 + (h)) * HTB)
#define PG8_SB(b, h) ((4 + (b) * 2 + (h)) * HTB)
#define PG8_STAGE(bufoff, gbase, v0, v1) do { \
        __builtin_amdgcn_global_load_lds((const unsigned*)((const char*)(gbase) + (v0)), (LAS unsigned*)(lds + (bufoff) + ldsw), 16, 0, 0); \
        __builtin_amdgcn_global_load_lds((const unsigned*)((const char*)(gbase) + (v1)), (LAS unsigned*)(lds + (bufoff) + ldsw + 8192), 16, 0, 0); } while (0)
#define PG8_STB(bufoff, gbase) PG8_STAGE(bufoff, gbase, voffB[0], voffB[1])
#define PG8_STA_CUR(bufoff, gbase, h) do { if constexpr (GATHER) PG8_STAGE(bufoff, gbase, vc[h][0], vc[h][1]); else PG8_STAGE(bufoff, (gbase) + (h) * hstepA, voffA[0], voffA[1]); } while (0)
#define PG8_STA_SEL(bufoff, gbase, h) do { if constexpr (GATHER) PG8_STAGE(bufoff, gbase, vs[h][0], vs[h][1]); else PG8_STAGE(bufoff, (gbase) + (h) * hstepA, voffA[0], voffA[1]); } while (0)
#define PG8_LDA(dst, b, h) do { _Pragma("unroll") for (int m = 0; m < 4; ++m) _Pragma("unroll") for (int k = 0; k < 2; ++k) dst[m][k] = *(const LAS bf16x8*)(lds + PG8_SA(b, h) + aoff + m * 2048 + k * 1024); } while (0)
#define PG8_LDB(dst, b, h) do { _Pragma("unroll") for (int n = 0; n < 2; ++n) _Pragma("unroll") for (int k = 0; k < 2; ++k) dst[n][k] = *(const LAS bf16x8*)(lds + PG8_SB(b, h) + boff + n * 2048 + k * 1024); } while (0)
#define PG8_MMA(ai, bj, At, Bt) do { __builtin_amdgcn_s_setprio(1); _Pragma("unroll") for (int m = 0; m < 4; ++m) _Pragma("unroll") for (int n = 0; n < 2; ++n) _Pragma("unroll") for (int k = 0; k < 2; ++k) \
        acc[ai][bj][m][n] = __builtin_amdgcn_mfma_f32_16x16x32_bf16(Bt[n][k], At[m][k], acc[ai][bj][m][n], 0, 0, 0); __builtin_amdgcn_s_setprio(0); } while (0)
#define PG8_WAIT_V(n) asm volatile("s_waitcnt vmcnt(" #n ")" ::: "memory")
#define PG8_WAIT_L(n) asm volatile("s_waitcnt lgkmcnt(" #n ")" ::: "memory")
#define PG8_BAR __builtin_amdgcn_s_barrier()
#define PG8_SCHED __builtin_amdgcn_sched_barrier(0)
    Unit cur, nxt; int ui = 0;
    if (!S.next(0, cur)) return;
    f32x4 acc[2][2][4][2];
#pragma unroll
    for (int a = 0; a < 2; ++a)
#pragma unroll
        for (int b = 0; b < 2; ++b)
#pragma unroll
            for (int m = 0; m < 4; ++m)
#pragma unroll
                for (int n = 0; n < 2; ++n) acc[a][b][m][n] = (f32x4){0.f, 0.f, 0.f, 0.f};
    bf16x8 At[4][2], B0[2][2], B1[2][2];
    unsigned vc[2][2], vn[2][2];
    if constexpr (GATHER) S.a_off(cur, Rst, Cst, g.lda, vc);
    const char* cA = S.a_base(cur, g); const char* cB = (const char*)g.Bt + (size_t)cur.e * g.b_estride + (size_t)cur.pn * 2 * hstepB;
    PG8_STB(PG8_SB(0, 0), cB); PG8_STB(PG8_SB(0, 1), cB + hstepB); PG8_STA_CUR(PG8_SA(0, 0), cA, 0); PG8_STA_CUR(PG8_SA(0, 1), cA, 1);
    if (wr == 1) PG8_BAR;
    PG8_WAIT_V(2); PG8_BAR;
    PG8_STB(PG8_SB(1, 0), cB + kstep); PG8_STA_CUR(PG8_SA(1, 0), cA + kstep, 0); PG8_STB(PG8_SB(1, 1), cB + hstepB + kstep);
    PG8_WAIT_V(6); PG8_BAR;
    for (;;) {
        const bool has_next = S.next(ui + 1, nxt);
        const char* nA = cA; const char* nB = cB;
        if constexpr (GATHER) {
#pragma unroll
            for (int h = 0; h < 2; ++h) { vn[h][0] = vc[h][0]; vn[h][1] = vc[h][1]; } }
        if (has_next) { nA = S.a_base(nxt, g); nB = (const char*)g.Bt + (size_t)nxt.e * g.b_estride + (size_t)nxt.pn * 2 * hstepB; if constexpr (GATHER) S.a_off(nxt, Rst, Cst, g.lda, vn); }
        float pre[8];
        if constexpr (Epi::HAS_PRE) E.pre(cur, wr, fr, pre);
        if (HALF_MMA && Sched::HAS_HALF && cur.hf) {
#pragma nounroll
        for (int t = 0; t < nt; t += 2) {
            const bool last = (t == nt - 2);
            const char* a1 = cA + (size_t)(t + 1) * kstep;
            const char* a2 = last ? nA : cA + (size_t)(t + 2) * kstep; const char* b2 = last ? nB : cB + (size_t)(t + 2) * kstep;
            const char* a3 = a2 + kstep; const char* b3 = b2 + kstep;
            unsigned vs[2][2];
            if constexpr (GATHER) { vs[0][0] = last ? vn[0][0] : vc[0][0]; vs[0][1] = last ? vn[0][1] : vc[0][1]; vs[1][0] = last ? vn[1][0] : vc[1][0]; vs[1][1] = last ? vn[1][1] : vc[1][1]; }
            PG8_LDB(B0, 0, 0); PG8_LDB(B1, 0, 1); PG8_SCHED; PG8_LDA(At, 0, 0); PG8_STA_CUR(PG8_SA(1, 1), a1, 1);
            PG8_WAIT_V(8); PG8_WAIT_L(0); PG8_BAR; PG8_MMA(0, 0, At, B0); PG8_MMA(0, 1, At, B1); PG8_BAR; PG8_SCHED;
            PG8_LDA(At, 0, 1); PG8_STB(PG8_SB(0, 0), b2); PG8_STB(PG8_SB(0, 1), b2 + hstepB); PG8_STA_SEL(PG8_SA(0, 0), a2, 0);
            PG8_WAIT_V(8); PG8_WAIT_L(0); PG8_BAR;  PG8_BAR; PG8_SCHED;
            PG8_LDB(B0, 1, 0); PG8_LDB(B1, 1, 1); PG8_SCHED; PG8_LDA(At, 1, 0); PG8_STA_SEL(PG8_SA(0, 1), a2, 1);
            PG8_WAIT_V(8); PG8_WAIT_L(0); PG8_BAR; PG8_MMA(0, 0, At, B0); PG8_MMA(0, 1, At, B1); PG8_BAR; PG8_SCHED;
            PG8_LDA(At, 1, 1); PG8_STB(PG8_SB(1, 0), b3); PG8_STB(PG8_SB(1, 1), b3 + hstepB); PG8_STA_SEL(PG8_SA(1, 0), a3, 0);
            PG8_WAIT_V(8); PG8_WAIT_L(0); PG8_BAR;  PG8_BAR; PG8_SCHED;
        }
        } else {
#pragma nounroll
        for (int t = 0; t < nt; t += 2) {
            const bool last = (t == nt - 2);
            const char* a1 = cA + (size_t)(t + 1) * kstep;
            const char* a2 = last ? nA : cA + (size_t)(t + 2) * kstep; const char* b2 = last ? nB : cB + (size_t)(t + 2) * kstep;
            const char* a3 = a2 + kstep; const char* b3 = b2 + kstep;
            unsigned vs[2][2];
            if constexpr (GATHER) { vs[0][0] = last ? vn[0][0] : vc[0][0]; vs[0][1] = last ? vn[0][1] : vc[0][1]; vs[1][0] = last ? vn[1][0] : vc[1][0]; vs[1][1] = last ? vn[1][1] : vc[1][1]; }
            PG8_LDB(B0, 0, 0); PG8_LDB(B1, 0, 1); PG8_SCHED; PG8_LDA(At, 0, 0); PG8_STA_CUR(PG8_SA(1, 1), a1, 1);
            PG8_WAIT_V(8); PG8_WAIT_L(0); PG8_BAR; PG8_MMA(0, 0, At, B0); PG8_MMA(0, 1, At, B1); PG8_BAR; PG8_SCHED;
            PG8_LDA(At, 0, 1); PG8_STB(PG8_SB(0, 0), b2); PG8_STB(PG8_SB(0, 1), b2 + hstepB); PG8_STA_SEL(PG8_SA(0, 0), a2, 0);
            PG8_WAIT_V(8); PG8_WAIT_L(0); PG8_BAR; PG8_MMA(1, 0, At, B0); PG8_MMA(1, 1, At, B1); PG8_BAR; PG8_SCHED;
            PG8_LDB(B0, 1, 0); PG8_LDB(B1, 1, 1); PG8_SCHED; PG8_LDA(At, 1, 0); PG8_STA_SEL(PG8_SA(0, 1), a2, 1);
            PG8_WAIT_V(8); PG8_WAIT_L(0); PG8_BAR; PG8_MMA(0, 0, At, B0); PG8_MMA(0, 1, At, B1); PG8_BAR; PG8_SCHED;
            PG8_LDA(At, 1, 1); PG8_STB(PG8_SB(1, 0), b3); PG8_STB(PG8_SB(1, 1), b3 + hstepB); PG8_STA_SEL(PG8_SA(1, 0), a3, 0);
            PG8_WAIT_V(8); PG8_WAIT_L(0); PG8_BAR; PG8_MMA(1, 0, At, B0); PG8_MMA(1, 1, At, B1); PG8_BAR; PG8_SCHED;
        }
        }
        if (wr == 0) PG8_BAR;
        if constexpr (Epi::HAS_PRE) E.apply(acc, cur, wr, wc, fr, fq, pre); else E(acc, cur, wr, wc, fr, fq);
        if (!has_next) break;
#pragma unroll
        for (int a = 0; a < 2; ++a)
#pragma unroll
            for (int b = 0; b < 2; ++b)
#pragma unroll
                for (int m = 0; m < 4; ++m)
#pragma unroll
                    for (int n = 0; n < 2; ++n) acc[a][b][m][n] = (f32x4){0.f, 0.f, 0.f, 0.f};
        cur = nxt; cA = nA; cB = nB; ++ui;
        if constexpr (GATHER) {
#pragma unroll
            for (int h = 0; h < 2; ++h) { vc[h][0] = vn[h][0]; vc[h][1] = vn[h][1]; } }
        if (wr == 1) PG8_BAR;
    }
    PG8_WAIT_V(0);
    PG8_BAR;
#undef PG8_SA
#undef PG8_SB
#undef PG8_STAGE
#undef PG8_STB
#undef PG8_STA_CUR
#undef PG8_STA_SEL
#undef PG8_LDA
#undef PG8_LDB
#undef PG8_MMA
#undef PG8_WAIT_V
#undef PG8_WAIT_L
#undef PG8_BAR
#undef PG8_SCHED
}

struct DenseOrder {
    static constexpr bool HAS_HALF = false;
    int nM, nN, nwg, G, c, e;
    __device__ void init(int M, int N, int G_, int c_) { nM = M / BM; nN = N / BM; nwg = nM * nN; G = G_; c = c_; e = 0; }
    __device__ __forceinline__ bool next(int i, Unit& u) const {
        const long L = (long)i * G + c; if (L >= nwg) return false;
        int wgid = (int)L; { const int q = nwg / 8, r = nwg % 8, xcd = wgid % 8, off = wgid / 8; wgid = (xcd < r ? xcd * (q + 1) : r * (q + 1) + (xcd - r) * q) + off; }
        const int nig = 8 * nN, gid = wgid / nig, fm = gid * 8, gsz = (nM - fm) < 8 ? (nM - fm) : 8;
        u.pm = fm + ((wgid % nig) % gsz); u.pn = (wgid % nig) / gsz; u.e = e; u.hf = 0; return true;
    }
    __device__ __forceinline__ const char* a_base(const Unit& u, const Gemm& g) const { return (const char*)g.A + (size_t)u.pm * 256 * g.lda * 2; }
    __device__ __forceinline__ void a_off(const Unit&, const int (&R)[2], const int (&C)[2], int lda, unsigned (&v)[2][2]) const {
#pragma unroll
        for (int h = 0; h < 2; ++h)
#pragma unroll
            for (int i = 0; i < 2; ++i) v[h][i] = (unsigned)((h * 128 + R[i]) * lda + C[i]) * 2u;
    }
};
struct OwnOrder {
    static constexpr bool HAS_HALF = false;
    unsigned long long own; int nN, n;
    __device__ __forceinline__ bool next(int i, Unit& u) const {
        if (i >= n) return false;
        unsigned long long m = own; const int k = i / nN;
        for (int j = 0; j < k; ++j) m &= m - 1ull;
        u.pm = __builtin_ctzll(m); u.pn = i % nN; u.e = 0; u.hf = 0; return true;
    }
    __device__ __forceinline__ const char* a_base(const Unit& u, const Gemm& g) const { return (const char*)g.A + (size_t)u.pm * 256 * g.lda * 2; }
    __device__ __forceinline__ void a_off(const Unit&, const int (&R)[2], const int (&C)[2], int lda, unsigned (&v)[2][2]) const {
#pragma unroll
        for (int h = 0; h < 2; ++h)
#pragma unroll
            for (int i = 0; i < 2; ++i) v[h][i] = (unsigned)((h * 128 + R[i]) * lda + C[i]) * 2u;
    }
};
}

struct Args {
    const float* in[23]; float* out; unsigned char* ws; int ph_lo, ph_hi;
};
enum { I_X = 0, I_POS, I_WIN, I_WOUT, I_KVN, I_WUK, I_WUV, I_CLAM, I_CSUB, I_DCONV, I_DALOG, I_DDT, I_DNORM, I_LN1G, I_LN1B, I_WR, I_BR, I_WGU, I_BGU, I_WDN, I_BDN, I_LN2G, I_LN2B };

struct Frame {
    LAS unsigned char* lds; int tid, lane, wave, G, vcu, wv; unsigned char* ws; unsigned* ctl;
};
#define CAS __attribute__((address_space(4)))
__device__ __forceinline__ const CAS Args& kargs() { const CAS Args* p = (const CAS Args*)__builtin_amdgcn_kernarg_segment_ptr(); asm volatile("" : "+s"(p)); return *p; }
__device__ __forceinline__ void frame_refresh(Frame& F) { int t = F.wv * 64 + lane_now(); asm volatile("" : "+v"(t)); F.tid = t; F.lane = t & 63; F.wave = __builtin_amdgcn_readfirstlane(t >> 6); }

__device__ __forceinline__ void cvt_item(const float* W, int ldw, int k0, bf16* dst, int Kdst, int r0, int srccol, float scale, const float* kscale, LAS float* scr, int lane) {
#pragma unroll
    for (int kk = 0; kk < 64; ++kk) {
        float v = 0.f;
        if (srccol >= 0) v = __builtin_nontemporal_load(W + (size_t)(k0 + kk) * ldw + srccol) * scale;
        if (kscale) v *= kscale[k0 + kk];
        scr[kk * 65 + lane] = v;
    }
    asm volatile("s_waitcnt lgkmcnt(0)" ::: "memory");
    const int c = lane & 7;
#pragma unroll
    for (int j = 0; j < 8; ++j) {
        const int n = (lane >> 3) + 8 * j; const LAS float* s = scr + (8 * c) * 65 + n;
        u32x4 o; o.x = pk2(s[0], s[65]); o.y = pk2(s[2 * 65], s[3 * 65]); o.z = pk2(s[4 * 65], s[5 * 65]); o.w = pk2(s[6 * 65], s[7 * 65]);
        *(u32x4*)(dst + (size_t)(r0 + n) * Kdst + k0 + 8 * c) = o;
    }
    asm volatile("s_waitcnt lgkmcnt(0)" ::: "memory");
}

__device__ __forceinline__ bool inproj_is_rot(int g) { return (g >= 8 && g < 12) || (g >= 16 && g < 26) || (g >= 27 && g < 35) || (g >= 51 && g < 67); }
__device__ __forceinline__ void inproj_map(int r, int& sc, float& scale) {
    const int g = r >> 6; int p = r & 63; scale = 1.f;
    if (inproj_is_rot(g)) p = (p >> 1) + 32 * (p & 1);
    const float qa = 0.07216878364870322f * LOG2E;
    if (g < 8) { const int h = g >> 1; sc = SC_AQ + h * 192 + (g & 1) * 64 + p; scale = qa; }
    else if (g < 12) { sc = SC_AQ + (g - 8) * 192 + 128 + p; scale = qa; }
    else if (g < 16) sc = SC_CKV + (g - 12) * 64 + p;
    else if (g == 16) sc = SC_AKR + p;
    else if (g == 17) sc = SC_AIK + p;
    else if (g < 26) sc = SC_AIQ + (g - 18) * 64 + p;
    else if (g == 26) { sc = p < 8 ? SC_AIW + p : -1; scale = 0.04419417382415922f; }
    else if (g < 31) sc = SC_BQ + (g - 27) * 64 + p;
    else if (g < 35) { sc = SC_BK + (g - 31) * 64 + p; scale = 0.125f; }
    else if (g < 43) sc = SC_BV + (g - 35) * 64 + p;
    else if (g < 51) sc = SC_BG + (g - 43) * 64 + p;
    else if (g < 59) { sc = SC_CQ + (g - 51) * 64 + p; scale = 0.125f * LOG2E; }
    else if (g < 67) sc = SC_CK + (g - 59) * 64 + p;
    else if (g < 75) sc = SC_CV + (g - 67) * 64 + p;
    else if (g < 99) sc = SC_DQKV + (g - 75) * 64 + p;
    else if (g < 107) sc = SC_DZ + (g - 99) * 64 + p;
    else sc = p < 8 ? SC_DB + p : -1;
}

struct CvtP { const float* W; int ldw, k0; bf16* dst; int Kdst, r0, srccol; float scale; const float* ks; };
__device__ __forceinline__ void phase_prologue(Frame& F, const CAS Args& a) {
    LAS float* scr = (LAS float*)(F.lds + F.wave * 16640);
    const int gw = F.vcu * NWAVES + F.wave, NGW = F.G * NWAVES;
    bf16* Win = (bf16*)(F.ws + WS_WIN); bf16* Wkv = (bf16*)(F.ws + WS_WKV); bf16* Wout = (bf16*)(F.ws + WS_WOUT); bf16* Wgu = (bf16*)(F.ws + WS_WGU); bf16* Wdn = (bf16*)(F.ws + WS_WDN);
    constexpr int I_IN = DEPTH * (NP / 64) * (DM / 64);
    constexpr int I_KV = DEPTH * (1024 / 64) * (256 / 64);
    constexpr int I_OUT = DEPTH * (DM / 64) * (DM / 64);
    constexpr int I_GU = DEPTH * NE * (1024 / 64) * (DM / 64);
    constexpr int I_DN = DEPTH * NE * (DM / 64) * (DFF / 64);
    constexpr int NITEMS = I_IN + I_KV + I_OUT + I_GU + I_DN;
    auto decode = [&](int it, CvtP& p) {
        int r = it;
        if (r < I_IN) { const int l = r / ((NP / 64) * 32), q = r % ((NP / 64) * 32), rb = q / 32, kb = q % 32; int sc; float s; inproj_map(rb * 64 + F.lane, sc, s);
            p = CvtP{a.in[I_WIN] + (size_t)l * DM * INTOT, INTOT, kb * 64, Win + (size_t)l * NP * DM, DM, rb * 64, sc, s, nullptr}; return; }
        r -= I_IN;
        if (r < I_KV) { const int l = r / 64, q = r % 64, rb = q / 4, kb = q % 4; const int row = rb * 64 + F.lane;
            const float* src = (row < 512 ? a.in[I_WUK] : a.in[I_WUV]) + (size_t)l * 256 * 512;
            p = CvtP{src, 512, kb * 64, Wkv + (size_t)l * 1024 * 256, 256, rb * 64, row & 511, 1.f, a.in[I_KVN] + l * 256}; return; }
        r -= I_KV;
        if (r < I_OUT) { const int l = r / 1024, q = r % 1024, rb = q / 32, kb = q % 32;
            p = CvtP{a.in[I_WOUT] + (size_t)l * DM * DM, DM, kb * 64, Wout + (size_t)l * DM * DM, DM, rb * 64, rb * 64 + F.lane, 1.f, nullptr}; return; }
        r -= I_OUT;
        if (r < I_GU) { const int le = r / 512, q = r % 512, rb = q / 32, kb = q % 32; const int row = rb * 64 + F.lane;
            p = CvtP{a.in[I_WGU] + (size_t)le * DM * 1024, 1024, kb * 64, Wgu + (size_t)le * 1024 * DM, DM, rb * 64, (row >> 1) + 512 * (row & 1), 1.f, nullptr}; return; }
        r -= I_GU;
        { const int le = r / 256, q = r % 256, rb = q / 8, kb = q % 8;
            p = CvtP{a.in[I_WDN] + (size_t)le * DFF * DM, DM, kb * 64, Wdn + (size_t)le * DM * DFF, DFF, rb * 64, rb * 64 + F.lane, 1.f, nullptr}; }
    };
    CvtP pc; float rv[64];
    auto loadraw = [&](const CvtP& p) {
#pragma unroll
        for (int kk = 0; kk < 64; ++kk) rv[kk] = (p.srccol >= 0) ? __builtin_nontemporal_load(p.W + (size_t)(p.k0 + kk) * p.ldw + p.srccol) : 0.f;
    };
    int it = gw;
    if (it < NITEMS) { decode(it, pc); loadraw(pc); }
    while (it < NITEMS) {
#pragma unroll
        for (int kk = 0; kk < 64; ++kk) { float v = rv[kk] * pc.scale; if (pc.ks) v *= pc.ks[pc.k0 + kk]; scr[kk * 65 + F.lane] = v; }
        asm volatile("s_waitcnt lgkmcnt(0)" ::: "memory");
        const int nx = it + NGW; CvtP pn = pc;
        if (nx < NITEMS) { decode(nx, pn); loadraw(pn); }
        const int c = F.lane & 7;
#pragma unroll
        for (int j = 0; j < 8; ++j) {
            const int n = (F.lane >> 3) + 8 * j; const LAS float* sp = scr + (8 * c) * 65 + n;
            u32x4 o; o.x = pk2(sp[0], sp[65]); o.y = pk2(sp[2 * 65], sp[3 * 65]); o.z = pk2(sp[4 * 65], sp[5 * 65]); o.w = pk2(sp[6 * 65], sp[7 * 65]);
            *(u32x4*)(pc.dst + (size_t)(pc.r0 + n) * pc.Kdst + pc.k0 + 8 * c) = o;
        }
        asm volatile("s_waitcnt lgkmcnt(0)" ::: "memory");
        pc = pn; it = nx;
    }
    {
        const f32x4* x4 = (const f32x4*)a.in[I_X]; u32x2* xb = (u32x2*)(F.ws + WS_XB);
        const size_t n4 = (size_t)NTOK * DM / 4;
        const size_t stride = (size_t)F.G * NTHR;
        for (size_t i0 = (size_t)(F.vcu * NTHR + F.tid); i0 < n4; i0 += 8 * stride) {
            f32x4 v[8];
#pragma unroll
            for (int u = 0; u < 8; ++u) { const size_t i = i0 + u * stride; v[u] = (i < n4) ? __builtin_nontemporal_load(x4 + i) : (f32x4){0.f, 0.f, 0.f, 0.f}; }
#pragma unroll
            for (int u = 0; u < 8; ++u) { const size_t i = i0 + u * stride; if (i < n4) { u32x2 o; o.x = pk2(v[u].x, v[u].y); o.y = pk2(v[u].z, v[u].w); xb[i] = o; } }
        }
    }
    {
        const int* pos = (const int*)a.in[I_POS]; f32x2* cs = (f32x2*)(F.ws + WS_CS);
        for (int i = F.vcu * NTHR + F.tid; i < NTOK * 32; i += F.G * NTHR) {
            const int tok = i >> 5, j = i & 31; const double inv = exp2(-(double)j * (13.287712379549449 / 32.0));
            const float angf = (float)pos[tok] * (float)inv;
            double s, c; sincos((double)angf, &s, &c); cs[i] = (f32x2){(float)c, (float)s};
        }
    }
}

__host__ __device__ __forceinline__ int vperm32(int k) { return 8 * ((k >> 2) & 3) + 4 * (k >> 4) + (k & 3); }
struct EpiInProj {
    static constexpr bool PERM = true, HAS_PRE = false;
    bf16* P; const f32x2* cs; float* gb; float* iw; float* ssq; const float* a_log; const float* dt_bias;
    __device__ __forceinline__ void operator()(const f32x4 (&acc)[2][2][4][2], const pg8::Unit& u, int wr, int wc, int fr, int fq) const {
        const int row0 = u.pm * 256 + wr * 64 + fr;
#pragma unroll
        for (int bj = 0; bj < 2; ++bj) {
            const int c0 = u.pn * 256 + bj * 128 + wc * 32 + 8 * fq; const int g = c0 >> 6;
            if (inproj_is_rot(g)) {
                const int j0 = (c0 & 63) >> 1;
#pragma unroll
                for (int ai = 0; ai < 2; ++ai) {
                    f32x4 csa[4], csb[4];
#pragma unroll
                    for (int m = 0; m < 4; ++m) { const int row = row0 + ai * 128 + m * 16; csa[m] = *(const f32x4*)(cs + (size_t)row * 32 + j0); csb[m] = *(const f32x4*)(cs + (size_t)row * 32 + j0 + 2); }
#pragma unroll
                    for (int m = 0; m < 4; ++m) {
                        const int row = row0 + ai * 128 + m * 16; const f32x4 v0 = acc[ai][bj][m][0], v1 = acc[ai][bj][m][1];
                        const f32x4 cs01 = csa[m], cs23 = csb[m];
                        const float a0 = v0.x * cs01.x - v0.y * cs01.y, b0 = v0.y * cs01.x + v0.x * cs01.y;
                        const float a1 = v0.z * cs01.z - v0.w * cs01.w, b1 = v0.w * cs01.z + v0.z * cs01.w;
                        const float a2 = v1.x * cs23.x - v1.y * cs23.y, b2 = v1.y * cs23.x + v1.x * cs23.y;
                        const float a3 = v1.z * cs23.z - v1.w * cs23.w, b3 = v1.w * cs23.z + v1.z * cs23.w;
                        bf16* rp = P + (size_t)row * NP + (g << 6) + j0;
                        u32x2 lo, hi; lo.x = pk2(a0, a1); lo.y = pk2(a2, a3); hi.x = pk2(b0, b1); hi.y = pk2(b2, b3);
                        *(u32x2*)rp = lo; *(u32x2*)(rp + 32) = hi;
                    }
                    asm volatile("" ::: "memory");
                }
            } else {
#pragma unroll
                for (int ai = 0; ai < 2; ++ai)
#pragma unroll
                    for (int m = 0; m < 4; ++m) {
                        const int row = row0 + ai * 128 + m * 16; const f32x4 v0 = acc[ai][bj][m][0], v1 = acc[ai][bj][m][1];
                        u32x4 w; w.x = pk2(v0.x, v0.y); w.y = pk2(v0.z, v0.w); w.z = pk2(v1.x, v1.y); w.w = pk2(v1.z, v1.w);
                        *(u32x4*)(P + (size_t)row * NP + c0) = w;
                        if (g == 26 && (c0 & 63) == 0) { *(f32x4*)(iw + (size_t)row * 8) = v0; *(f32x4*)(iw + (size_t)row * 8 + 4) = v1; }
                        if (g == 107 && (c0 & 63) == 0) {
                            f32x4 be, gg;
#pragma unroll
                            for (int h = 0; h < 4; ++h) { be[h] = sigmoidf_(v0[h]); const float z = v1[h] + dt_bias[h]; const float ez = __expf(z); const float sp = z > 20.f ? z : (ez < 1e-4f ? ez * (1.f - 0.5f * ez) : __logf(1.f + ez));     gg[h] = -__expf(a_log[h]) * sp; }
                            *(f32x4*)(gb + (size_t)row * 8) = be; *(f32x4*)(gb + (size_t)row * 8 + 4) = gg;
                        }
                        asm volatile("" ::: "memory");
                    }
            }
        }
        if (u.pn == 3) {
#pragma unroll
            for (int ai = 0; ai < 2; ++ai)
#pragma unroll
                for (int m = 0; m < 4; ++m) {
                    float s = 0.f;
#pragma unroll
                    for (int bj = 0; bj < 2; ++bj)
#pragma unroll
                        for (int n = 0; n < 2; ++n) { const f32x4 v = acc[ai][bj][m][n]; s += (v.x * v.x + v.y * v.y) + (v.z * v.z + v.w * v.w); }
                    s = sum_x16_x32(s);
                    if (fq == 0) ssq[(size_t)(row0 + ai * 128 + m * 16) * 4 + wc] = s;
                }
        }
    }
};

struct EpiKvUp {
    static constexpr bool PERM = true, HAS_PRE = false;
    bf16* KN; bf16* VAT; const float* ssq;
    __device__ __forceinline__ void operator()(const f32x4 (&acc)[2][2][4][2], const pg8::Unit& u, int wr, int wc, int fr, int fq) const {
        const int row0 = u.pm * 256 + wr * 64 + fr;
        if (u.pn < 2) {
#pragma unroll
            for (int ai = 0; ai < 2; ++ai)
#pragma unroll
                for (int m = 0; m < 4; ++m) {
                    const int row = row0 + ai * 128 + m * 16; const f32x4 q = *(const f32x4*)(ssq + (size_t)row * 4);
                    const float rstd = 1.0f / sqrtf(((q.x + q.y) + (q.z + q.w)) * (1.f / 256.f) + RMS_EPS);
#pragma unroll
                    for (int bj = 0; bj < 2; ++bj) {
                        const int c0 = u.pn * 256 + bj * 128 + wc * 32 + 8 * fq; const f32x4 v0 = acc[ai][bj][m][0] * rstd, v1 = acc[ai][bj][m][1] * rstd;
                        u32x4 w; w.x = pk2(v0.x, v0.y); w.y = pk2(v0.z, v0.w); w.z = pk2(v1.x, v1.y); w.w = pk2(v1.z, v1.w); *(u32x4*)(KN + (size_t)row * 512 + c0) = w;
                    }
                    asm volatile("" ::: "memory");
                }
        } else {
            const int b = u.pm >> 3;
#pragma unroll
            for (int ai = 0; ai < 2; ++ai)
#pragma unroll
                for (int m = 0; m < 4; ++m) {
                    const int row = row0 + ai * 128 + m * 16; const f32x4 q = *(const f32x4*)(ssq + (size_t)row * 4);
                    const float rstd = 1.0f / sqrtf(((q.x + q.y) + (q.z + q.w)) * (1.f / 256.f) + RMS_EPS);
                    const int s = (row & 2047 & ~31) | vperm32(row & 31);
#pragma unroll
                    for (int bj = 0; bj < 2; ++bj) {
                        const int c = (u.pn - 2) * 256 + bj * 128 + wc * 32 + 8 * fq; const f32x4 v0 = acc[ai][bj][m][0] * rstd, v1 = acc[ai][bj][m][1] * rstd;
                        GAS bf16* vp = (GAS bf16*)(VAT + ((size_t)b * 512 + c) * SEQ + s);
#pragma unroll
                        for (int j = 0; j < 8; ++j) { *vp = (bf16)f2bf(j < 4 ? v0[j & 3] : v1[j & 3]); vp += SEQ; asm volatile("" : "+v"(vp)); }
                    }
                    asm volatile("" ::: "memory");
                }
        }
    }
};

struct EpiOutProj {
    static constexpr bool PERM = true, HAS_PRE = false;
    const bf16* XB; bf16* RB;
    __device__ __forceinline__ void operator()(const f32x4 (&acc)[2][2][4][2], const pg8::Unit& u, int wr, int wc, int fr, int fq) const {
        const int row0 = u.pm * 256 + wr * 64 + fr, col0 = u.pn * 256 + wc * 32 + 8 * fq;
#pragma unroll
        for (int ai = 0; ai < 2; ++ai) {
            u32x4 xr[4][2];
#pragma unroll
            for (int m = 0; m < 4; ++m) { const size_t off = (size_t)(row0 + ai * 128 + m * 16) * DM + col0; xr[m][0] = *(const u32x4*)(XB + off); xr[m][1] = *(const u32x4*)(XB + off + 128); }
#pragma unroll
            for (int m = 0; m < 4; ++m) { const size_t off = (size_t)(row0 + ai * 128 + m * 16) * DM + col0;
#pragma unroll
                for (int bj = 0; bj < 2; ++bj) { const u32x4 xw = xr[m][bj]; const f32x4 a0 = acc[ai][bj][m][0], a1 = acc[ai][bj][m][1];
                    u32x4 w; w.x = pk2(bflo(xw.x) * DN_ALPHA + a0.x, bfhi(xw.x) * DN_ALPHA + a0.y); w.y = pk2(bflo(xw.y) * DN_ALPHA + a0.z, bfhi(xw.y) * DN_ALPHA + a0.w);
                    w.z = pk2(bflo(xw.z) * DN_ALPHA + a1.x, bfhi(xw.z) * DN_ALPHA + a1.y); w.w = pk2(bflo(xw.w) * DN_ALPHA + a1.z, bfhi(xw.w) * DN_ALPHA + a1.w);
                    *(u32x4*)(RB + off + bj * 128) = w; } }
            asm volatile("" ::: "memory"); }
    }
};

struct EpiGU {
    static constexpr bool PERM = true, HAS_PRE = false;
    bf16* ACT; const float* bgu;
    __device__ __forceinline__ void operator()(const f32x4 (&acc)[2][2][4][2], const pg8::Unit& u, int wr, int wc, int fr, int fq) const {
        const int row0 = u.pm * 256 + wr * 64 + fr; const float* bb = bgu + (size_t)u.e * 1024;
#pragma unroll
        for (int bj = 0; bj < 2; ++bj) {
            const int c0 = u.pn * 256 + bj * 128 + wc * 32 + 8 * fq, j0 = c0 >> 1;
            const f32x4 bg = *(const f32x4*)(bb + j0), bl = *(const f32x4*)(bb + 512 + j0);
#pragma unroll
            for (int ai = 0; ai < 2; ++ai) {
                if (HALF_EPI && ai == 1 && u.hf) break;
#pragma unroll
                for (int m = 0; m < 4; ++m) {
                    const f32x4 v0 = acc[ai][bj][m][0], v1 = acc[ai][bj][m][1];
                    const float gl[4] = {v0.x + bg.x, v0.z + bg.y, v1.x + bg.z, v1.z + bg.w}, li[4] = {v0.y + bl.x, v0.w + bl.y, v1.y + bl.z, v1.w + bl.w}; float o[4];
#pragma unroll
                    for (int j = 0; j < 4; ++j) { const float gcl = fminf(gl[j], 7.0f), lcl = fminf(fmaxf(li[j], -7.0f), 7.0f); o[j] = gcl * sigmoidf_(1.702f * gcl) * (lcl + 1.0f); }
                    u32x2 w; w.x = pk2(o[0], o[1]); w.y = pk2(o[2], o[3]);
                    *(u32x2*)(ACT + (size_t)(row0 + ai * 128 + m * 16) * DFF + j0) = w;
                    asm volatile("" ::: "memory");
                }
            }
        }
    }
};

struct EpiDN {
    static constexpr bool PERM = true, HAS_PRE = true;
    bf16* Y; const float* bdn; const float* lgate; const int* cnt; const LAS int* pstart;
    __device__ __forceinline__ void pre(const pg8::Unit& u, int wr, int fr, float (&gt)[8]) const {
        const int row0 = u.pm * 256 + wr * 64 + fr; const int ps = pstart[u.e], ce = cnt[u.e];
#pragma unroll
        for (int ai = 0; ai < 2; ++ai)
#pragma unroll
            for (int m = 0; m < 4; ++m) { const int slot = row0 + ai * 128 + m * 16 - ps; gt[ai * 4 + m] = slot < ce ? lgate[(size_t)u.e * NTOK + slot] : 0.f; }
    }
    __device__ __forceinline__ void apply(const f32x4 (&acc)[2][2][4][2], const pg8::Unit& u, int wr, int wc, int fr, int fq, const float (&gt)[8]) const {
        const int row0 = u.pm * 256 + wr * 64 + fr; const float* bb = bdn + (size_t)u.e * DM;
        f32x4 bv[2][2];
#pragma unroll
        for (int bj = 0; bj < 2; ++bj) { const int c0 = u.pn * 256 + bj * 128 + wc * 32 + 8 * fq; bv[bj][0] = *(const f32x4*)(bb + c0); bv[bj][1] = *(const f32x4*)(bb + c0 + 4); }
#pragma unroll
        for (int ai = 0; ai < 2; ++ai) {
            if (HALF_EPI && ai == 1 && u.hf) break;
#pragma unroll
            for (int m = 0; m < 4; ++m) {
                const int row = row0 + ai * 128 + m * 16; const float g_ = gt[ai * 4 + m];
#pragma unroll
                for (int bj = 0; bj < 2; ++bj) {
                    const int c0 = u.pn * 256 + bj * 128 + wc * 32 + 8 * fq;
                    const f32x4 v0 = (acc[ai][bj][m][0] + bv[bj][0]) * g_, v1 = (acc[ai][bj][m][1] + bv[bj][1]) * g_;
                    u32x4 w; w.x = pk2(v0.x, v0.y); w.y = pk2(v0.z, v0.w); w.z = pk2(v1.x, v1.y); w.w = pk2(v1.z, v1.w);
                    *(u32x4*)(Y + (size_t)row * DM + c0) = w;
                }
                asm volatile("" ::: "memory");
            }
        }
    }
};

template <bool GATHER>
struct MoeOrder {
    static constexpr bool HAS_HALF = true;
    int nN, nwg, G, c; const LAS unsigned short* tord; const LAS int* pstart; const int* cnt; const int* ltok;
    __device__ __forceinline__ bool next(int i, pg8::Unit& u) const {
        const long L = (long)i * G + c; if (L >= nwg) return false;
        const unsigned o = tord[(int)L / nN]; u.pm = (int)(o & 511u); u.pn = (int)L % nN; u.e = (int)((o >> 9) & 31u); u.hf = (int)(o >> 15); return true;
    }
    __device__ __forceinline__ const char* a_base(const pg8::Unit& u, const pg8::Gemm& g) const { return GATHER ? (const char*)g.A : (const char*)g.A + (size_t)u.pm * 256 * g.lda * 2; }
    __device__ __forceinline__ void a_off(const pg8::Unit& u, const int (&R)[2], const int (&C)[2], int lda, unsigned (&v)[2][2]) const {
        if (GATHER) {
            const int ps = pstart[u.e], ce = cnt[u.e];
#pragma unroll
            for (int h = 0; h < 2; ++h)
#pragma unroll
                for (int i = 0; i < 2; ++i) { const int slot = u.pm * 256 + h * 128 + R[i] - ps; const int tok = slot < ce ? ltok[(size_t)u.e * NTOK + slot] : 0; v[h][i] = (unsigned)(tok * lda + C[i]) * 2u; }
        } else {
#pragma unroll
            for (int h = 0; h < 2; ++h)
#pragma unroll
                for (int i = 0; i < 2; ++i) v[h][i] = (unsigned)((h * 128 + R[i]) * lda + C[i]) * 2u;
        }
    }
};

__device__ __forceinline__ int moe_tables(Frame& F, const int* cnt, LAS int* pstart, LAS unsigned short* tord) {
    frame_refresh(F);
    LAS int* wcnt = pstart + 40;
    if (F.tid == 0) { int acc = 0; for (int e = 0; e < NE; ++e) { pstart[e] = acc; acc += (cnt[e] + 255) / 256 * 256; } pstart[NE] = acc; }
    __syncthreads();
    const int ntiles = pstart[NE] / 256; const int t = F.tid; const bool vt = t < ntiles; int e = 0; bool hf = false;
    if (vt) { while (pstart[e + 1] <= t * 256) ++e; hf = (cnt[e] - (t * 256 - pstart[e])) <= 128; }
    const unsigned long long bh = __ballot(vt && hf);
    if (F.lane == 0) wcnt[F.wave] = (int)__popcll(bh);
    __syncthreads();
    int hb = 0, htot = 0;
#pragma unroll
    for (int w = 0; w < NWAVES; ++w) { const int c = wcnt[w]; hb += (w < F.wave) ? c : 0; htot += c; }
    const int hrank = hb + (int)__popcll(bh & ((1ull << F.lane) - 1ull));
    if (vt) { const int pos = hf ? (ntiles - htot) + hrank : t - hrank; tord[pos] = (unsigned short)(t | (e << 9) | ((hf ? 1 : 0) << 15)); }
    __syncthreads();
    return ntiles;
}

__device__ __forceinline__ void ln_stats(const f32x4 (&v)[8], float& mean, float& rstd) {
    float s = 0.f;
#pragma unroll
    for (int j = 0; j < 8; ++j) s += (v[j].x + v[j].y) + (v[j].z + v[j].w);
    mean = wave_sum(s) * (1.f / DM); float q = 0.f;
#pragma unroll
    for (int j = 0; j < 8; ++j) { const f32x4 d = v[j] - mean; q += (d.x * d.x + d.y * d.y) + (d.z * d.z + d.w * d.w); }
    rstd = 1.0f / sqrtf(wave_sum(q) * (1.f / DM) + LN_EPS);
}

__device__ __forceinline__ void ln_stats32(const float (&v)[4][8], float& mean, float& rstd) {
    float s = 0.f;
#pragma unroll
    for (int j = 0; j < 4; ++j)
#pragma unroll
        for (int t = 0; t < 8; ++t) s += v[j][t];
    mean = wave_sum(s) * (1.f / DM); float q = 0.f;
#pragma unroll
    for (int j = 0; j < 4; ++j)
#pragma unroll
        for (int t = 0; t < 8; ++t) { const float d = v[j][t] - mean; q += d * d; }
    rstd = 1.0f / sqrtf(wave_sum(q) * (1.f / DM) + LN_EPS);
}
__device__ __forceinline__ void unpack8(const u32x4 w, float (&o)[8]) { o[0] = bflo(w.x); o[1] = bfhi(w.x); o[2] = bflo(w.y); o[3] = bfhi(w.y); o[4] = bflo(w.z); o[5] = bfhi(w.z); o[6] = bflo(w.w); o[7] = bfhi(w.w); }
__device__ __forceinline__ void phase_ln1_router(Frame& F, const CAS Args& a, int l) {
    frame_refresh(F);
    const bf16* RB = (const bf16*)(F.ws + WS_R); bf16* HB = (bf16*)(F.ws + WS_HB);
    const float* g1 = a.in[I_LN1G] + l * DM; const float* b1 = a.in[I_LN1B] + l * DM;
    const float* Wr = a.in[I_WR] + (size_t)l * DM * NE; const float* br = a.in[I_BR] + l * NE;
    int* ecnt = (int*)(F.ctl + CW_ECNT + l * 64); int* ltok = (int*)(F.ws + WS_LTOK); float* lgate = (float*)(F.ws + WS_LGATE); int* tslot = (int*)(F.ws + WS_TSLOT);
    LAS float* img = (LAS float*)F.lds;
    LAS float* red = (LAS float*)F.lds;
    constexpr int IST = 2052;
    float wb0[64], wb1[64];
    { const float* wp = Wr + (size_t)(F.wave * 256 + 4 * (F.lane >> 4)) * NE + (F.lane & 15);
#pragma unroll
      for (int sx = 0; sx < 64; ++sx) { const float* q = wp + (size_t)(16 * (sx >> 2) + (sx & 3)) * NE; wb0[sx] = q[0]; wb1[sx] = q[16]; } }
    LAS float* lgt = (LAS float*)(F.lds + 131584);
    u32x4 pr[2][4];
    auto fetch = [&](int un) {
#pragma unroll
        for (int rr = 0; rr < 2; ++rr)
#pragma unroll
            for (int j = 0; j < 4; ++j) pr[rr][j] = __builtin_nontemporal_load((const u32x4*)(RB + (size_t)(un * 16 + F.wave * 2 + rr) * DM + (64 * j + F.lane) * 8));
    };
    const bool aff1 = (F.G % 8 == 0); const int cpg1 = aff1 ? F.G / 8 : F.G; const int ustep = cpg1;
    const int ufirst = aff1 ? (F.vcu / cpg1) * 128 + F.vcu % cpg1 : F.vcu; const int uend = aff1 ? (F.vcu / cpg1) * 128 + 128 : NTOK / 16;
    if (ufirst < uend) fetch(ufirst);
    for (int unit = ufirst; unit < uend; unit += ustep) {
        const int r0 = unit * 16;
#pragma unroll
        for (int rr = 0; rr < 2; ++rr) {
            const int lr = F.wave * 2 + rr, row = r0 + lr; float v[4][8];
#pragma unroll
            for (int j = 0; j < 4; ++j) unpack8(pr[rr][j], v[j]);
            float mean, rstd; ln_stats32(v, mean, rstd);
#pragma unroll
            for (int j = 0; j < 4; ++j) { const int c = (64 * j + F.lane) * 8; const f32x4 ga = *(const f32x4*)(g1 + c), gb = *(const f32x4*)(g1 + c + 4), ba = *(const f32x4*)(b1 + c), bb = *(const f32x4*)(b1 + c + 4);
                const f32x4 y0 = ((f32x4){v[j][0], v[j][1], v[j][2], v[j][3]} - mean) * rstd * ga + ba, y1 = ((f32x4){v[j][4], v[j][5], v[j][6], v[j][7]} - mean) * rstd * gb + bb;
                u32x4 w; w.x = pk2(y0.x, y0.y); w.y = pk2(y0.z, y0.w); w.z = pk2(y1.x, y1.y); w.w = pk2(y1.z, y1.w); *(u32x4*)(HB + (size_t)row * DM + c) = w;
                *(LAS f32x4*)(img + lr * IST + c) = y0; *(LAS f32x4*)(img + lr * IST + c + 4) = y1; }
        }
        asm volatile("" ::: "memory");
        if (unit + ustep < uend) fetch(unit + ustep);
        __syncthreads();
        f32x4 acc0 = {0.f, 0.f, 0.f, 0.f}, acc1 = {0.f, 0.f, 0.f, 0.f};
        const int lm = lane_now();
        { const LAS float* ap = img + (lm & 15) * IST + F.wave * 256 + 4 * (lm >> 4);
#pragma unroll
            for (int s4 = 0; s4 < 16; ++s4) { const f32x4 av = *(const LAS f32x4*)(ap + 16 * s4);
#pragma unroll
                for (int t = 0; t < 4; ++t) { acc0 = __builtin_amdgcn_mfma_f32_16x16x4f32(av[t], wb0[4 * s4 + t], acc0, 0, 0, 0); acc1 = __builtin_amdgcn_mfma_f32_16x16x4f32(av[t], wb1[4 * s4 + t], acc1, 0, 0, 0); } } }
        __syncthreads();
#pragma unroll
        for (int i = 0; i < 4; ++i) { const int rw = 4 * (lm >> 4) + i; red[(F.wave * 16 + rw) * 32 + (lm & 15)] = acc0[i]; red[(F.wave * 16 + rw) * 32 + 16 + (lm & 15)] = acc1[i]; }
        __syncthreads();
        { const int tq = F.wave * 64 + lm; const int rw = tq >> 5, e = tq & 31; float s = br[e];
#pragma unroll
            for (int w = 0; w < 8; ++w) s += red[(w * 16 + rw) * 32 + e];
            lgt[tq] = s; }
        __syncthreads();
        if (F.wave == 0) {
            int ln = lm; asm volatile("" : "+v"(ln));
            const int row = ln >> 2, part = ln & 3; const LAS float* lg = lgt + row * 32 + part * 8;
            float v[8];
#pragma unroll
            for (int t = 0; t < 8; ++t) v[t] = lg[t];
            float tv[4]; int te[4];
#pragma unroll
            for (int k = 0; k < 4; ++k) {
                float best = -INFINITY; int bi = 99;
#pragma unroll
                for (int t = 0; t < 8; ++t) if (v[t] > best) { best = v[t]; bi = part * 8 + t; }
#pragma unroll
                for (int off = 1; off <= 2; off <<= 1) { const int bb_ = __builtin_bit_cast(int, best); const float ob = __builtin_bit_cast(float, off == 1 ? __builtin_amdgcn_update_dpp(0, bb_, 0xB1, 0xf, 0xf, true) : __builtin_amdgcn_update_dpp(0, bb_, 0x4E, 0xf, 0xf, true)); const int oi = off == 1 ? __builtin_amdgcn_update_dpp(0, bi, 0xB1, 0xf, 0xf, true) : __builtin_amdgcn_update_dpp(0, bi, 0x4E, 0xf, 0xf, true); if (ob > best || (ob == best && oi < bi)) { best = ob; bi = oi; } }
                tv[k] = best; te[k] = bi;
#pragma unroll
                for (int t = 0; t < 8; ++t) if (part * 8 + t == bi) v[t] = -INFINITY;
            }
            const float e1 = __expf(tv[1] - tv[0]), e2 = __expf(tv[2] - tv[0]), e3 = __expf(tv[3] - tv[0]); const float inv = 1.0f / (1.0f + e1 + e2 + e3);
            const int me = part == 0 ? te[0] : part == 1 ? te[1] : part == 2 ? te[2] : te[3];
            const float mg = part == 0 ? inv : part == 1 ? e1 * inv : part == 2 ? e2 * inv : e3 * inv;
            const int tok = r0 + row;
            unsigned long long same = 0ull;
#pragma unroll 8
            for (int e = 0; e < NE; ++e) { const unsigned long long bm = __ballot(me == e); if (me == e) same = bm; }
            const int leader = __ffsll((long long)same) - 1; const int rank = (int)__popcll(same & ((1ull << ln) - 1ull));
            int base = 0;
            if (ln == leader) base = __hip_atomic_fetch_add(ecnt + me, (int)__popcll(same), RLX_AGENT);
            base = __builtin_amdgcn_ds_bpermute(leader << 2, base);
            const int slot = base + rank;
            ltok[(size_t)me * NTOK + slot] = tok; lgate[(size_t)me * NTOK + slot] = mg; tslot[tok * 4 + part] = (me << 16) | slot;
        }
    }
    __syncthreads();
}

__device__ __forceinline__ void phase_ln2(Frame& F, const CAS Args& a, int l) {
    frame_refresh(F);
    const bf16* HB = (const bf16*)(F.ws + WS_HB); const bf16* Y = (const bf16*)(F.ws + WS_Y); const int* tslot = (const int*)(F.ws + WS_TSLOT);
    const int* ecnt = (const int*)(F.ctl + CW_ECNT + l * 64);
    float* XO = a.out; bf16* XB = (bf16*)(F.ws + WS_XB);
    const float* g2 = a.in[I_LN2G] + l * DM; const float* b2 = a.in[I_LN2B] + l * DM;
    LAS int* pstart = (LAS int*)(F.lds);
    if (F.tid == 0) { int acc = 0; for (int e = 0; e < NE; ++e) { pstart[e] = acc; acc += (ecnt[e] + 255) / 256 * 256; } }
    __syncthreads();
    f32x4 gq[4][2], bq[4][2];
#pragma unroll
    for (int j = 0; j < 4; ++j) { const int c = (64 * j + F.lane) * 8; gq[j][0] = *(const f32x4*)(g2 + c); gq[j][1] = *(const f32x4*)(g2 + c + 4); bq[j][0] = *(const f32x4*)(b2 + c); bq[j][1] = *(const f32x4*)(b2 + c + 4); }
    const bool aff2 = (F.G % 8 == 0); const int cpg2 = aff2 ? F.G / 8 : F.G;
    const int rstride = cpg2 * NWAVES; const int rend = aff2 ? (F.vcu / cpg2) * SEQ + SEQ : NTOK;
    int row = aff2 ? (F.vcu / cpg2) * SEQ + (F.vcu % cpg2) * NWAVES + F.wave : F.vcu * NWAVES + F.wave;
    int4 tsn = {0, 0, 0, 0};
    u32x4 dh[4], dy[4][4];
    auto issue = [&](int r, const int4& ts) {
        const int tsv[4] = {ts.x, ts.y, ts.z, ts.w};
#pragma unroll
        for (int j = 0; j < 4; ++j) dh[j] = __builtin_nontemporal_load((const u32x4*)(HB + (size_t)r * DM + (64 * j + F.lane) * 8));
#pragma unroll
        for (int k = 0; k < 4; ++k) { const size_t yr = (size_t)(pstart[tsv[k] >> 16] + (tsv[k] & 0xffff)) * DM;
#pragma unroll
            for (int j = 0; j < 4; ++j) dy[k][j] = __builtin_nontemporal_load((const u32x4*)(Y + yr + (64 * j + F.lane) * 8)); }
    };
    if (row < rend) { const int4 ts0 = *(const int4*)(tslot + row * 4); if (row + rstride < rend) tsn = *(const int4*)(tslot + (row + rstride) * 4); issue(row, ts0); }
    for (; row < rend; row += rstride) {
        float v[4][8];
#pragma unroll
        for (int j = 0; j < 4; ++j) { unpack8(dh[j], v[j]);
#pragma unroll
            for (int t = 0; t < 8; ++t) v[j][t] *= DN_ALPHA; }
#pragma unroll
        for (int k = 0; k < 4; ++k)
#pragma unroll
            for (int j = 0; j < 4; ++j) { float y[8]; unpack8(dy[k][j], y);
#pragma unroll
                for (int t = 0; t < 8; ++t) v[j][t] += y[t]; }
        asm volatile("" ::: "memory"); __builtin_amdgcn_sched_barrier(0);
        if (row + rstride < rend) { issue(row + rstride, tsn); if (row + 2 * rstride < rend) tsn = *(const int4*)(tslot + (row + 2 * rstride) * 4); }
        asm volatile("" ::: "memory"); __builtin_amdgcn_sched_barrier(0);
        float mean, rstd; ln_stats32(v, mean, rstd);
#pragma unroll
        for (int j = 0; j < 4; ++j) { const int c = (64 * j + F.lane) * 8; const f32x4 ga = gq[j][0], gb = gq[j][1], ba = bq[j][0], bb = bq[j][1];
            const f32x4 y0 = ((f32x4){v[j][0], v[j][1], v[j][2], v[j][3]} - mean) * rstd * ga + ba, y1 = ((f32x4){v[j][4], v[j][5], v[j][6], v[j][7]} - mean) * rstd * gb + bb;
            if (l == DEPTH - 1) { *(f32x4*)(XO + (size_t)row * DM + c) = y0; *(f32x4*)(XO + (size_t)row * DM + c + 4) = y1; }
            else { u32x4 w; w.x = pk2(y0.x, y0.y); w.y = pk2(y0.z, y0.w); w.z = pk2(y1.x, y1.y); w.w = pk2(y1.z, y1.w); *(u32x4*)(XB + (size_t)row * DM + c) = w; } }
    }
    __syncthreads();
}

__device__ __forceinline__ f32x4 mma16(f32x4 acc, const LAS bf16* A, int lda, const LAS bf16* B, int ldb, int K, int lane) {
    const LAS bf16* ap = A + (lane & 15) * lda + 8 * (lane >> 4); const LAS bf16* bp = B + (lane & 15) * ldb + 8 * (lane >> 4);
    for (int k = 0; k < K; k += 32) acc = __builtin_amdgcn_mfma_f32_16x16x32_bf16(*(const LAS bf16x8*)(ap + k), *(const LAS bf16x8*)(bp + k), acc, 0, 0, 0);
    return acc;
}
__device__ __forceinline__ float ret_lg2gamma(int h) { return log2f(1.0f - exp2f(-5.0f - (float)h)); }

__device__ __forceinline__ void ret_stage1(Frame& F, int unit) {
    const int b = unit >> 6, h = (unit >> 4) & 3, n = unit & 15; const int tok0 = b * SEQ + n * 128;
    const bf16* P = (const bf16*)(F.ws + WS_P); float* BKV = (float*)(F.ws + WS_BKV) + (size_t)unit * 8192;
    LAS bf16* KT = (LAS bf16*)F.lds;
    LAS bf16* VT = KT + 64 * 136;
    const float lg = ret_lg2gamma(h);
#pragma unroll
    for (int ps = 0; ps < 2; ++ps) { const int i_ = F.tid + 512 * ps, c = i_ & 127, ch = i_ >> 7;
        const u32x4 w = *(const u32x4*)(P + (size_t)(tok0 + c) * NP + PC_BK + 64 * h + 8 * ch);
        const float sc = fast_exp2(lg * (float)(127 - c)); const unsigned ww[4] = {w.x, w.y, w.z, w.w};
#pragma unroll
        for (int j = 0; j < 4; ++j) { KT[(8 * ch + 2 * j) * 136 + c] = (bf16)f2bf(bflo(ww[j]) * sc); KT[(8 * ch + 2 * j + 1) * 136 + c] = (bf16)f2bf(bfhi(ww[j]) * sc); } }
#pragma unroll
    for (int ps = 0; ps < 4; ++ps) { const int i_ = F.tid + 512 * ps, c = i_ & 127, ch = i_ >> 7; const u32x4 w = *(const u32x4*)(P + (size_t)(tok0 + c) * NP + PC_BV + 128 * h + 8 * ch);
        const unsigned ww[4] = {w.x, w.y, w.z, w.w};
#pragma unroll
        for (int j = 0; j < 4; ++j) { VT[(8 * ch + 2 * j) * 136 + c] = (bf16)(ww[j] & 0xffffu); VT[(8 * ch + 2 * j + 1) * 136 + c] = (bf16)(ww[j] >> 16); } }
    __syncthreads();
    const int dt = F.wave & 3, e0 = (F.wave >> 2) * 4;
#pragma unroll
    for (int et = 0; et < 4; ++et) {
        f32x4 acc = {0.f, 0.f, 0.f, 0.f};
        acc = mma16(acc, KT + dt * 16 * 136, 136, VT + (e0 + et) * 16 * 136, 136, 128, F.lane);
        *(f32x4*)(BKV + (size_t)((e0 + et) * 16 + (F.lane & 15)) * 64 + dt * 16 + 4 * (F.lane >> 4)) = acc;
    }
    __syncthreads();
}

__device__ __forceinline__ void ret_stage2(Frame& F, int unit) {
    const int b = unit >> 6, h = (unit >> 4) & 3, n = unit & 15; const int tok0 = b * SEQ + n * 128;
    const bf16* P = (const bf16*)(F.ws + WS_P); const float* BKV = (const float*)(F.ws + WS_BKV) + (size_t)(unit - n) * 8192; bf16* HEADS = (bf16*)(F.ws + WS_HEADS);
    LAS bf16* Qs = (LAS bf16*)F.lds;
    LAS bf16* Ks = Qs + 128 * 72;
    LAS bf16* VT = Ks + 128 * 72;
    LAS bf16* SC = VT + 128 * 136;
    LAS bf16* PT = SC + 128 * 136;
    const float lg = ret_lg2gamma(h);
#pragma unroll
    for (int ps = 0; ps < 2; ++ps) { const int c = (F.tid >> 3) + 64 * ps, ch = F.tid & 7; const size_t ro = (size_t)(tok0 + c) * NP;
        *(LAS u32x4*)(Qs + c * 72 + 8 * ch) = *(const u32x4*)(P + ro + PC_BQ + 64 * h + 8 * ch); *(LAS u32x4*)(Ks + c * 72 + 8 * ch) = *(const u32x4*)(P + ro + PC_BK + 64 * h + 8 * ch); }
#pragma unroll
    for (int ps = 0; ps < 4; ++ps) { const int i_ = F.tid + 512 * ps, c = i_ & 127, ch = i_ >> 7; const u32x4 w = *(const u32x4*)(P + (size_t)(tok0 + c) * NP + PC_BV + 128 * h + 8 * ch);
        const unsigned ww[4] = {w.x, w.y, w.z, w.w};
#pragma unroll
        for (int j = 0; j < 4; ++j) { VT[(8 * ch + 2 * j) * 136 + c] = (bf16)(ww[j] & 0xffffu); VT[(8 * ch + 2 * j + 1) * 136 + c] = (bf16)(ww[j] >> 16); } }
    {
        float z_ = 0.f; asm volatile("" : "+v"(z_));
#pragma unroll
        for (int ps = 0; ps < 4; ++ps) { const int idx = (F.tid + 512 * ps) * 4; f32x4 s = {z_, z_, z_, z_};
            for (int m = 0; m < n; ++m) { const float wgt = fast_exp2(lg * 128.0f * (float)(n - 1 - m)); s += *(const f32x4*)(BKV + (size_t)m * 8192 + idx) * wgt; }
            const int e = idx >> 6, d = idx & 63; u32x2 w; w.x = pk2(s.x, s.y); w.y = pk2(s.z, s.w); *(LAS u32x2*)(PT + e * 72 + d) = w; }
    }
    __syncthreads();
    const int w = F.wave, li = F.lane & 15, g = F.lane >> 4;
    for (int jt = 0; jt <= (w | 1); ++jt) {
        f32x4 acc = {0.f, 0.f, 0.f, 0.f};
        if (jt <= w) acc = mma16(acc, Ks + jt * 16 * 72, 72, Qs + w * 16 * 72, 72, 64, F.lane);
        const int i = 16 * w + li; float v[4];
#pragma unroll
        for (int r = 0; r < 4; ++r) { const int j = 16 * jt + 4 * g + r; v[r] = (j <= i) ? acc[r] * fast_exp2(lg * (float)(i - j)) : 0.f; }
        u32x2 pw; pw.x = pk2(v[0], v[1]); pw.y = pk2(v[2], v[3]); *(LAS u32x2*)(SC + i * 136 + 16 * jt + 4 * g) = pw;
    }
    asm volatile("s_waitcnt lgkmcnt(0)" ::: "memory");
    const int kext = 16 * ((w | 1) + 1);
    const int tok = tok0 + 16 * w + li; const float fin = fast_exp2(lg * (float)(16 * w + li + 1));
    f32x4 o[8]; float ss = 0.f;
#pragma unroll
    for (int et = 0; et < 8; ++et) {
        f32x4 a1 = {0.f, 0.f, 0.f, 0.f}, a2 = {0.f, 0.f, 0.f, 0.f};
        a1 = mma16(a1, VT + et * 16 * 136, 136, SC + w * 16 * 136, 136, kext, F.lane);
        a2 = mma16(a2, PT + et * 16 * 72, 72, Qs + w * 16 * 72, 72, 64, F.lane);
        o[et] = a1 + a2 * fin; ss += (o[et].x * o[et].x + o[et].y * o[et].y) + (o[et].z * o[et].z + o[et].w * o[et].w);
    }
    ss = sum_x16_x32(ss);
    const float rstd = 1.0f / sqrtf(ss * (1.f / 128.f) + RMS_EPS);
#pragma unroll
    for (int et = 0; et < 8; ++et) { const int e = 16 * et + 4 * g; const u32x2 gw = *(const u32x2*)(P + (size_t)tok * NP + PC_BG + 128 * h + e);
        const float g0 = bflo(gw.x), g1 = bfhi(gw.x), g2 = bflo(gw.y), g3 = bfhi(gw.y);
        u32x2 ow; ow.x = pk2(o[et].x * rstd * g0 * sigmoidf_(g0), o[et].y * rstd * g1 * sigmoidf_(g1)); ow.y = pk2(o[et].z * rstd * g2 * sigmoidf_(g2), o[et].w * rstd * g3 * sigmoidf_(g3));
        *(u32x2*)(HEADS + (size_t)tok * DM + 512 + 128 * h + e) = ow; }
    __syncthreads();
}

__device__ __forceinline__ float rowmax4(float x) {
    float a = x, b = x; swap16(a, b); x = fmaxf(a, b);
    a = x; b = x; swap32(a, b); return fmaxf(a, b);
}
struct AttnSrc { const bf16* q0; const bf16* q1; const bf16* k0; const bf16* k1; int sq0, sq1, sk0, sk1; const bf16* vt; const unsigned long long* mask; };
template <int D0, int D1, bool MASK, int RG>
__device__ __forceinline__ void attn_unit(Frame& F, const AttnSrc& A, int qb0  , f32x4 (&ot)[RG][8]) {
    constexpr int DK = D0 + D1, KST = DK + 8, NKS = DK / 32, KCH = DK / 8;
    constexpr int KBUF = 64 * KST, VBUF = 128 * 72;
    LAS bf16* Kl = (LAS bf16*)F.lds;
    LAS bf16* Vl = Kl + 2 * KBUF;
    const int w = F.wave, li = F.lane & 15, g = F.lane >> 4;
    const int qw0 = qb0 + 16 * RG * w;
    bf16x8 qf[RG][NKS];
#pragma unroll
    for (int r = 0; r < RG; ++r)
#pragma unroll
        for (int ks = 0; ks < NKS; ++ks) { const int d = 32 * ks + 8 * g; const int qpos = qw0 + 16 * r + li;
            if constexpr (D1 == 0) qf[r][ks] = *(const bf16x8*)(A.q0 + (size_t)qpos * A.sq0 + d);
            else qf[r][ks] = (d < D0) ? *(const bf16x8*)(A.q0 + (size_t)qpos * A.sq0 + d) : *(const bf16x8*)(A.q1 + (size_t)qpos * A.sq1 + (d - D0)); }
    float m_run[RG], l_run[RG];
#pragma unroll
    for (int r = 0; r < RG; ++r) { m_run[r] = -INFINITY; l_run[r] = 0.f;
#pragma unroll
        for (int et = 0; et < 8; ++et) ot[r][et] = (f32x4){0.f, 0.f, 0.f, 0.f}; }
    const int nkt = (qb0 + 128 * RG) / 64;
    constexpr int NKL = (64 * KCH + NTHR - 1) / NTHR;
    u32x4 kreg[NKL], vreg[2]; unsigned long long mreg[RG], mcur[RG];
#pragma unroll
    for (int r = 0; r < RG; ++r) { mreg[r] = 0ull; mcur[r] = 0ull; }
    auto issue = [&](int kt) {
#pragma unroll
        for (int i = 0; i < NKL; ++i) { const int c = F.tid + i * NTHR; if (c < 64 * KCH) { const int rr = c / KCH, ch = c % KCH, d = 8 * ch; const int key = 64 * kt + rr;
            if constexpr (D1 == 0) kreg[i] = *(const u32x4*)(A.k0 + (size_t)key * A.sk0 + d);
            else kreg[i] = (d < D0) ? *(const u32x4*)(A.k0 + (size_t)key * A.sk0 + d) : *(const u32x4*)(A.k1 + (size_t)key * A.sk1 + (d - D0)); } }
#pragma unroll
        for (int i = 0; i < 2; ++i) { const int c = F.tid + i * NTHR, e = c >> 3, ch = c & 7; vreg[i] = *(const u32x4*)(A.vt + (size_t)e * SEQ + 64 * kt + 8 * ch); }
        if (MASK) {
#pragma unroll
            for (int r = 0; r < RG; ++r) mreg[r] = A.mask[(size_t)(qw0 + 16 * r + li) * 32 + kt]; }
    };
    auto commit = [&](int buf) {
#pragma unroll
        for (int i = 0; i < NKL; ++i) { const int c = F.tid + i * NTHR; if (c < 64 * KCH) { const int rr = c / KCH, ch = c % KCH; *(LAS u32x4*)(Kl + buf * KBUF + rr * KST + 8 * ch) = kreg[i]; } }
#pragma unroll
        for (int i = 0; i < 2; ++i) { const int c = F.tid + i * NTHR, e = c >> 3, ch = c & 7; *(LAS u32x4*)(Vl + buf * VBUF + e * 72 + 8 * ch) = vreg[i]; }
    };
    issue(0); commit(0);
#pragma unroll
    for (int r = 0; r < RG; ++r) mcur[r] = mreg[r];
    __syncthreads();
    for (int kt = 0; kt < nkt; ++kt) {
        const int buf = kt & 1;
        if (kt + 1 < nkt) issue(kt + 1);
        if (64 * kt <= qw0 + 16 * RG - 1) {
            const LAS bf16* Kb = Kl + buf * KBUF; const LAS bf16* Vb = Vl + buf * VBUF;
            const bool diag = (64 * kt + 63 > qw0);
            f32x4 st[RG][4];
            unsigned nmw[RG][2];
            if constexpr (MASK) {
#pragma unroll
                for (int r = 0; r < RG; ++r) { nmw[r][0] = ~(unsigned)mcur[r] >> (4 * g); nmw[r][1] = ~(unsigned)(mcur[r] >> 32) >> (4 * g); } }
#pragma unroll
            for (int t4 = 0; t4 < 4; ++t4) {
#pragma unroll
                for (int r = 0; r < RG; ++r) {
                    if constexpr (MASK) {
#pragma unroll
                        for (int c = 0; c < 4; ++c) st[r][t4][c] = __builtin_bit_cast(float, __builtin_amdgcn_sbfe((int)nmw[r][t4 >> 1], 16 * (t4 & 1) + c, 1) & (int)0xff800000);
                    } else st[r][t4] = (f32x4){0.f, 0.f, 0.f, 0.f};
                }
#pragma unroll
                for (int ks = 0; ks < NKS; ++ks) { const bf16x8 kf = *(const LAS bf16x8*)(Kb + (16 * t4 + li) * KST + 32 * ks + 8 * g);
#pragma unroll
                    for (int r = 0; r < RG; ++r) st[r][t4] = __builtin_amdgcn_mfma_f32_16x16x32_bf16(kf, qf[r][ks], st[r][t4], 0, 0, 0); } }
            __builtin_amdgcn_sched_barrier(0);
            bf16x8 pf[RG][2]; float alpha[RG]; bool resc = false;
#pragma unroll
            for (int r = 0; r < RG; ++r) {
                const int qpos = qw0 + 16 * r + li; float mx = -INFINITY;
                if (!MASK && diag) {
#pragma unroll
                    for (int t4 = 0; t4 < 4; ++t4)
#pragma unroll
                        for (int c = 0; c < 4; ++c) { const int kin = 16 * t4 + 4 * g + c; const bool ok = (64 * kt + kin) <= qpos;
                            st[r][t4][c] = ok ? st[r][t4][c] : -INFINITY; }
                }
#pragma unroll
                for (int t4 = 0; t4 < 4; ++t4) mx = fmaxf(fmaxf(mx, fmaxf(st[r][t4][0], st[r][t4][1])), fmaxf(st[r][t4][2], st[r][t4][3]));
                mx = rowmax4(mx);
                const float m_new = fmaxf(m_run[r], mx);
                const float msafe = (m_new == -INFINITY) ? 0.f : m_new;
                alpha[r] = fast_exp2(m_run[r] - msafe);
                resc = resc || (m_new != m_run[r]);
                m_run[r] = m_new;
                float ps = 0.f; unsigned pw[8];
#pragma unroll
                for (int t4 = 0; t4 < 4; ++t4) { const float p0 = fast_exp2(st[r][t4][0] - msafe), p1 = fast_exp2(st[r][t4][1] - msafe), p2 = fast_exp2(st[r][t4][2] - msafe), p3 = fast_exp2(st[r][t4][3] - msafe);
                    ps += (p0 + p1) + (p2 + p3); pw[2 * t4] = pk2(p0, p1); pw[2 * t4 + 1] = pk2(p2, p3); }
                pf[r][0] = __builtin_bit_cast(bf16x8, (u32x4){pw[0], pw[1], pw[2], pw[3]}); pf[r][1] = __builtin_bit_cast(bf16x8, (u32x4){pw[4], pw[5], pw[6], pw[7]});
                l_run[r] = l_run[r] * alpha[r] + ps;
            }
            __builtin_amdgcn_sched_barrier(0);
            if (__any(resc)) {
#pragma unroll
                for (int r = 0; r < RG; ++r)
#pragma unroll
                    for (int et = 0; et < 8; ++et) ot[r][et] = ot[r][et] * alpha[r];
            }
#pragma unroll
            for (int et = 0; et < 8; ++et)
#pragma unroll
                for (int k2 = 0; k2 < 2; ++k2) { const bf16x8 vf = *(const LAS bf16x8*)(Vb + (16 * et + li) * 72 + 32 * k2 + 8 * g);
#pragma unroll
                    for (int r = 0; r < RG; ++r) ot[r][et] = __builtin_amdgcn_mfma_f32_16x16x32_bf16(vf, pf[r][k2], ot[r][et], 0, 0, 0); }
        }
        if (kt + 1 < nkt) { commit(buf ^ 1);
#pragma unroll
            for (int r = 0; r < RG; ++r) mcur[r] = mreg[r]; }
        __syncthreads();
    }
#pragma unroll
    for (int r = 0; r < RG; ++r) { float l = sum_x16_x32(l_run[r]); const float inv = 1.0f / l;
#pragma unroll
        for (int et = 0; et < 8; ++et) ot[r][et] = ot[r][et] * inv; }
}

__device__ __forceinline__ void cvt_transpose_unit(Frame& F, int unit) {
    const int b = unit >> 6, h = (unit >> 4) & 3, n = unit & 15; const int tok0 = b * SEQ + n * 128;
    const bf16* P = (const bf16*)(F.ws + WS_P); bf16* CVT = (bf16*)(F.ws + WS_CVT) + (size_t)(b * 4 + h) * 128 * SEQ + n * 128;
    LAS bf16* T = (LAS bf16*)F.lds;
#pragma unroll
    for (int ps = 0; ps < 4; ++ps) { const int c = (F.tid >> 4) + 32 * ps, ch = F.tid & 15; *(LAS u32x4*)(T + c * 136 + 8 * ch) = *(const u32x4*)(P + (size_t)(tok0 + c) * NP + PC_CV + 128 * h + 8 * ch); }
    __syncthreads();
#pragma unroll
    for (int ps = 0; ps < 4; ++ps) { const int it = F.tid + 512 * ps, e = it & 127, cc = it >> 7;
        unsigned wv[4];
#pragma unroll
        for (int j = 0; j < 4; ++j) {
            const int blk = cc >> 2, gg = cc & 3, j0 = 2 * j, j1 = 2 * j + 1; const int t0 = 32 * blk + 16 * (j0 >> 2) + 4 * gg + (j0 & 3), t1 = 32 * blk + 16 * (j1 >> 2) + 4 * gg + (j1 & 3);
            wv[j] = (unsigned)T[t0 * 136 + e] | ((unsigned)T[t1 * 136 + e] << 16); }
        *(u32x4*)(CVT + (size_t)e * SEQ + 8 * cc) = (u32x4){wv[0], wv[1], wv[2], wv[3]}; }
    __syncthreads();
}

constexpr int ATT_RG = 2;
__device__ __forceinline__ void diffattn_unit(Frame& F, const CAS Args& a, int l, int unit) {
    const int b = unit >> 5, h = (unit >> 3) & 3, qb = 7 - (unit & 7);
    const bf16* P = (const bf16*)(F.ws + WS_P) + (size_t)b * SEQ * NP; bf16* HEADS = (bf16*)(F.ws + WS_HEADS);
    const float* lam = a.in[I_CLAM] + l * 256; const float* sg = a.in[I_CSUB] + l * 128;
    const float l1 = wave_sum(lam[F.lane] * lam[64 + F.lane]), l2 = wave_sum(lam[128 + F.lane] * lam[192 + F.lane]);
    const float lam_init = 0.8f - 0.6f * __expf(-0.3f * (float)l); const float lam_full = __expf(l1) - __expf(l2) + lam_init;
    f32x4 o2[ATT_RG][8];
    float* O1 = (float*)(F.ws + WS_H);
    AttnSrc S; S.q1 = nullptr; S.k1 = nullptr; S.sq1 = 0; S.sk1 = 0; S.sq0 = NP; S.sk0 = NP; S.mask = nullptr;
    S.vt = (const bf16*)(F.ws + WS_CVT) + (size_t)(b * 4 + h) * 128 * SEQ;
    S.q0 = P + PC_CQ + 64 * (2 * h); S.k0 = P + PC_CK + 64 * (2 * h);
    const int li = F.lane & 15, g = F.lane >> 4;
    attn_unit<64, 0, false, ATT_RG>(F, S, qb * 128 * ATT_RG, o2);
#pragma unroll
    for (int r = 0; r < ATT_RG; ++r) { const int tok = b * SEQ + qb * 128 * ATT_RG + 16 * ATT_RG * F.wave + 16 * r + li;
#pragma unroll
        for (int et = 0; et < 8; ++et) *(f32x4*)(O1 + ((size_t)tok * 4 + h) * 128 + 16 * et + 4 * g) = o2[r][et]; }
    S.q0 = P + PC_CQ + 64 * (2 * h + 1); S.k0 = P + PC_CK + 64 * (2 * h + 1);
    attn_unit<64, 0, false, ATT_RG>(F, S, qb * 128 * ATT_RG, o2);
#pragma unroll
    for (int r = 0; r < ATT_RG; ++r) {
        const int tok = b * SEQ + qb * 128 * ATT_RG + 16 * ATT_RG * F.wave + 16 * r + li;
        float ss = 0.f; f32x4 o1[1][8];
#pragma unroll
        for (int et = 0; et < 8; ++et) o1[0][et] = *(const f32x4*)(O1 + ((size_t)tok * 4 + h) * 128 + 16 * et + 4 * g);
#pragma unroll
        for (int et = 0; et < 8; ++et) { o1[0][et] = o1[0][et] - o2[r][et] * lam_full; ss += (o1[0][et].x * o1[0][et].x + o1[0][et].y * o1[0][et].y) + (o1[0][et].z * o1[0][et].z + o1[0][et].w * o1[0][et].w); }
        ss = sum_x16_x32(ss);
        const float rs = (1.0f - lam_init) / sqrtf(ss * (1.f / 128.f) + RMS_EPS);
#pragma unroll
        for (int et = 0; et < 8; ++et) { const int e = 16 * et + 4 * g; const f32x4 gv = *(const f32x4*)(sg + e); const f32x4 y = o1[0][et] * gv * rs;
            u32x2 ow; ow.x = pk2(y.x, y.y); ow.y = pk2(y.z, y.w); *(u32x2*)(HEADS + (size_t)tok * DM + 1024 + 128 * h + e) = ow; }
    }
}

__device__ __forceinline__ unsigned ord_f32(float x) { unsigned u = __builtin_bit_cast(unsigned, x); if (u == 0x80000000u) u = 0u; return (u & 0x80000000u) ? ~u : (u | 0x80000000u); }
__device__ __forceinline__ void cnt_ge(int& c, unsigned v, unsigned cand) {
    asm volatile("v_cmp_ge_u32_e32 vcc, %1, %2\n\tv_addc_co_u32_e32 %0, vcc, 0, %0, vcc" : "+v"(c) : "v"(v), "v"(cand) : "vcc"); }
__device__ __forceinline__ void cnt_tie(int& c, unsigned v, unsigned T, int key, int mid, int big) {
    int t;
    asm volatile("v_cmp_eq_u32_e32 vcc, %2, %3\n\tv_cndmask_b32_e32 %1, %6, %4, vcc\n\tv_cmp_le_i32_e32 vcc, %1, %5\n\tv_addc_co_u32_e32 %0, vcc, 0, %0, vcc"
                 : "+v"(c), "=&v"(t) : "v"(v), "v"(T), "v"(key), "v"(mid), "v"(big) : "vcc"); }
__device__ __forceinline__ void sel_bit(unsigned& nib, unsigned v, unsigned T, int key, int X, int big, int zero) {
    int t;
    asm volatile("v_cmp_eq_u32_e32 vcc, %2, %3\n\tv_cndmask_b32_e32 %1, %6, %4, vcc\n\tv_cmp_gt_u32_e32 vcc, %2, %3\n\tv_cndmask_b32_e32 %1, %1, %7, vcc\n\tv_cmp_le_i32_e32 vcc, %1, %5\n\tv_addc_co_u32_e32 %0, vcc, %0, %0, vcc"
                 : "+v"(nib), "=&v"(t) : "v"(v), "v"(T), "v"(key), "v"(X), "v"(big), "v"(zero) : "vcc"); }
__device__ __forceinline__ void cnt_ge_s(int& c, unsigned v, unsigned cand) {
    unsigned long long m; int t;
    asm volatile("v_cmp_ge_u32_e64 %1, %3, %4\n\ts_bcnt1_i32_b64 %2, %1\n\ts_add_i32 %0, %0, %2" : "+s"(c), "=&s"(m), "=&s"(t) : "v"(v), "s"(cand) : "scc"); }
__device__ __forceinline__ void cnt_tie_s(int& c, unsigned v, unsigned T, int key, int mid) {
    unsigned long long m, n; int t;
    asm volatile("v_cmp_eq_u32_e64 %1, %4, %5\n\tv_cmp_le_i32_e64 %2, %6, %7\n\ts_and_b64 %1, %1, %2\n\ts_bcnt1_i32_b64 %3, %1\n\ts_add_i32 %0, %0, %3"
                 : "+s"(c), "=&s"(m), "=&s"(n), "=&s"(t) : "v"(v), "s"(T), "v"(key), "s"(mid) : "scc"); }
__device__ __forceinline__ void cnt_le_sv(int& c, unsigned cand, unsigned v) {
    asm volatile("v_cmp_le_u32_e32 vcc, %1, %2\n\tv_addc_co_u32_e32 %0, vcc, 0, %0, vcc" : "+v"(c) : "s"(cand), "v"(v) : "vcc"); }
__device__ __forceinline__ int wave_sum_dpp(int v) {
    v += __builtin_amdgcn_update_dpp(0, v, 0x111, 0xf, 0xf, false);
    v += __builtin_amdgcn_update_dpp(0, v, 0x112, 0xf, 0xf, false);
    v += __builtin_amdgcn_update_dpp(0, v, 0x114, 0xf, 0xf, false);
    v += __builtin_amdgcn_update_dpp(0, v, 0x118, 0xf, 0xf, false);
    v += __builtin_amdgcn_update_dpp(0, v, 0x142, 0xa, 0xf, false);
    v += __builtin_amdgcn_update_dpp(0, v, 0x143, 0xc, 0xf, false);
    return __builtin_amdgcn_readlane(v, 63);
}
__device__ __forceinline__ void indexer_unit(Frame& F, int unit) {
    const int b = unit >> 7, qi = 127 - (unit & 127), q0 = qi * 16;
    const bf16* P = (const bf16*)(F.ws + WS_P) + (size_t)b * SEQ * NP; const float* IW = (const float*)(F.ws + WS_IW) + (size_t)b * SEQ * 8;
    unsigned* M32 = (unsigned*)(F.ws + WS_MASK) + (size_t)b * SEQ * 64;
    constexpr int VST = 2052;
    LAS unsigned* V = (LAS unsigned*)F.lds;
    const int w = F.wave, li = F.lane & 15, g = F.lane >> 4, q = q0 + li;
#pragma unroll 1
    for (int rep1 = 0; rep1 < 1 + REP2(12); ++rep1) {
        bf16x8 qf[8][2]; float iwv[8];
#pragma unroll
        for (int h = 0; h < 8; ++h) { iwv[h] = IW[(size_t)q * 8 + h];
#pragma unroll
            for (int ks = 0; ks < 2; ++ks) qf[h][ks] = *(const bf16x8*)(P + (size_t)q * NP + PC_AIQ + 64 * h + 32 * ks + 8 * g); }
        const int NT = qi + 1;
        bf16x8 a0n, a1n, a0m, a1m;
        const GAS bf16* kp = (const GAS bf16*)(P + (size_t)(16 * w + li) * NP + PC_AIK + 8 * g);
        int kidx = 16 * w + 4 * g;
        a0n = *(const GAS bf16x8*)kp; a1n = *(const GAS bf16x8*)(kp + 32);
        kp += (size_t)128 * NP; asm volatile("" : "+v"(kp));
        a0m = a0n; a1m = a1n;
        if (w + 8 < NT) { a0m = *(const GAS bf16x8*)kp; a1m = *(const GAS bf16x8*)(kp + 32); }
        LAS unsigned* vrow = V + li * VST;
#pragma unroll
        for (int ti = 0; ti < 16; ++ti) {
            const int t = w + 8 * ti;
            if (t < NT) {
                const bf16x8 a0 = a0n, a1 = a1n;
                a0n = a0m; a1n = a1m;
                kp += (size_t)128 * NP; asm volatile("" : "+v"(kp));
                if (ti + 2 < 16 && t + 16 < NT) { a0m = *(const GAS bf16x8*)kp; a1m = *(const GAS bf16x8*)(kp + 32); }
                asm volatile("" ::: "memory");
                f32x4 idx = {0.f, 0.f, 0.f, 0.f};
#pragma unroll
                for (int h = 0; h < 8; ++h) { f32x4 c = {0.f, 0.f, 0.f, 0.f}; c = __builtin_amdgcn_mfma_f32_16x16x32_bf16(a0, qf[h][0], c, 0, 0, 0); c = __builtin_amdgcn_mfma_f32_16x16x32_bf16(a1, qf[h][1], c, 0, 0, 0);
#pragma unroll
                    for (int r = 0; r < 4; ++r) idx[r] += fmaxf(c[r], 0.f) * iwv[h]; }
                u32x4 o;
#pragma unroll
                for (int r = 0; r < 4; ++r) o[r] = (kidx + r <= q) ? ord_f32(idx[r]) : 0u;
                const int G = 4 * t + g; *(LAS u32x4*)(vrow + 4 * (G ^ ((G >> 4) & 15))) = o;
                kidx += 128; asm volatile("" : "+v"(kidx));
                __builtin_amdgcn_sched_barrier(0);
            }
        }
    }
    __syncthreads();
    int big = 0x7fffffff, zero = 0; asm volatile("" : "+v"(big), "+v"(zero));
#pragma unroll 1
    for (int qq2 = 0; qq2 < 2 * (1 + REP2(13)); ++qq2) {
        const int qq = qq2 & 1;
        const int ql = 2 * w + qq, qg = q0 + ql; const int L = F.lane, kbase = 32 * L;
        unsigned val[32];
#pragma unroll
        for (int m8 = 0; m8 < 8; ++m8) { const int G = 8 * L + m8; const u32x4 x = *(const LAS u32x4*)(V + ql * VST + 4 * (G ^ ((G >> 4) & 15)));
#pragma unroll
            for (int c = 0; c < 4; ++c) val[4 * m8 + c] = (kbase + 4 * m8 + c <= qg) ? x[c] : 0u; }
        unsigned T = 0u; int cge = -1;
        for (int bit = 31; bit >= 0; --bit) { const unsigned cand = T | (1u << bit); int cl = 0;
#pragma unroll
            for (int m = 0; m < 32; ++m) cnt_le_sv(cl, cand, val[m]);
            const int c = wave_sum_dpp(cl);
            if (c >= 256) { T = cand; if (c == 256) { cge = 256; break; } } }
        int X = 4096;
        if (cge < 0 && T != 0u) {
            int c1 = 0, c2 = 0;
            { int cl = 0;
#pragma unroll
              for (int m = 0; m < 32; ++m) cnt_le_sv(cl, T, val[m]);
              c1 = wave_sum_dpp(cl); }
            if (T != 0xffffffffu) { int cl = 0;
#pragma unroll
                for (int m = 0; m < 32; ++m) cnt_le_sv(cl, T + 1u, val[m]);
                c2 = wave_sum_dpp(cl); }
            if (c1 > 256) {
                const int want = 256 - c2; int lo = 0, hi = 2047;
                for (int it = 0; it < 11; ++it) { const int mid = (lo + hi) >> 1; int c = 0;
#pragma unroll
                    for (int m = 0; m < 32; ++m) cnt_tie_s(c, val[m], T, kbase + m, mid);
                    if (c >= want) hi = mid; else lo = mid + 1; }
                X = hi;
            }
        }
        unsigned word = 0u; const unsigned T1 = T > 1u ? T : 1u;
#pragma unroll
        for (int m = 31; m >= 0; --m) sel_bit(word, val[m], T1, kbase + m, X, big, zero);
        M32[(size_t)qg * 64 + L] = word;
    }
    __syncthreads();
}

__device__ __forceinline__ void dsa_attn_unit(Frame& F, int unit) {
    const int b = unit >> 6, h = (unit >> 4) & 3, qb = 15 - (unit & 15);
    const bf16* P = (const bf16*)(F.ws + WS_P) + (size_t)b * SEQ * NP; bf16* HEADS = (bf16*)(F.ws + WS_HEADS);
    AttnSrc S; S.q0 = P + PC_AQN + 128 * h; S.q1 = P + PC_AQR + 64 * h; S.sq0 = NP; S.sq1 = NP;
    S.k0 = (const bf16*)(F.ws + WS_KN) + (size_t)b * SEQ * 512 + 128 * h; S.sk0 = 512; S.k1 = P + PC_AKR; S.sk1 = NP;
    S.vt = (const bf16*)(F.ws + WS_VAT) + (size_t)(b * 4 + h) * 128 * SEQ; S.mask = (const unsigned long long*)(F.ws + WS_MASK) + (size_t)b * SEQ * 32;
    f32x4 o[1][8];
    attn_unit<128, 64, true, 1>(F, S, qb * 128, o);
    const int li = F.lane & 15, g = F.lane >> 4;
#pragma unroll
    for (int r = 0; r < 1; ++r) { const int tok = b * SEQ + qb * 128 + 16 * F.wave + li;
#pragma unroll
        for (int et = 0; et < 8; ++et) { u32x2 ow; ow.x = pk2(o[r][et].x, o[r][et].y); ow.y = pk2(o[r][et].z, o[r][et].w); *(u32x2*)(HEADS + (size_t)tok * DM + 128 * h + 16 * et + 4 * g) = ow; } }
}

__device__ __forceinline__ void gdn_prep_unit(Frame& F, const CAS Args& a, int l, int unit) {
    const int b = unit >> 7, h = (unit >> 5) & 3, n = unit & 31; const int tok0 = b * SEQ + n * 64;
    const bf16* P = (const bf16*)(F.ws + WS_P); const float* GB = (const float*)(F.ws + WS_GB);
    const float* cw = a.in[I_DCONV] + (size_t)l * 4 * 1536;
    bf16* DW = (bf16*)(F.ws + WS_DW) + (size_t)unit * 8192; bf16* DQG = (bf16*)(F.ws + WS_DQG) + (size_t)unit * 8192; bf16* DKDT = (bf16*)(F.ws + WS_DKDT) + (size_t)unit * 8192;
    bf16* DATT = (bf16*)(F.ws + WS_DATT) + (size_t)unit * 4096; float* DUT = (float*)(F.ws + WS_DUT) + (size_t)unit * 8192; float* DDL = (float*)(F.ws + WS_DDL);
    LAS bf16* Xq = (LAS bf16*)F.lds;
    LAS bf16* Xk = Xq + 64 * 136;
    LAS bf16* KT = Xk + 64 * 136;
    LAS bf16* VT = KT + 128 * 72;
    LAS bf16* T1 = VT + 128 * 72;
    LAS bf16* T2 = T1 + 64 * 72;
    LAS float* Lm = (LAS float*)(T2 + 64 * 72);
    LAS float* part = Lm + 64 * 68;
    LAS float* vG = part + 64 * 32;
    LAS float* vB = vG + 64;
    LAS float* vRq = vB + 64;
    LAS float* vRk = vRq + 64;
    const int w = F.wave, li = F.lane & 15, g = F.lane >> 4;
#pragma unroll 1
    for (int it = F.tid; it < 768; it += NTHR) {
        const int rb = it & 15, cg = it >> 4, sect = cg >> 4, c8 = 8 * (cg & 15); const int ch = sect * 512 + 128 * h + c8;
        f32x4 wt[4][2];
#pragma unroll
        for (int tap = 0; tap < 4; ++tap) { wt[tap][0] = *(const f32x4*)(cw + tap * 1536 + ch); wt[tap][1] = *(const f32x4*)(cw + tap * 1536 + ch + 4); }
        u32x4 xr[7];
#pragma unroll
        for (int i = 0; i < 7; ++i) { const int pos = n * 64 + 4 * rb - 3 + i; xr[i] = (u32x4){0u, 0u, 0u, 0u}; if (pos >= 0) xr[i] = *(const u32x4*)(P + (size_t)(tok0 + 4 * rb - 3 + i) * NP + PC_DQKV + ch); }
#pragma unroll
        for (int rr = 0; rr < 4; ++rr) {
            const int r = 4 * rb + rr; float acc[8];
#pragma unroll
            for (int j = 0; j < 8; ++j) acc[j] = 0.f;
#pragma unroll
            for (int tap = 0; tap < 4; ++tap) { const u32x4 xw = xr[rr + tap]; const f32x4 w0 = wt[tap][0], w1 = wt[tap][1];
                acc[0] += bflo(xw.x) * w0.x; acc[1] += bfhi(xw.x) * w0.y; acc[2] += bflo(xw.y) * w0.z; acc[3] += bfhi(xw.y) * w0.w;
                acc[4] += bflo(xw.z) * w1.x; acc[5] += bfhi(xw.z) * w1.y; acc[6] += bflo(xw.w) * w1.z; acc[7] += bfhi(xw.w) * w1.w; }
            float ss = 0.f;
#pragma unroll
            for (int j = 0; j < 8; ++j) { acc[j] = acc[j] * sigmoidf_(acc[j]); ss += acc[j] * acc[j]; }
            if (sect < 2) { part[r * 32 + cg] = ss; u32x4 o; o.x = pk2(acc[0], acc[1]); o.y = pk2(acc[2], acc[3]); o.z = pk2(acc[4], acc[5]); o.w = pk2(acc[6], acc[7]);
                *(LAS u32x4*)((sect == 0 ? Xq : Xk) + r * 136 + c8) = o; }
            else {
#pragma unroll
                for (int j = 0; j < 8; ++j) VT[(c8 + j) * 72 + r] = (bf16)f2bf(acc[j]); }
        }
    }
    __syncthreads();
    if (w == 0) {
        const int r = F.lane; float sq = 0.f, sk = 0.f;
#pragma unroll
        for (int c = 0; c < 16; ++c) { sq += part[r * 32 + c]; sk += part[r * 32 + 16 + c]; }
        vRq[r] = 0.08838834764831845f / sqrtf(sq + RMS_EPS); vRk[r] = 1.0f / sqrtf(sk + RMS_EPS);
        float gc = GB[(size_t)(tok0 + r) * 8 + 4 + h];
#pragma unroll
        for (int o = 1; o < 64; o <<= 1) { const float t = __builtin_bit_cast(float, __builtin_amdgcn_ds_bpermute((r - o) << 2, __builtin_bit_cast(int, gc))); if (r >= o) gc += t; }
        vG[r] = gc; vB[r] = GB[(size_t)(tok0 + r) * 8 + h];
        if (r == 63) DDL[unit] = __expf(gc);
    }
    __syncthreads();
#pragma unroll
    for (int i = 0; i < 4; ++i) {
        const int it = F.tid + 512 * i, isk = it >> 10, r = it & 63, c8 = 8 * ((it >> 6) & 15);
        LAS bf16* X = isk ? Xk : Xq; const float sc = isk ? vRk[r] : vRq[r];
        const u32x4 xw = *(const LAS u32x4*)(X + r * 136 + c8); const unsigned ww[4] = {xw.x, xw.y, xw.z, xw.w}; float v[8];
#pragma unroll
        for (int j = 0; j < 4; ++j) { v[2 * j] = bflo(ww[j]) * sc; v[2 * j + 1] = bfhi(ww[j]) * sc; }
        u32x4 o; o.x = pk2(v[0], v[1]); o.y = pk2(v[2], v[3]); o.z = pk2(v[4], v[5]); o.w = pk2(v[6], v[7]);
        *(LAS u32x4*)(X + r * 136 + c8) = o;
        if (isk) {
#pragma unroll
            for (int j = 0; j < 8; ++j) KT[(c8 + j) * 72 + r] = (bf16)f2bf(v[j]); }
        else { const float eg = __expf(vG[r]); u32x4 q; q.x = pk2(v[0] * eg, v[1] * eg); q.y = pk2(v[2] * eg, v[3] * eg); q.z = pk2(v[4] * eg, v[5] * eg); q.w = pk2(v[6] * eg, v[7] * eg);
            *(u32x4*)(DQG + r * 128 + c8) = q; }
    }
    __syncthreads();
#pragma unroll
    for (int tq = 0; tq < 4; ++tq) {
        const int tt = w * 4 + tq, isq = tt >> 4, it_ = (tt >> 2) & 3, jt = tt & 3;
        f32x4 acc = {0.f, 0.f, 0.f, 0.f};
        if (jt <= it_) acc = mma16(acc, Xk + jt * 16 * 136, 136, (isq ? Xq : Xk) + it_ * 16 * 136, 136, 128, F.lane);
        const int i = 16 * it_ + li; const float Gi = vG[i], bi = vB[i]; float v[4];
#pragma unroll
        for (int r = 0; r < 4; ++r) { const int j = 16 * jt + 4 * g + r; const float dec = __expf(Gi - vG[j]);
            v[r] = isq ? ((j <= i) ? acc[r] * dec : 0.f) : ((j < i) ? acc[r] * dec * bi : 0.f); }
        if (isq) { u32x2 o; o.x = pk2(v[0], v[1]); o.y = pk2(v[2], v[3]); *(u32x2*)(DATT + i * 64 + 16 * jt + 4 * g) = o; }
        else *(LAS f32x4*)(Lm + i * 68 + 16 * jt + 4 * g) = (f32x4){v[0], v[1], v[2], v[3]};
    }
    __syncthreads();
    LAS float* Tm = (LAS float*)Xq;
    LAS float* PS = (LAS float*)Xk + w * 272;
    auto blk_mma = [&](f32x4 acc, const LAS float* Ab, int lda, const LAS float* Bb, int ldb) -> f32x4 {
#pragma unroll
        for (int ks = 0; ks < 4; ++ks) acc = __builtin_amdgcn_mfma_f32_16x16x4f32(Ab[(F.lane & 15) * lda + 4 * ks + (F.lane >> 4)], Bb[(4 * ks + (F.lane >> 4)) * ldb + (F.lane & 15)], acc, 0, 0, 0);
        return acc; };
    auto blk_finish = [&](f32x4 p, int bi, int bj) {
#pragma unroll
        for (int r = 0; r < 4; ++r) PS[(4 * (F.lane >> 4) + r) * 17 + (F.lane & 15)] = p[r];
        asm volatile("s_waitcnt lgkmcnt(0)" ::: "memory");
        f32x4 t = {0.f, 0.f, 0.f, 0.f}; t = blk_mma(t, Tm + (16 * bi) * 68 + 16 * bi, 68, PS, 17);
#pragma unroll
        for (int r = 0; r < 4; ++r) Tm[(16 * bi + 4 * (F.lane >> 4) + r) * 68 + 16 * bj + (F.lane & 15)] = -t[r]; };
    if (w < 4) {
        if (F.lane < 16) {
            const LAS float* Lb = Lm + (16 * w) * 68 + 16 * w; float tcb[16];
#pragma unroll
            for (int k = 0; k < 16; ++k) tcb[k] = 0.f;
#pragma unroll
            for (int i = 0; i < 16; ++i) { float sacc_ = Lb[i * 68 + F.lane];
#pragma unroll
                for (int k = 0; k < i; ++k) sacc_ += Lb[i * 68 + k] * tcb[k];
                tcb[i] = -sacc_; }
            LAS float* Tb = Tm + (16 * w) * 68 + 16 * w + F.lane;
#pragma unroll
            for (int i = 0; i < 16; ++i) Tb[i * 68] = tcb[i] + (i == F.lane ? 1.0f : 0.0f);
        }
    } else {
        const float Gl = vG[63];
        for (int it = F.tid - 256; it < 1024; it += 256) { const int d = it >> 3, j8 = 8 * (it & 7);
            const u32x4 kw = *(const LAS u32x4*)(KT + d * 72 + j8); const unsigned ww[4] = {kw.x, kw.y, kw.z, kw.w}; unsigned o[4];
#pragma unroll
            for (int j = 0; j < 4; ++j) o[j] = pk2(bflo(ww[j]) * __expf(Gl - vG[j8 + 2 * j]), bfhi(ww[j]) * __expf(Gl - vG[j8 + 2 * j + 1]));
            *(u32x4*)(DKDT + d * 64 + j8) = (u32x4){o[0], o[1], o[2], o[3]}; }
    }
    __syncthreads();
    if (w < 3) { f32x4 p = {0.f, 0.f, 0.f, 0.f}; p = blk_mma(p, Lm + (16 * (w + 1)) * 68 + 16 * w, 68, Tm + (16 * w) * 68 + 16 * w, 68); blk_finish(p, w + 1, w); }
    __syncthreads();
    if (w < 2) { f32x4 p = {0.f, 0.f, 0.f, 0.f}; p = blk_mma(p, Lm + (16 * (w + 2)) * 68 + 16 * w, 68, Tm + (16 * w) * 68 + 16 * w, 68);
                 p = blk_mma(p, Lm + (16 * (w + 2)) * 68 + 16 * (w + 1), 68, Tm + (16 * (w + 1)) * 68 + 16 * w, 68); blk_finish(p, w + 2, w); }
    __syncthreads();
    if (w == 0) { f32x4 p = {0.f, 0.f, 0.f, 0.f}; p = blk_mma(p, Lm + 48 * 68, 68, Tm, 68); p = blk_mma(p, Lm + 48 * 68 + 16, 68, Tm + 16 * 68, 68); p = blk_mma(p, Lm + 48 * 68 + 32, 68, Tm + 32 * 68, 68); blk_finish(p, 3, 0); }
    __syncthreads();
    {
        const int i = F.tid >> 3, j8 = 8 * (F.tid & 7); float t1[8], t2[8];
#pragma unroll
        for (int c = 0; c < 8; ++c) { const int j = j8 + c; const float t = ((i >> 4) >= (j >> 4)) ? Tm[i * 68 + j] : 0.f; const float bj = vB[j]; t1[c] = t * bj; t2[c] = t * bj * __expf(vG[j]); }
        u32x4 a1, a2; a1.x = pk2(t1[0], t1[1]); a1.y = pk2(t1[2], t1[3]); a1.z = pk2(t1[4], t1[5]); a1.w = pk2(t1[6], t1[7]);
        a2.x = pk2(t2[0], t2[1]); a2.y = pk2(t2[2], t2[3]); a2.z = pk2(t2[4], t2[5]); a2.w = pk2(t2[6], t2[7]);
        *(LAS u32x4*)(T1 + i * 72 + j8) = a1; *(LAS u32x4*)(T2 + i * 72 + j8) = a2;
    }
    __syncthreads();
#pragma unroll
    for (int tq = 0; tq < 4; ++tq) { const int tt = w * 4 + tq, dt = tt >> 2, it_ = tt & 3;
        f32x4 acc = {0.f, 0.f, 0.f, 0.f}; acc = mma16(acc, KT + dt * 16 * 72, 72, T2 + it_ * 16 * 72, 72, 64, F.lane);
        u32x2 o; o.x = pk2(acc.x, acc.y); o.y = pk2(acc.z, acc.w); *(u32x2*)(DW + (16 * it_ + li) * 128 + 16 * dt + 4 * g) = o; }
#pragma unroll
    for (int tq = 0; tq < 4; ++tq) { const int tt = w * 4 + tq, it_ = tt >> 3, et = tt & 7;
        f32x4 acc = {0.f, 0.f, 0.f, 0.f}; acc = mma16(acc, T1 + it_ * 16 * 72, 72, VT + et * 16 * 72, 72, 64, F.lane);
        *(f32x4*)(DUT + (16 * et + li) * 64 + 16 * it_ + 4 * g) = acc; }
    __syncthreads();
}

struct GdnRegsA { bf16x8 wf[4]; f32x4 u[4]; };
struct GdnRegsB { bf16x8 qf[4], af[2], kf[2]; float dl; };
__device__ __forceinline__ void gdn_load_a(GdnRegsA& R, const unsigned char* ws, int unit, int w, int li, int g) {
    const int jb = w & 3, eh = w >> 2;
    const bf16* DW = (const bf16*)(ws + WS_DW) + (size_t)unit * 8192 + (16 * jb + li) * 128 + 8 * g; const float* DUT = (const float*)(ws + WS_DUT) + (size_t)unit * 8192;
#pragma unroll
    for (int ks = 0; ks < 4; ++ks) R.wf[ks] = *(const bf16x8*)(DW + 32 * ks);
#pragma unroll
    for (int t = 0; t < 4; ++t) R.u[t] = *(const f32x4*)(DUT + (16 * (4 * eh + t) + li) * 64 + 16 * jb + 4 * g);
}
__device__ __forceinline__ void gdn_load_b(GdnRegsB& R, const unsigned char* ws, int unit, int w, int li, int g) {
    const int jb = w & 3;
    const bf16* DQG = (const bf16*)(ws + WS_DQG) + (size_t)unit * 8192 + (16 * jb + li) * 128 + 8 * g;
    const bf16* DATT = (const bf16*)(ws + WS_DATT) + (size_t)unit * 4096 + (16 * jb + li) * 64 + 8 * g; const bf16* DKDT = (const bf16*)(ws + WS_DKDT) + (size_t)unit * 8192 + (16 * w + li) * 64 + 8 * g;
#pragma unroll
    for (int ks = 0; ks < 4; ++ks) R.qf[ks] = *(const bf16x8*)(DQG + 32 * ks);
#pragma unroll
    for (int ks = 0; ks < 2; ++ks) { R.af[ks] = *(const bf16x8*)(DATT + 32 * ks); R.kf[ks] = *(const bf16x8*)(DKDT + 32 * ks); }
    R.dl = ((const float*)(ws + WS_DDL))[unit];
}
__device__ __forceinline__ void gdn_scan_unit(Frame& F, const CAS Args& a, int l, int bh) {
    const int b = bh >> 2, h = bh & 3;
    const bf16* P = (const bf16*)(F.ws + WS_P); bf16* HEADS = (bf16*)(F.ws + WS_HEADS); const float* ng = a.in[I_DNORM] + l * 128;
    LAS bf16* ST = (LAS bf16*)F.lds;
    LAS bf16* VN = ST + 128 * 136;
    LAS float* red = (LAS float*)(VN + 128 * 72);
    const int w = F.wave, li = F.lane & 15, g = F.lane >> 4, jb = w & 3, eh = w >> 2;
    for (int i = F.tid; i < 128 * 136 / 2; i += NTHR) ((LAS unsigned*)ST)[i] = 0u;
    f32x4 sacc[8];
#pragma unroll
    for (int et = 0; et < 8; ++et) sacc[et] = (f32x4){0.f, 0.f, 0.f, 0.f};
    GdnRegsA cur, nxt; GdnRegsB cb;
    gdn_load_a(cur, F.ws, bh * 32, w, li, g);
    __syncthreads();
    for (int n = 0; n < 32; ++n) {
        gdn_load_b(cb, F.ws, bh * 32 + n, w, li, g);
        gdn_load_a(nxt, F.ws, bh * 32 + (n < 31 ? n + 1 : n), w, li, g);
        const int tok = b * SEQ + n * 64 + 16 * jb + li;
        u32x2 zw[4];
#pragma unroll
        for (int t = 0; t < 4; ++t) zw[t] = *(const u32x2*)(P + (size_t)tok * NP + PC_DZ + 128 * h + 16 * (4 * eh + t) + 4 * g);
#pragma unroll
        for (int t = 0; t < 4; ++t) { f32x4 acc = {0.f, 0.f, 0.f, 0.f}; const LAS bf16* sp = ST + (16 * (4 * eh + t) + li) * 136 + 8 * g;
#pragma unroll
            for (int ks = 0; ks < 4; ++ks) acc = __builtin_amdgcn_mfma_f32_16x16x32_bf16(cur.wf[ks], *(const LAS bf16x8*)(sp + 32 * ks), acc, 0, 0, 0);
            const f32x4 vn = cur.u[t] - acc; u32x2 o; o.x = pk2(vn.x, vn.y); o.y = pk2(vn.z, vn.w);
            *(LAS u32x2*)(VN + (16 * (4 * eh + t) + li) * 72 + 16 * jb + 4 * g) = o; }
        __syncthreads();
        f32x4 oacc[4]; float ss = 0.f;
#pragma unroll
        for (int t = 0; t < 4; ++t) { f32x4 acc = {0.f, 0.f, 0.f, 0.f}; const LAS bf16* sp = ST + (16 * (4 * eh + t) + li) * 136 + 8 * g; const LAS bf16* vp = VN + (16 * (4 * eh + t) + li) * 72 + 8 * g;
#pragma unroll
            for (int ks = 0; ks < 4; ++ks) acc = __builtin_amdgcn_mfma_f32_16x16x32_bf16(*(const LAS bf16x8*)(sp + 32 * ks), cb.qf[ks], acc, 0, 0, 0);
#pragma unroll
            for (int ks = 0; ks < 2; ++ks) acc = __builtin_amdgcn_mfma_f32_16x16x32_bf16(*(const LAS bf16x8*)(vp + 32 * ks), cb.af[ks], acc, 0, 0, 0);
            oacc[t] = acc; ss += (acc.x * acc.x + acc.y * acc.y) + (acc.z * acc.z + acc.w * acc.w); }
        ss = sum_x16_x32(ss);
        if (g == 0) red[eh * 64 + 16 * jb + li] = ss;
        __syncthreads();
#pragma unroll
        for (int et = 0; et < 8; ++et) { f32x4 acc = sacc[et] * cb.dl; const LAS bf16* vp = VN + (16 * et + li) * 72 + 8 * g;
#pragma unroll
            for (int ks = 0; ks < 2; ++ks) acc = __builtin_amdgcn_mfma_f32_16x16x32_bf16(cb.kf[ks], *(const LAS bf16x8*)(vp + 32 * ks), acc, 0, 0, 0);
            sacc[et] = acc; u32x2 o; o.x = pk2(acc.x, acc.y); o.y = pk2(acc.z, acc.w); *(LAS u32x2*)(ST + (16 * et + li) * 136 + 16 * w + 4 * g) = o; }
        { const float tot = red[16 * jb + li] + red[64 + 16 * jb + li]; const float rstd = 1.0f / sqrtf(tot * (1.f / 128.f) + RMS_EPS);
#pragma unroll
          for (int t = 0; t < 4; ++t) { const int e = 16 * (4 * eh + t) + 4 * g; const f32x4 gv = *(const f32x4*)(ng + e);
              const float z0 = bflo(zw[t].x), z1 = bfhi(zw[t].x), z2 = bflo(zw[t].y), z3 = bfhi(zw[t].y);
              u32x2 o; o.x = pk2(oacc[t].x * rstd * gv.x * z0 * sigmoidf_(z0), oacc[t].y * rstd * gv.y * z1 * sigmoidf_(z1)); o.y = pk2(oacc[t].z * rstd * gv.z * z2 * sigmoidf_(z2), oacc[t].w * rstd * gv.w * z3 * sigmoidf_(z3));
              *(u32x2*)(HEADS + (size_t)tok * DM + 1536 + 128 * h + e) = o; } }
        cur = nxt;
        __syncthreads();
    }
}

__device__ __forceinline__ int queue_next(Frame& F, int* head, int base = 0);
struct QGroup { int x, nb, cpg, j; };
__device__ __forceinline__ QGroup qgroup(const Frame& F) { QGroup q; if (F.G % 8 == 0) { q.cpg = F.G / 8; q.x = F.vcu / q.cpg; q.j = F.vcu % q.cpg; q.nb = 1; } else { q.cpg = F.G; q.x = 0; q.j = F.vcu; q.nb = 8; } return q; }
constexpr int CW_XQ = 32768;
__device__ __forceinline__ int* xq_head(const Frame& F, int l, int q, int x) { return (int*)(F.ctl + CW_XQ + ((l * 8 + q) * 8 + x) * 64); }
#define XQ_B(g, i) ((g).nb * (g).x + (i) % (g).nb)
#define XQ_R(g, i) ((i) / (g).nb)
__device__ __forceinline__ void phase_prep_mixers(Frame& F, const CAS Args& a, int l, int qoff) {
    (void)qoff;
    frame_refresh(F);
    const QGroup g = qgroup(F);
    for (int i = g.j; i < (g.nb << 6); i += g.cpg) ret_stage1(F, (XQ_B(g, i) << 6) | XQ_R(g, i));
    for (int i = g.j; i < (g.nb << 6); i += g.cpg) cvt_transpose_unit(F, (XQ_B(g, i) << 6) | XQ_R(g, i));
    frame_refresh(F);
    { const int n = g.nb << 7, base = g.cpg < n ? g.cpg : n; int* qh = xq_head(F, l, 0, g.x);
      for (int i = g.j < n ? g.j : n; i < n; i = queue_next(F, qh, base)) indexer_unit(F, (XQ_B(g, i) << 7) | XQ_R(g, i)); }
    frame_refresh(F);
    { const int n = g.nb << 7; int* qh = xq_head(F, l, 1, g.x);
      for (int i = queue_next(F, qh); i < n; i = queue_next(F, qh)) gdn_prep_unit(F, a, l, (XQ_B(g, i) << 7) | XQ_R(g, i)); }
}

__device__ __forceinline__ int queue_next(Frame& F, int* head, int base) {
    LAS int* qslot = (LAS int*)(F.lds + MISC_OFF + 64);
    if (F.tid == 0) *qslot = __hip_atomic_fetch_add(head, 1, RLX_AGENT) + base;
    __syncthreads();
    const int item = *qslot;
    __syncthreads();
    return item;
}
__device__ __forceinline__ void phase_mix(Frame& F, const CAS Args& a, int l, int qoff) {
    (void)qoff;
    frame_refresh(F);
    const QGroup g = qgroup(F);
    { const int n = g.nb << 2, base = g.cpg < n ? g.cpg : n; int* qh = xq_head(F, l, 2, g.x);
      for (int i = g.j < n ? g.j : n; i < n; i = queue_next(F, qh, base)) gdn_scan_unit(F, a, l, (XQ_B(g, i) << 2) | XQ_R(g, i)); }
    frame_refresh(F);
    { const int n = g.nb << 5; int* qh = xq_head(F, l, 3, g.x);
      for (int i = queue_next(F, qh); i < n; i = queue_next(F, qh)) { const int r = XQ_R(g, i); diffattn_unit(F, a, l, (XQ_B(g, i) << 5) | ((r & 3) << 3) | (r >> 2)); } }
    frame_refresh(F);
    { const int n = g.nb << 6; int* qh = xq_head(F, l, 4, g.x);
      for (int i = queue_next(F, qh); i < n; i = queue_next(F, qh)) { const int r = XQ_R(g, i); dsa_attn_unit(F, (XQ_B(g, i) << 6) | ((r & 3) << 4) | (r >> 2)); } }
    frame_refresh(F);
    { const int n = g.nb << 6; int* qh = xq_head(F, l, 5, g.x);
      for (int i = queue_next(F, qh); i < n; i = queue_next(F, qh)) ret_stage2(F, (XQ_B(g, i) << 6) | XQ_R(g, i)); }
}

__device__ __forceinline__ void phase_zero_heads(Frame& F) {
    frame_refresh(F);
    u32x4* hp = (u32x4*)(F.ws + WS_HEADS); const size_t n = (size_t)NTOK * DM * 2 / 16;
    unsigned z = 0u; asm volatile("" : "+v"(z));
    for (size_t i = (size_t)(F.vcu * NTHR + F.tid); i < n; i += (size_t)F.G * NTHR) hp[i] = (u32x4){z, z, z, z};
}

constexpr int PH_PER_LAYER = 8;
constexpr int N_PHASES = 1 + DEPTH * PH_PER_LAYER;

__global__ void __launch_bounds__(NTHR, 2) mega_fwd(Args args) {
    extern __shared__ __attribute__((aligned(16))) unsigned char lds_raw[];
    Frame F;
    F.lds = (LAS unsigned char*)lds_raw; F.tid = threadIdx.x; F.lane = F.tid & 63; F.wave = __builtin_amdgcn_readfirstlane(F.tid >> 6); F.wv = F.wave;
    F.G = gridDim.x; { const int bx = blockIdx.x; F.vcu = (F.G % 8 == 0) ? (bx % 8) * (F.G / 8) + bx / 8 : bx; }
    F.ws = args.ws; F.ctl = (unsigned*)(args.ws + WS_CTL);
    volatile LAS unsigned* MISC = (volatile LAS unsigned*)(F.lds + MISC_OFF);
    if (F.tid < 64) MISC[F.tid] = 0u;
    __syncthreads();
#if ONE_LAUNCH
    XcdBarrier bar = xcd_barrier_post(F.ctl + CW_BAR, MISC + 8);
#define GRID_BAR() xcd_barrier(bar)
#else
#define GRID_BAR() do {} while (0)
#endif
    const int lo = args.ph_lo, hi = args.ph_hi;
#define IN(k) (lo <= (k) && (k) < hi)
#define SEAM(k) do { if (IN(k) && IN((k) + 1)) GRID_BAR(); } while (0)

    if (PHON(0) && IN(0)) { phase_prologue(F, kargs()); __syncthreads(); if (REP2(0)) { phase_prologue(F, kargs()); __syncthreads(); } }
    SEAM(0);
    for (int l = 0; l < DEPTH; ++l) {
        const int p0 = 1 + l * PH_PER_LAYER;
        if (p0 + PH_PER_LAYER <= lo || p0 >= hi) continue;
        if (PHON(1) && IN(p0 + 0)) {
            pg8::Gemm g{(const bf16*)(F.ws + WS_XB), (const bf16*)(F.ws + WS_WIN) + (size_t)l * NP * DM, DM, DM, 0};
            pg8::DenseOrder S; S.init(NTOK, NP, F.G, (int)blockIdx.x);
            EpiInProj E{(bf16*)(F.ws + WS_P), (const f32x2*)(F.ws + WS_CS), (float*)(F.ws + WS_GB), (float*)(F.ws + WS_IW), (float*)(F.ws + WS_SSQ), kargs().in[I_DALOG] + l * 4, kargs().in[I_DDT] + l * 4};
            pg8::gemm_phase<false>(F.lds, g, S, E, F.wv);
            if (REP2(1)) pg8::gemm_phase<false>(F.lds, g, S, E, F.wv);
            if (PHON(2)) {
                unsigned long long own = 0ull; { pg8::Unit u; for (int i = 0; S.next(i, u); ++i) if (u.pn == PC_CKV / 256) own |= 1ull << u.pm; }
                pg8::Gemm gk{(const bf16*)(F.ws + WS_P) + PC_CKV, (const bf16*)(F.ws + WS_WKV) + (size_t)l * 1024 * 256, NP, 256, 0};
                pg8::OwnOrder S2{own, 4, 4 * (int)__builtin_popcountll(own)};
                EpiKvUp E2{(bf16*)(F.ws + WS_KN), (bf16*)(F.ws + WS_VAT), (const float*)(F.ws + WS_SSQ)};
                pg8::gemm_phase<false>(F.lds, gk, S2, E2, F.wv);
            }
        }
        SEAM(p0 + 0);
        if (PHON(2) && IN(p0 + 1)) {
            phase_prep_mixers(F, kargs(), l, 0);
            if (REP2(2)) phase_prep_mixers(F, kargs(), l, 32);
        }
        SEAM(p0 + 1);
        if (PHON(3) && IN(p0 + 2)) { phase_mix(F, kargs(), l, 0); if (REP2(3)) phase_mix(F, kargs(), l, 32); }
        SEAM(p0 + 2);
        if (PHON(5) && IN(p0 + 3)) {
            pg8::Gemm g{(const bf16*)(F.ws + WS_HEADS), (const bf16*)(F.ws + WS_WOUT) + (size_t)l * DM * DM, DM, DM, 0};
            pg8::DenseOrder S; S.init(NTOK, DM, F.G, (int)blockIdx.x);
            EpiOutProj E{(const bf16*)(F.ws + WS_XB), (bf16*)(F.ws + WS_R)};
            pg8::gemm_phase<false>(F.lds, g, S, E, F.wv);
            if (REP2(5)) pg8::gemm_phase<false>(F.lds, g, S, E, F.wv);
        }
        SEAM(p0 + 3);
        if (PHON(6) && IN(p0 + 4)) phase_ln1_router(F, kargs(), l);
        SEAM(p0 + 4);
        if (PHON(7) && IN(p0 + 5)) {
            LAS int* pstart = (LAS int*)(F.lds + RING_BYTES); LAS unsigned short* tord = (LAS unsigned short*)(F.lds + RING_BYTES + 512);
            const int* ecnt = (const int*)(F.ctl + CW_ECNT + l * 64);
            const int ntiles = moe_tables(F, ecnt, pstart, tord);
            pg8::Gemm g{(const bf16*)(F.ws + WS_HB), (const bf16*)(F.ws + WS_WGU) + (size_t)l * NE * 1024 * DM, DM, DM, (size_t)1024 * DM * 2};
            MoeOrder<true> S{4, ntiles * 4, F.G, F.vcu, tord, pstart, ecnt, (const int*)(F.ws + WS_LTOK)};
            EpiGU E{(bf16*)(F.ws + WS_ACT), kargs().in[I_BGU] + (size_t)l * NE * 1024};
            pg8::gemm_phase<true>(F.lds, g, S, E, F.wv);
            if (REP2(7)) pg8::gemm_phase<true>(F.lds, g, S, E, F.wv);
        }
        SEAM(p0 + 5);
        if (PHON(8) && IN(p0 + 6)) {
            LAS int* pstart = (LAS int*)(F.lds + RING_BYTES); LAS unsigned short* tord = (LAS unsigned short*)(F.lds + RING_BYTES + 512);
            const int* ecnt = (const int*)(F.ctl + CW_ECNT + l * 64);
            const int ntiles = moe_tables(F, ecnt, pstart, tord);
            pg8::Gemm g{(const bf16*)(F.ws + WS_ACT), (const bf16*)(F.ws + WS_WDN) + (size_t)l * NE * DM * DFF, DFF, DFF, (size_t)DM * DFF * 2};
            MoeOrder<false> S{8, ntiles * 8, F.G, F.vcu, tord, pstart, ecnt, nullptr};
            EpiDN E{(bf16*)(F.ws + WS_Y), kargs().in[I_BDN] + (size_t)l * NE * DM, (const float*)(F.ws + WS_LGATE), ecnt, pstart};
            pg8::gemm_phase<false>(F.lds, g, S, E, F.wv);
            if (REP2(8)) pg8::gemm_phase<false>(F.lds, g, S, E, F.wv);
        }
        SEAM(p0 + 6);
        if (PHON(9) && IN(p0 + 7)) { phase_ln2(F, kargs(), l); if (REP2(9)) phase_ln2(F, kargs(), l); }
        SEAM(p0 + 7);
    }
#undef IN
#undef SEAM
}

extern "C" void kernel_launch(void* const* d_in, const int* in_sizes, int n_in, void* d_out, int out_size, void* d_ws, size_t ws_size, hipStream_t stream) {
    static int grid = 0;
    if (grid == 0) {
        if (n_in != 23 || out_size != NTOK * DM || ws_size < WS_END) { fprintf(stderr, "kernel_launch: unexpected shapes (n_in %d out %d ws %zu need %zu)\n", n_in, out_size, ws_size, (size_t)WS_END); grid = -1; return; }
        int dev = 0, cus = 0, per_cu = 0;
        if (hipGetDevice(&dev) != hipSuccess || hipDeviceGetAttribute(&cus, hipDeviceAttributeMultiprocessorCount, dev) != hipSuccess) { grid = -1; return; }
        if (hipFuncSetAttribute((const void*)mega_fwd, hipFuncAttributeMaxDynamicSharedMemorySize, LDS_BYTES) != hipSuccess) { fprintf(stderr, "kernel_launch: hipFuncSetAttribute failed\n"); grid = -1; return; }
        if (hipOccupancyMaxActiveBlocksPerMultiprocessor(&per_cu, (const void*)mega_fwd, NTHR, LDS_BYTES) != hipSuccess || per_cu < 1) fprintf(stderr, "kernel_launch: occupancy query says %d\n", per_cu);
        (void)hipGetLastError();
        grid = cus;
    }
    if (grid < 0) return;
    (void)hipMemsetAsync((char*)d_ws + WS_CTL, 0, CTL_ZERO_BYTES, stream);
    Args a{};
    for (int i = 0; i < 23; ++i) a.in[i] = (const float*)d_in[i];
    a.out = (float*)d_out; a.ws = (unsigned char*)d_ws;
#if ONE_LAUNCH
    a.ph_lo = 0; a.ph_hi = N_PHASES;
    hipLaunchKernelGGL(mega_fwd, dim3(grid), dim3(NTHR), LDS_BYTES, stream, a);
#else
    for (int p = 0; p < N_PHASES; ++p) { a.ph_lo = p; a.ph_hi = p + 1; hipLaunchKernelGGL(mega_fwd, dim3(grid), dim3(NTHR), LDS_BYTES, stream, a); }
#endif
}
```

```cpp
#include <hip/hip_runtime.h>
#include <cstdio>
#include <cstdint>

#ifndef ONE_LAUNCH
#define ONE_LAUNCH 1
#endif
#ifndef PHASE_MASK
#define PHASE_MASK 0xfffff
#endif
#define NO_MOE 0
#define PHON(k) ((PHASE_MASK >> (k)) & 1)
#ifndef HALF_MMA
#define HALF_MMA 1
#endif
#ifndef HALF_EPI
#define HALF_EPI 1
#endif
#ifndef REP_MASK
#define REP_MASK 0
#endif
#define REP2(k) ((REP_MASK >> (k)) & 1)

#define LAS __attribute__((address_space(3)))
#define GAS __attribute__((address_space(1)))
typedef unsigned short bf16;
typedef short bf16x8 __attribute__((ext_vector_type(8)));
typedef float f32x4 __attribute__((ext_vector_type(4)));
typedef float f32x2 __attribute__((ext_vector_type(2)));
typedef unsigned u32x4 __attribute__((ext_vector_type(4)));
typedef unsigned u32x2 __attribute__((ext_vector_type(2)));

constexpr int DM = 2048, NBATCH = 8, SEQ = 2048, NTOK = NBATCH * SEQ, DEPTH = 4;
constexpr int INTOT = 6800, NP = 6912;
constexpr int NE = 32, TOPK = 4, DFF = 512;
constexpr int NWAVES = 8, NTHR = 512;
constexpr float LN_EPS = 1e-5f, RMS_EPS = 1e-6f;
constexpr float DN_ALPHA = 1.681792830507429f;
constexpr float LOG2E = 1.4426950408889634f;
constexpr int MAXROWS = NTOK * TOPK + NE * 256;

constexpr int PC_AQN = 0, PC_AQR = 512, PC_CKV = 768, PC_AKR = 1024, PC_AIK = 1088, PC_AIQ = 1152, PC_AIW = 1664;
constexpr int PC_BQ = 1728, PC_BK = 1984, PC_BV = 2240, PC_BG = 2752;
constexpr int PC_CQ = 3264, PC_CK = 3776, PC_CV = 4288;
constexpr int PC_DQKV = 4800, PC_DZ = 6336, PC_DBA = 6848;
constexpr int SC_AQ = 0, SC_CKV = 768, SC_AKR = 1024, SC_AIQ = 1088, SC_AIK = 1600, SC_AIW = 1664, SC_BQ = 1672, SC_BK = 1928, SC_BV = 2184, SC_BG = 2696;
constexpr int SC_CQ = 3208, SC_CK = 3720, SC_CV = 4232, SC_DQKV = 4744, SC_DZ = 6280, SC_DB = 6792;

constexpr size_t MiB = 1u << 20;
constexpr size_t WS_CTL = 0, CTL_ZERO_BYTES = 1 * MiB;
constexpr size_t WS_CS = 1 * MiB;
constexpr size_t WS_WIN = 8 * MiB;
constexpr size_t WS_WKV = WS_WIN + 108 * MiB;
constexpr size_t WS_WOUT = WS_WKV + 2 * MiB;
constexpr size_t WS_WGU = WS_WOUT + 32 * MiB;
constexpr size_t WS_WDN = WS_WGU + 512 * MiB;
constexpr size_t WS_X = WS_WDN + 256 * MiB;
constexpr size_t WS_XB = WS_X + 128 * MiB;
constexpr size_t WS_P = WS_XB + 64 * MiB;
constexpr size_t WS_SIDE = WS_P + 216 * MiB;
constexpr size_t WS_GB = WS_SIDE, WS_IW = WS_SIDE + 512 * 1024, WS_SSQ = WS_SIDE + 1024 * 1024;
constexpr size_t WS_KN = WS_SIDE + 2 * MiB;
constexpr size_t WS_VAT = WS_KN + 16 * MiB;
constexpr size_t WS_HEADS = WS_VAT + 16 * MiB;
constexpr size_t WS_R = WS_HEADS + 64 * MiB;
constexpr size_t WS_H = WS_R + 128 * MiB;
constexpr size_t WS_HB = WS_H + 128 * MiB;
constexpr size_t WS_ACT = WS_HB + 64 * MiB;
constexpr size_t WS_Y = WS_ACT + 72 * MiB;
constexpr size_t WS_LTOK = WS_Y + 288 * MiB;
constexpr size_t WS_LGATE = WS_LTOK + 2 * MiB;
constexpr size_t WS_TSLOT = WS_LGATE + 2 * MiB;
constexpr size_t WS_MIX = WS_TSLOT + 1 * MiB;
constexpr size_t WS_BKV = WS_MIX;
constexpr size_t WS_CVT = WS_BKV + 16 * MiB;
constexpr size_t WS_MASK = WS_CVT + 16 * MiB;
constexpr size_t WS_DPRE = WS_MASK + 4 * MiB;
constexpr size_t WS_DW = WS_DPRE;
constexpr size_t WS_DQG = WS_DW + 16 * MiB;
constexpr size_t WS_DKDT = WS_DQG + 16 * MiB;
constexpr size_t WS_DATT = WS_DKDT + 16 * MiB;
constexpr size_t WS_DUT = WS_DATT + 8 * MiB;
constexpr size_t WS_DDL = WS_DUT + 32 * MiB;
constexpr size_t WS_END = WS_MIX + 512 * MiB;

constexpr int CW_BAR = 4096;
constexpr int CW_ECNT = 16384;
constexpr int CW_QUEUE = 20480;

constexpr int RING_BYTES = 131072;
constexpr int MISC_OFF = 135168;
constexpr int LDS_BYTES = 147456;

#define RLX_AGENT __ATOMIC_RELAXED, __HIP_MEMORY_SCOPE_AGENT
__device__ __forceinline__ unsigned f2bf(float f) { unsigned u = __builtin_bit_cast(unsigned, f); return (u + 0x7fffu + ((u >> 16) & 1u)) >> 16; }
typedef __bf16 bf16x2_t __attribute__((ext_vector_type(2)));
__device__ __forceinline__ unsigned pk2(float lo, float hi) { const f32x2 v = {lo, hi}; const bf16x2_t b = __builtin_convertvector(v, bf16x2_t); return __builtin_bit_cast(unsigned, b); }
__device__ __forceinline__ float bf2f(unsigned short h) { return __builtin_bit_cast(float, (unsigned)h << 16); }
__device__ __forceinline__ float bflo(unsigned w) { return __builtin_bit_cast(float, w << 16); }
__device__ __forceinline__ float bfhi(unsigned w) { return __builtin_bit_cast(float, w & 0xffff0000u); }
#define DPP_ADDF(v, ctrl, rmask) v += __builtin_bit_cast(float, __builtin_amdgcn_update_dpp(0, __builtin_bit_cast(int, v), ctrl, rmask, 0xf, false))
__device__ __forceinline__ float wave_sum(float v) {
    DPP_ADDF(v, 0x111, 0xf); DPP_ADDF(v, 0x112, 0xf); DPP_ADDF(v, 0x114, 0xf); DPP_ADDF(v, 0x118, 0xf);
    DPP_ADDF(v, 0x142, 0xa); DPP_ADDF(v, 0x143, 0xc);
    return __builtin_bit_cast(float, __builtin_amdgcn_readlane(__builtin_bit_cast(int, v), 63));
}
__device__ __forceinline__ void swap16(float& a, float& b) { asm volatile("s_nop 1\n\tv_permlane16_swap_b32 %0, %1\n\ts_nop 1" : "+v"(a), "+v"(b)); }
__device__ __forceinline__ void swap32(float& a, float& b) { asm volatile("s_nop 1\n\tv_permlane32_swap_b32 %0, %1\n\ts_nop 1" : "+v"(a), "+v"(b)); }
__device__ __forceinline__ float sum_x16_x32(float x) {
    float a = x, b = x; swap16(a, b); x = a + b;
    a = x; b = x; swap32(a, b); return a + b;
}
__device__ __forceinline__ float fast_exp2(float x) { return __builtin_amdgcn_exp2f(x); }
__device__ __forceinline__ float sigmoidf_(float x) { return 1.0f / (1.0f + __expf(-x)); }

#define XB_TMO      128
#define XB_XCNT(j)  (256  + 64 * (j))
#define XB_XSUB(j)  (1280 + 64 * (j))
#define XB_XGEN(j)  (2304 + 64 * (j))
#define XB_TOP      3328
#define XB_TOPGEN   3392
#define XCD_BAR_WORDS 3456
#define XB_SPIN_CAP (1u << 22)
__device__ __forceinline__ unsigned xb_ld(unsigned* p)              { return __hip_atomic_load(p, __ATOMIC_RELAXED, __HIP_MEMORY_SCOPE_AGENT); }
__device__ __forceinline__ unsigned xb_add(unsigned* p, unsigned v) { return __hip_atomic_fetch_add(p, v, __ATOMIC_RELAXED, __HIP_MEMORY_SCOPE_AGENT); }
__device__ __forceinline__ unsigned xb_xcc_id() { return (unsigned)__builtin_amdgcn_s_getreg((3 << 11) | 20) & 0xFu; }
#define XB_SPIN(cond, bar) do { unsigned _sp = 0; while (cond) { __builtin_amdgcn_s_sleep(1); \
    if ((++_sp & 255u) == 0u) { if (xb_ld(&(bar)[XB_TMO])) break; if (_sp > XB_SPIN_CAP) { atomicAdd(&(bar)[XB_TMO], 1u); break; } } } } while (0)
__device__ __forceinline__ int lane_now() { int l; asm volatile("v_mbcnt_lo_u32_b32 %0, -1, 0\n\tv_mbcnt_hi_u32_b32 %0, -1, %0" : "=v"(l)); return l; }
struct XcdBarrier { unsigned* bar; unsigned x; volatile LAS unsigned* st; int wv; };
__device__ __forceinline__ XcdBarrier xcd_barrier_post(unsigned* bar, volatile LAS unsigned* st) {
    XcdBarrier b; b.bar = bar; b.x = xb_xcc_id(); b.st = st; b.wv = __builtin_amdgcn_readfirstlane((int)threadIdx.x >> 6);
    if (threadIdx.x == 0) (void)xb_add(&bar[XB_XCNT(b.x)], 1u);
    return b;
}
__device__ __forceinline__ void xcd_barrier_complete(unsigned* bar, unsigned x, unsigned& nloc, unsigned& nx) {
    const unsigned G = gridDim.x * gridDim.y * gridDim.z;
    unsigned sum, cnt, mine, sp = 0u;
    for (;;) {
        sum = 0u; cnt = 0u; mine = 0u;
#pragma unroll
        for (unsigned j = 0; j < 16; ++j) { const unsigned c = xb_ld(&bar[XB_XCNT(j)]); sum += c; cnt += (c > 0u) ? 1u : 0u; mine = (j == x) ? c : mine; }
        if (sum == G) break;
        __builtin_amdgcn_s_sleep(1);
        if ((++sp & 255u) == 0u) { if (xb_ld(&bar[XB_TMO])) break; if (sp > XB_SPIN_CAP) { atomicAdd(&bar[XB_TMO], 1u); break; } }
    }
    nloc = mine > 0u ? mine : 1u; nx = cnt > 0u ? cnt : 1u;
}
#define XB_LSUB(j)  (3584 + 64 * (j))
#define XB_LGEN(j)  (4608 + 64 * (j))
__device__ __forceinline__ void xcd_local_barrier(const XcdBarrier& b) {
    asm volatile("s_waitcnt vmcnt(0)" ::: "memory");
    __syncthreads();
    if (b.wv == 0 && lane_now() == 0) {
        unsigned* bar = b.bar;
        __builtin_amdgcn_s_waitcnt(0);
        unsigned nloc = b.st[0], nx = b.st[1];
        if (nloc == 0u) { xcd_barrier_complete(bar, b.x, nloc, nx); b.st[0] = nloc; b.st[1] = nx; }
        const unsigned old = xb_add(&bar[XB_LSUB(b.x)], 1u);
        const unsigned gen = old / nloc;
        if (old + 1u == (gen + 1u) * nloc) xb_add(&bar[XB_LGEN(b.x)], 1u);
        else XB_SPIN(xb_ld(&bar[XB_LGEN(b.x)]) == gen, bar);
        __builtin_amdgcn_fence(__ATOMIC_ACQUIRE, "agent");
        asm volatile("s_waitcnt vmcnt(0)" ::: "memory");
    }
    __syncthreads();
}
__device__ __forceinline__ void xcd_barrier(const XcdBarrier& b) {
    asm volatile("s_waitcnt vmcnt(0)" ::: "memory");
    __syncthreads();
    if (b.wv == 0 && lane_now() == 0) {
        unsigned* bar = b.bar;
        __builtin_amdgcn_s_waitcnt(0);
        unsigned nloc = b.st[0], nx = b.st[1];
        if (nloc == 0u) { xcd_barrier_complete(bar, b.x, nloc, nx); b.st[0] = nloc; b.st[1] = nx; }
        const unsigned old = xb_add(&bar[XB_XSUB(b.x)], 1u);
        const unsigned gen = old / nloc;
        if (old + 1u == (gen + 1u) * nloc) {
            __builtin_amdgcn_fence(__ATOMIC_RELEASE, "agent");
            asm volatile("s_waitcnt vmcnt(0)" ::: "memory");
            const unsigned og = xb_add(&bar[XB_TOP], 1u);
            const unsigned tg = og / nx;
            if (og + 1u == (tg + 1u) * nx) xb_add(&bar[XB_TOPGEN], 1u);
            else XB_SPIN(xb_ld(&bar[XB_TOPGEN]) == tg, bar);
            __builtin_amdgcn_fence(__ATOMIC_ACQUIRE, "agent");
            xb_add(&bar[XB_XGEN(b.x)], 1u);
            asm volatile("s_waitcnt vmcnt(0)" ::: "memory");
        } else {
            XB_SPIN(xb_ld(&bar[XB_XGEN(b.x)]) == gen, bar);
            __builtin_amdgcn_fence(__ATOMIC_ACQUIRE, "agent");
            asm volatile("s_waitcnt vmcnt(0)" ::: "memory");
        }
    }
    __syncthreads();
}

namespace pg8 {
constexpr int BM = 256, BK = 64, HALF = 128, HTB = HALF * BK * 2, STAGE_BYTES = 8 * HTB;
__host__ __device__ __forceinline__ int lds_byte(int r, int c) { const int st = (r >> 4) * 2 + (c >> 5), rr = r & 15, cc = c & 31, ob = rr * 64 + cc * 2; return st * 1024 + (ob ^ (((ob >> 9) & 1) << 5)); }
__host__ __device__ __forceinline__ void stage_rc(int b, int& R, int& C) { const int st = b / 1024, sb = b % 1024, swz = sb ^ (((sb >> 9) & 1) << 5); R = (st >> 1) * 16 + swz / 64; C = (st & 1) * 32 + (swz % 64) / 2; }
__host__ __device__ __forceinline__ int perm32(int rho) { const int n = rho >> 4, i = rho & 15; return 8 * (i >> 2) + 4 * n + (i & 3); }

struct Unit { int pm, pn, e, hf; };
struct Gemm { const bf16* A; const bf16* Bt; int lda; int K; size_t b_estride; };

template <bool GATHER, class Epi, class Sched>
__device__ __forceinline__ void gemm_phase(LAS unsigned char* lds, const Gemm g, const Sched& S, const Epi& E, int wv) {
    int tid_ = wv * 64 + lane_now(); asm volatile("" : "+v"(tid_));
    const int tid = tid_, wid = __builtin_amdgcn_readfirstlane(tid >> 6), lane = tid & 63, wr = wid >> 2, wc = wid & 3, fr = lane & 15, fq = lane >> 4;
    const int K = g.K, nt = K / BK;
    int Rst[2], Cst[2]; unsigned voffB[2], voffA[2];
#pragma unroll
    for (int i = 0; i < 2; ++i) { int R, C; stage_rc(tid * 16 + i * 8192, R, C); Rst[i] = R; Cst[i] = C; const int Rb = Epi::PERM ? ((R & ~31) + perm32(R & 31)) : R; voffB[i] = (unsigned)(Rb * K + C) * 2u; voffA[i] = (unsigned)(R * g.lda + C) * 2u; }
    const size_t kstep = (size_t)(BK * 2);
    const size_t hstepB = (size_t)HALF * K * 2, hstepA = (size_t)HALF * g.lda * 2;
    const unsigned ldsw = (unsigned)wid * 1024u;
    const int aoff = lds_byte(wr * 64 + fr, fq * 8), boff = lds_byte(wc * 32 + fr, fq * 8);
#define PG8_SA(b, h) (((b) * 2 + (h)) * HTB)
#define PG8_SB(b, h) ((4 + (b) * 2 + (h)) * HTB)
#define PG8_STAGE(bufoff, gbase, v0, v1) do { \
        __builtin_amdgcn_global_load_lds((const unsigned*)((const char*)(gbase) + (v0)), (LAS unsigned*)(lds + (bufoff) + ldsw), 16, 0, 0); \
        __builtin_amdgcn_global_load_lds((const unsigned*)((const char*)(gbase) + (v1)), (LAS unsigned*)(lds + (bufoff) + ldsw + 8192), 16, 0, 0); } while (0)
#define PG8_STB(bufoff, gbase) PG8_STAGE(bufoff, gbase, voffB[0], voffB[1])
#define PG8_STA_CUR(bufoff, gbase, h) do { if constexpr (GATHER) PG8_STAGE(bufoff, gbase, vc[h][0], vc[h][1]); else PG8_STAGE(bufoff, (gbase) + (h) * hstepA, voffA[0], voffA[1]); } while (0)
#define PG8_STA_SEL(bufoff, gbase, h) do { if constexpr (GATHER) PG8_STAGE(bufoff, gbase, vs[h][0], vs[h][1]); else PG8_STAGE(bufoff, (gbase) + (h) * hstepA, voffA[0], voffA[1]); } while (0)
#define PG8_LDA(dst, b, h) do { _Pragma("unroll") for (int m = 0; m < 4; ++m) _Pragma("unroll") for (int k = 0; k < 2; ++k) dst[m][k] = *(const LAS bf16x8*)(lds + PG8_SA(b, h) + aoff + m * 2048 + k * 1024); } while (0)
#define PG8_LDB(dst, b, h) do { _Pragma("unroll") for (int n = 0; n < 2; ++n) _Pragma("unroll") for (int k = 0; k < 2; ++k) dst[n][k] = *(const LAS bf16x8*)(lds + PG8_SB(b, h) + boff + n * 2048 + k * 1024); } while (0)
#define PG8_MMA(ai, bj, At, Bt) do { __builtin_amdgcn_s_setprio(1); _Pragma("unroll") for (int m = 0; m < 4; ++m) _Pragma("unroll") for (int n = 0; n < 2; ++n) _Pragma("unroll") for (int k = 0; k < 2; ++k) \
        acc[ai][bj][m][n] = __builtin_amdgcn_mfma_f32_16x16x32_bf16(Bt[n][k], At[m][k], acc[ai][bj][m][n], 0, 0, 0); __builtin_amdgcn_s_setprio(0); } while (0)
#define PG8_WAIT_V(n) asm volatile("s_waitcnt vmcnt(" #n ")" ::: "memory")
#define PG8_WAIT_L(n) asm volatile("s_waitcnt lgkmcnt(" #n ")" ::: "memory")
#define PG8_BAR __builtin_amdgcn_s_barrier()
#define PG8_SCHED __builtin_amdgcn_sched_barrier(0)
    Unit cur, nxt; int ui = 0;
    if (!S.next(0, cur)) return;
    f32x4 acc[2][2][4][2];
#pragma unroll
    for (int a = 0; a < 2; ++a)
#pragma unroll
        for (int b = 0; b < 2; ++b)
#pragma unroll
            for (int m = 0; m < 4; ++m)
#pragma unroll
                for (int n = 0; n < 2; ++n) acc[a][b][m][n] = (f32x4){0.f, 0.f, 0.f, 0.f};
    bf16x8 At[4][2], B0[2][2], B1[2][2];
    unsigned vc[2][2], vn[2][2];
    if constexpr (GATHER) S.a_off(cur, Rst, Cst, g.lda, vc);
    const char* cA = S.a_base(cur, g); const char* cB = (const char*)g.Bt + (size_t)cur.e * g.b_estride + (size_t)cur.pn * 2 * hstepB;
    PG8_STB(PG8_SB(0, 0), cB); PG8_STB(PG8_SB(0, 1), cB + hstepB); PG8_STA_CUR(PG8_SA(0, 0), cA, 0); PG8_STA_CUR(PG8_SA(0, 1), cA, 1);
    if (wr == 1) PG8_BAR;
    PG8_WAIT_V(2); PG8_BAR;
    PG8_STB(PG8_SB(1, 0), cB + kstep); PG8_STA_CUR(PG8_SA(1, 0), cA + kstep, 0); PG8_STB(PG8_SB(1, 1), cB + hstepB + kstep);
    PG8_WAIT_V(6); PG8_BAR;
    for (;;) {
        const bool has_next = S.next(ui + 1, nxt);
        const char* nA = cA; const char* nB = cB;
        if constexpr (GATHER) {
#pragma unroll
            for (int h = 0; h < 2; ++h) { vn[h][0] = vc[h][0]; vn[h][1] = vc[h][1]; } }
        if (has_next) { nA = S.a_base(nxt, g); nB = (const char*)g.Bt + (size_t)nxt.e * g.b_estride + (size_t)nxt.pn * 2 * hstepB; if constexpr (GATHER) S.a_off(nxt, Rst, Cst, g.lda, vn); }
        float pre[8];
        if constexpr (Epi::HAS_PRE) E.pre(cur, wr, fr, pre);
        if (HALF_MMA && Sched::HAS_HALF && cur.hf) {
#pragma nounroll
        for (int t = 0; t < nt; t += 2) {
            const bool last = (t == nt - 2);
            const char* a1 = cA + (size_t)(t + 1) * kstep;
            const char* a2 = last ? nA : cA + (size_t)(t + 2) * kstep; const char* b2 = last ? nB : cB + (size_t)(t + 2) * kstep;
            const char* a3 = a2 + kstep; const char* b3 = b2 + kstep;
            unsigned vs[2][2];
            if constexpr (GATHER) { vs[0][0] = last ? vn[0][0] : vc[0][0]; vs[0][1] = last ? vn[0][1] : vc[0][1]; vs[1][0] = last ? vn[1][0] : vc[1][0]; vs[1][1] = last ? vn[1][1] : vc[1][1]; }
            PG8_LDB(B0, 0, 0); PG8_LDB(B1, 0, 1); PG8_SCHED; PG8_LDA(At, 0, 0); PG8_STA_CUR(PG8_SA(1, 1), a1, 1);
            PG8_WAIT_V(8); PG8_WAIT_L(0); PG8_BAR; PG8_MMA(0, 0, At, B0); PG8_MMA(0, 1, At, B1); PG8_BAR; PG8_SCHED;
            PG8_LDA(At, 0, 1); PG8_STB(PG8_SB(0, 0), b2); PG8_STB(PG8_SB(0, 1), b2 + hstepB); PG8_STA_SEL(PG8_SA(0, 0), a2, 0);
            PG8_WAIT_V(8); PG8_WAIT_L(0); PG8_BAR;  PG8_BAR; PG8_SCHED;
            PG8_LDB(B0, 1, 0); PG8_LDB(B1, 1, 1); PG8_SCHED; PG8_LDA(At, 1, 0); PG8_STA_SEL(PG8_SA(0, 1), a2, 1);
            PG8_WAIT_V(8); PG8_WAIT_L(0); PG8_BAR; PG8_MMA(0, 0, At, B0); PG8_MMA(0, 1, At, B1); PG8_BAR; PG8_SCHED;
            PG8_LDA(At, 1, 1); PG8_STB(PG8_SB(1, 0), b3); PG8_STB(PG8_SB(1, 1), b3 + hstepB); PG8_STA_SEL(PG8_SA(1, 0), a3, 0);
            PG8_WAIT_V(8); PG8_WAIT_L(0); PG8_BAR;  PG8_BAR; PG8_SCHED;
        }
        } else {
#pragma nounroll
        for (int t = 0; t < nt; t += 2) {
            const bool last = (t == nt - 2);
            const char* a1 = cA + (size_t)(t + 1) * kstep;
            const char* a2 = last ? nA : cA + (size_t)(t + 2) * kstep; const char* b2 = last ? nB : cB + (size_t)(t + 2) * kstep;
            const char* a3 = a2 + kstep; const char* b3 = b2 + kstep;
            unsigned vs[2][2];
            if constexpr (GATHER) { vs[0][0] = last ? vn[0][0] : vc[0][0]; vs[0][1] = last ? vn[0][1] : vc[0][1]; vs[1][0] = last ? vn[1][0] : vc[1][0]; vs[1][1] = last ? vn[1][1] : vc[1][1]; }
            PG8_LDB(B0, 0, 0); PG8_LDB(B1, 0, 1); PG8_SCHED; PG8_LDA(At, 0, 0); PG8_STA_CUR(PG8_SA(1, 1), a1, 1);
            PG8_WAIT_V(8); PG8_WAIT_L(0); PG8_BAR; PG8_MMA(0, 0, At, B0); PG8_MMA(0, 1, At, B1); PG8_BAR; PG8_SCHED;
            PG8_LDA(At, 0, 1); PG8_STB(PG8_SB(0, 0), b2); PG8_STB(PG8_SB(0, 1), b2 + hstepB); PG8_STA_SEL(PG8_SA(0, 0), a2, 0);
            PG8_WAIT_V(8); PG8_WAIT_L(0); PG8_BAR; PG8_MMA(1, 0, At, B0); PG8_MMA(1, 1, At, B1); PG8_BAR; PG8_SCHED;
            PG8_LDB(B0, 1, 0); PG8_LDB(B1, 1, 1); PG8_SCHED; PG8_LDA(At, 1, 0); PG8_STA_SEL(PG8_SA(0, 1), a2, 1);
            PG8_WAIT_V(8); PG8_WAIT_L(0); PG8_BAR; PG8_MMA(0, 0, At, B0); PG8_MMA(0, 1, At, B1); PG8_BAR; PG8_SCHED;
            PG8_LDA(At, 1, 1); PG8_STB(PG8_SB(1, 0), b3); PG8_STB(PG8_SB(1, 1), b3 + hstepB); PG8_STA_SEL(PG8_SA(1, 0), a3, 0);
            PG8_WAIT_V(8); PG8_WAIT_L(0); PG8_BAR; PG8_MMA(1, 0, At, B0); PG8_MMA(1, 1, At, B1); PG8_BAR; PG8_SCHED;
        }
        }
        if (wr == 0) PG8_BAR;
        if constexpr (Epi::HAS_PRE) E.apply(acc, cur, wr, wc, fr, fq, pre); else E(acc, cur, wr, wc, fr, fq);
        if (!has_next) break;
#pragma unroll
        for (int a = 0; a < 2; ++a)
#pragma unroll
            for (int b = 0; b < 2; ++b)
#pragma unroll
                for (int m = 0; m < 4; ++m)
#pragma unroll
                    for (int n = 0; n < 2; ++n) acc[a][b][m][n] = (f32x4){0.f, 0.f, 0.f, 0.f};
        cur = nxt; cA = nA; cB = nB; ++ui;
        if constexpr (GATHER) {
#pragma unroll
            for (int h = 0; h < 2; ++h) { vc[h][0] = vn[h][0]; vc[h][1] = vn[h][1]; } }
        if (wr == 1) PG8_BAR;
    }
    PG8_WAIT_V(0);
    PG8_BAR;
#undef PG8_SA
#undef PG8_SB
#undef PG8_STAGE
#undef PG8_STB
#undef PG8_STA_CUR
#undef PG8_STA_SEL
#undef PG8_LDA
#undef PG8_LDB
#undef PG8_MMA
#undef PG8_WAIT_V
#undef PG8_WAIT_L
#undef PG8_BAR
#undef PG8_SCHED
}

struct DenseOrder {
    static constexpr bool HAS_HALF = false;
    int nM, nN, nwg, G, c, e;
    __device__ void init(int M, int N, int G_, int c_) { nM = M / BM; nN = N / BM; nwg = nM * nN; G = G_; c = c_; e = 0; }
    __device__ __forceinline__ bool next(int i, Unit& u) const {
        const long L = (long)i * G + c; if (L >= nwg) return false;
        int wgid = (int)L; { const int q = nwg / 8, r = nwg % 8, xcd = wgid % 8, off = wgid / 8; wgid = (xcd < r ? xcd * (q + 1) : r * (q + 1) + (xcd - r) * q) + off; }
        const int nig = 8 * nN, gid = wgid / nig, fm = gid * 8, gsz = (nM - fm) < 8 ? (nM - fm) : 8;
        u.pm = fm + ((wgid % nig) % gsz); u.pn = (wgid % nig) / gsz; u.e = e; u.hf = 0; return true;
    }
    __device__ __forceinline__ const char* a_base(const Unit& u, const Gemm& g) const { return (const char*)g.A + (size_t)u.pm * 256 * g.lda * 2; }
    __device__ __forceinline__ void a_off(const Unit&, const int (&R)[2], const int (&C)[2], int lda, unsigned (&v)[2][2]) const {
#pragma unroll
        for (int h = 0; h < 2; ++h)
#pragma unroll
            for (int i = 0; i < 2; ++i) v[h][i] = (unsigned)((h * 128 + R[i]) * lda + C[i]) * 2u;
    }
};
struct OwnOrder {
    static constexpr bool HAS_HALF = false;
    unsigned long long own; int nN, n;
    __device__ __forceinline__ bool next(int i, Unit& u) const {
        if (i >= n) return false;
        unsigned long long m = own; const int k = i / nN;
        for (int j = 0; j < k; ++j) m &= m - 1ull;
        u.pm = __builtin_ctzll(m); u.pn = i % nN; u.e = 0; u.hf = 0; return true;
    }
    __device__ __forceinline__ const char* a_base(const Unit& u, const Gemm& g) const { return (const char*)g.A + (size_t)u.pm * 256 * g.lda * 2; }
    __device__ __forceinline__ void a_off(const Unit&, const int (&R)[2], const int (&C)[2], int lda, unsigned (&v)[2][2]) const {
#pragma unroll
        for (int h = 0; h < 2; ++h)
#pragma unroll
            for (int i = 0; i < 2; ++i) v[h][i] = (unsigned)((h * 128 + R[i]) * lda + C[i]) * 2u;
    }
};
}

struct Args {
    const float* in[23]; float* out; unsigned char* ws; int ph_lo, ph_hi;
};
enum { I_X = 0, I_POS, I_WIN, I_WOUT, I_KVN, I_WUK, I_WUV, I_CLAM, I_CSUB, I_DCONV, I_DALOG, I_DDT, I_DNORM, I_LN1G, I_LN1B, I_WR, I_BR, I_WGU, I_BGU, I_WDN, I_BDN, I_LN2G, I_LN2B };

struct Frame {
    LAS unsigned char* lds; int tid, lane, wave, G, vcu, wv; unsigned char* ws; unsigned* ctl;
};
#define CAS __attribute__((address_space(4)))
__device__ __forceinline__ const CAS Args& kargs() { const CAS Args* p = (const CAS Args*)__builtin_amdgcn_kernarg_segment_ptr(); asm volatile("" : "+s"(p)); return *p; }
__device__ __forceinline__ void frame_refresh(Frame& F) { int t = F.wv * 64 + lane_now(); asm volatile("" : "+v"(t)); F.tid = t; F.lane = t & 63; F.wave = __builtin_amdgcn_readfirstlane(t >> 6); }

__device__ __forceinline__ void cvt_item(const float* W, int ldw, int k0, bf16* dst, int Kdst, int r0, int srccol, float scale, const float* kscale, LAS float* scr, int lane) {
#pragma unroll
    for (int kk = 0; kk < 64; ++kk) {
        float v = 0.f;
        if (srccol >= 0) v = __builtin_nontemporal_load(W + (size_t)(k0 + kk) * ldw + srccol) * scale;
        if (kscale) v *= kscale[k0 + kk];
        scr[kk * 65 + lane] = v;
    }
    asm volatile("s_waitcnt lgkmcnt(0)" ::: "memory");
    const int c = lane & 7;
#pragma unroll
    for (int j = 0; j < 8; ++j) {
        const int n = (lane >> 3) + 8 * j; const LAS float* s = scr + (8 * c) * 65 + n;
        u32x4 o; o.x = pk2(s[0], s[65]); o.y = pk2(s[2 * 65], s[3 * 65]); o.z = pk2(s[4 * 65], s[5 * 65]); o.w = pk2(s[6 * 65], s[7 * 65]);
        *(u32x4*)(dst + (size_t)(r0 + n) * Kdst + k0 + 8 * c) = o;
    }
    asm volatile("s_waitcnt lgkmcnt(0)" ::: "memory");
}

__device__ __forceinline__ bool inproj_is_rot(int g) { return (g >= 8 && g < 12) || (g >= 16 && g < 26) || (g >= 27 && g < 35) || (g >= 51 && g < 67); }
__device__ __forceinline__ void inproj_map(int r, int& sc, float& scale) {
    const int g = r >> 6; int p = r & 63; scale = 1.f;
    if (inproj_is_rot(g)) p = (p >> 1) + 32 * (p & 1);
    const float qa = 0.07216878364870322f * LOG2E;
    if (g < 8) { const int h = g >> 1; sc = SC_AQ + h * 192 + (g & 1) * 64 + p; scale = qa; }
    else if (g < 12) { sc = SC_AQ + (g - 8) * 192 + 128 + p; scale = qa; }
    else if (g < 16) sc = SC_CKV + (g - 12) * 64 + p;
    else if (g == 16) sc = SC_AKR + p;
    else if (g == 17) sc = SC_AIK + p;
    else if (g < 26) sc = SC_AIQ + (g - 18) * 64 + p;
    else if (g == 26) { sc = p < 8 ? SC_AIW + p : -1; scale = 0.04419417382415922f; }
    else if (g < 31) sc = SC_BQ + (g - 27) * 64 + p;
    else if (g < 35) { sc = SC_BK + (g - 31) * 64 + p; scale = 0.125f; }
    else if (g < 43) sc = SC_BV + (g - 35) * 64 + p;
    else if (g < 51) sc = SC_BG + (g - 43) * 64 + p;
    else if (g < 59) { sc = SC_CQ + (g - 51) * 64 + p; scale = 0.125f * LOG2E; }
    else if (g < 67) sc = SC_CK + (g - 59) * 64 + p;
    else if (g < 75) sc = SC_CV + (g - 67) * 64 + p;
    else if (g < 99) sc = SC_DQKV + (g - 75) * 64 + p;
    else if (g < 107) sc = SC_DZ + (g - 99) * 64 + p;
    else sc = p < 8 ? SC_DB + p : -1;
}

struct CvtP { const float* W; int ldw, k0; bf16* dst; int Kdst, r0, srccol; float scale; const float* ks; };
__device__ __forceinline__ void phase_prologue(Frame& F, const CAS Args& a) {
    LAS float* scr = (LAS float*)(F.lds + F.wave * 16640);
    const int gw = F.vcu * NWAVES + F.wave, NGW = F.G * NWAVES;
    bf16* Win = (bf16*)(F.ws + WS_WIN); bf16* Wkv = (bf16*)(F.ws + WS_WKV); bf16* Wout = (bf16*)(F.ws + WS_WOUT); bf16* Wgu = (bf16*)(F.ws + WS_WGU); bf16* Wdn = (bf16*)(F.ws + WS_WDN);
    constexpr int I_IN = DEPTH * (NP / 64) * (DM / 64);
    constexpr int I_KV = DEPTH * (1024 / 64) * (256 / 64);
    constexpr int I_OUT = DEPTH * (DM / 64) * (DM / 64);
    constexpr int I_GU = DEPTH * NE * (1024 / 64) * (DM / 64);
    constexpr int I_DN = DEPTH * NE * (DM / 64) * (DFF / 64);
    constexpr int NITEMS = I_IN + I_KV + I_OUT + I_GU + I_DN;
    auto decode = [&](int it, CvtP& p) {
        int r = it;
        if (r < I_IN) { const int l = r / ((NP / 64) * 32), q = r % ((NP / 64) * 32), rb = q / 32, kb = q % 32; int sc; float s; inproj_map(rb * 64 + F.lane, sc, s);
            p = CvtP{a.in[I_WIN] + (size_t)l * DM * INTOT, INTOT, kb * 64, Win + (size_t)l * NP * DM, DM, rb * 64, sc, s, nullptr}; return; }
        r -= I_IN;
        if (r < I_KV) { const int l = r / 64, q = r % 64, rb = q / 4, kb = q % 4; const int row = rb * 64 + F.lane;
            const float* src = (row < 512 ? a.in[I_WUK] : a.in[I_WUV]) + (size_t)l * 256 * 512;
            p = CvtP{src, 512, kb * 64, Wkv + (size_t)l * 1024 * 256, 256, rb * 64, row & 511, 1.f, a.in[I_KVN] + l * 256}; return; }
        r -= I_KV;
        if (r < I_OUT) { const int l = r / 1024, q = r % 1024, rb = q / 32, kb = q % 32;
            p = CvtP{a.in[I_WOUT] + (size_t)l * DM * DM, DM, kb * 64, Wout + (size_t)l * DM * DM, DM, rb * 64, rb * 64 + F.lane, 1.f, nullptr}; return; }
        r -= I_OUT;
        if (r < I_GU) { const int le = r / 512, q = r % 512, rb = q / 32, kb = q % 32; const int row = rb * 64 + F.lane;
            p = CvtP{a.in[I_WGU] + (size_t)le * DM * 1024, 1024, kb * 64, Wgu + (size_t)le * 1024 * DM, DM, rb * 64, (row >> 1) + 512 * (row & 1), 1.f, nullptr}; return; }
        r -= I_GU;
        { const int le = r / 256, q = r % 256, rb = q / 8, kb = q % 8;
            p = CvtP{a.in[I_WDN] + (size_t)le * DFF * DM, DM, kb * 64, Wdn + (size_t)le * DM * DFF, DFF, rb * 64, rb * 64 + F.lane, 1.f, nullptr}; }
    };
    CvtP pc; float rv[64];
    auto loadraw = [&](const CvtP& p) {
#pragma unroll
        for (int kk = 0; kk < 64; ++kk) rv[kk] = (p.srccol >= 0) ? __builtin_nontemporal_load(p.W + (size_t)(p.k0 + kk) * p.ldw + p.srccol) : 0.f;
    };
    int it = gw;
    if (it < NITEMS) { decode(it, pc); loadraw(pc); }
    while (it < NITEMS) {
#pragma unroll
        for (int kk = 0; kk < 64; ++kk) { float v = rv[kk] * pc.scale; if (pc.ks) v *= pc.ks[pc.k0 + kk]; scr[kk * 65 + F.lane] = v; }
        asm volatile("s_waitcnt lgkmcnt(0)" ::: "memory");
        const int nx = it + NGW; CvtP pn = pc;
        if (nx < NITEMS) { decode(nx, pn); loadraw(pn); }
        const int c = F.lane & 7;
#pragma unroll
        for (int j = 0; j < 8; ++j) {
            const int n = (F.lane >> 3) + 8 * j; const LAS float* sp = scr + (8 * c) * 65 + n;
            u32x4 o; o.x = pk2(sp[0], sp[65]); o.y = pk2(sp[2 * 65], sp[3 * 65]); o.z = pk2(sp[4 * 65], sp[5 * 65]); o.w = pk2(sp[6 * 65], sp[7 * 65]);
            *(u32x4*)(pc.dst + (size_t)(pc.r0 + n) * pc.Kdst + pc.k0 + 8 * c) = o;
        }
        asm volatile("s_waitcnt lgkmcnt(0)" ::: "memory");
        pc = pn; it = nx;
    }
    {
        const f32x4* x4 = (const f32x4*)a.in[I_X]; u32x2* xb = (u32x2*)(F.ws + WS_XB);
        const size_t n4 = (size_t)NTOK * DM / 4;
        const size_t stride = (size_t)F.G * NTHR;
        for (size_t i0 = (size_t)(F.vcu * NTHR + F.tid); i0 < n4; i0 += 8 * stride) {
            f32x4 v[8];
#pragma unroll
            for (int u = 0; u < 8; ++u) { const size_t i = i0 + u * stride; v[u] = (i < n4) ? __builtin_nontemporal_load(x4 + i) : (f32x4){0.f, 0.f, 0.f, 0.f}; }
#pragma unroll
            for (int u = 0; u < 8; ++u) { const size_t i = i0 + u * stride; if (i < n4) { u32x2 o; o.x = pk2(v[u].x, v[u].y); o.y = pk2(v[u].z, v[u].w); xb[i] = o; } }
        }
    }
    {
        const int* pos = (const int*)a.in[I_POS]; f32x2* cs = (f32x2*)(F.ws + WS_CS);
        for (int i = F.vcu * NTHR + F.tid; i < NTOK * 32; i += F.G * NTHR) {
            const int tok = i >> 5, j = i & 31; const double inv = exp2(-(double)j * (13.287712379549449 / 32.0));
            const float angf = (float)pos[tok] * (float)inv;
            double s, c; sincos((double)angf, &s, &c); cs[i] = (f32x2){(float)c, (float)s};
        }
    }
}

__host__ __device__ __forceinline__ int vperm32(int k) { return 8 * ((k >> 2) & 3) + 4 * (k >> 4) + (k & 3); }
struct EpiInProj {
    static constexpr bool PERM = true, HAS_PRE = false;
    bf16* P; const f32x2* cs; float* gb; float* iw; float* ssq; const float* a_log; const float* dt_bias;
    __device__ __forceinline__ void operator()(const f32x4 (&acc)[2][2][4][2], const pg8::Unit& u, int wr, int wc, int fr, int fq) const {
        const int row0 = u.pm * 256 + wr * 64 + fr;
#pragma unroll
        for (int bj = 0; bj < 2; ++bj) {
            const int c0 = u.pn * 256 + bj * 128 + wc * 32 + 8 * fq; const int g = c0 >> 6;
            if (inproj_is_rot(g)) {
                const int j0 = (c0 & 63) >> 1;
#pragma unroll
                for (int ai = 0; ai < 2; ++ai) {
                    f32x4 csa[4], csb[4];
#pragma unroll
                    for (int m = 0; m < 4; ++m) { const int row = row0 + ai * 128 + m * 16; csa[m] = *(const f32x4*)(cs + (size_t)row * 32 + j0); csb[m] = *(const f32x4*)(cs + (size_t)row * 32 + j0 + 2); }
#pragma unroll
                    for (int m = 0; m < 4; ++m) {
                        const int row = row0 + ai * 128 + m * 16; const f32x4 v0 = acc[ai][bj][m][0], v1 = acc[ai][bj][m][1];
                        const f32x4 cs01 = csa[m], cs23 = csb[m];
                        const float a0 = v0.x * cs01.x - v0.y * cs01.y, b0 = v0.y * cs01.x + v0.x * cs01.y;
                        const float a1 = v0.z * cs01.z - v0.w * cs01.w, b1 = v0.w * cs01.z + v0.z * cs01.w;
                        const float a2 = v1.x * cs23.x - v1.y * cs23.y, b2 = v1.y * cs23.x + v1.x * cs23.y;
                        const float a3 = v1.z * cs23.z - v1.w * cs23.w, b3 = v1.w * cs23.z + v1.z * cs23.w;
                        bf16* rp = P + (size_t)row * NP + (g << 6) + j0;
                        u32x2 lo, hi; lo.x = pk2(a0, a1); lo.y = pk2(a2, a3); hi.x = pk2(b0, b1); hi.y = pk2(b2, b3);
                        *(u32x2*)rp = lo; *(u32x2*)(rp + 32) = hi;
                    }
                    asm volatile("" ::: "memory");
                }
            } else {
#pragma unroll
                for (int ai = 0; ai < 2; ++ai)
#pragma unroll
                    for (int m = 0; m < 4; ++m) {
                        const int row = row0 + ai * 128 + m * 16; const f32x4 v0 = acc[ai][bj][m][0], v1 = acc[ai][bj][m][1];
                        u32x4 w; w.x = pk2(v0.x, v0.y); w.y = pk2(v0.z, v0.w); w.z = pk2(v1.x, v1.y); w.w = pk2(v1.z, v1.w);
                        *(u32x4*)(P + (size_t)row * NP + c0) = w;
                        if (g == 26 && (c0 & 63) == 0) { *(f32x4*)(iw + (size_t)row * 8) = v0; *(f32x4*)(iw + (size_t)row * 8 + 4) = v1; }
                        if (g == 107 && (c0 & 63) == 0) {
                            f32x4 be, gg;
#pragma unroll
                            for (int h = 0; h < 4; ++h) { be[h] = sigmoidf_(v0[h]); const float z = v1[h] + dt_bias[h]; const float ez = __expf(z); const float sp = z > 20.f ? z : (ez < 1e-4f ? ez * (1.f - 0.5f * ez) : __logf(1.f + ez));     gg[h] = -__expf(a_log[h]) * sp; }
                            *(f32x4*)(gb + (size_t)row * 8) = be; *(f32x4*)(gb + (size_t)row * 8 + 4) = gg;
                        }
                        asm volatile("" ::: "memory");
                    }
            }
        }
        if (u.pn == 3) {
#pragma unroll
            for (int ai = 0; ai < 2; ++ai)
#pragma unroll
                for (int m = 0; m < 4; ++m) {
                    float s = 0.f;
#pragma unroll
                    for (int bj = 0; bj < 2; ++bj)
#pragma unroll
                        for (int n = 0; n < 2; ++n) { const f32x4 v = acc[ai][bj][m][n]; s += (v.x * v.x + v.y * v.y) + (v.z * v.z + v.w * v.w); }
                    s = sum_x16_x32(s);
                    if (fq == 0) ssq[(size_t)(row0 + ai * 128 + m * 16) * 4 + wc] = s;
                }
        }
    }
};

struct EpiKvUp {
    static constexpr bool PERM = true, HAS_PRE = false;
    bf16* KN; bf16* VAT; const float* ssq;
    __device__ __forceinline__ void operator()(const f32x4 (&acc)[2][2][4][2], const pg8::Unit& u, int wr, int wc, int fr, int fq) const {
        const int row0 = u.pm * 256 + wr * 64 + fr;
        if (u.pn < 2) {
#pragma unroll
            for (int ai = 0; ai < 2; ++ai)
#pragma unroll
                for (int m = 0; m < 4; ++m) {
                    const int row = row0 + ai * 128 + m * 16; const f32x4 q = *(const f32x4*)(ssq + (size_t)row * 4);
                    const float rstd = 1.0f / sqrtf(((q.x + q.y) + (q.z + q.w)) * (1.f / 256.f) + RMS_EPS);
#pragma unroll
                    for (int bj = 0; bj < 2; ++bj) {
                        const int c0 = u.pn * 256 + bj * 128 + wc * 32 + 8 * fq; const f32x4 v0 = acc[ai][bj][m][0] * rstd, v1 = acc[ai][bj][m][1] * rstd;
                        u32x4 w; w.x = pk2(v0.x, v0.y); w.y = pk2(v0.z, v0.w); w.z = pk2(v1.x, v1.y); w.w = pk2(v1.z, v1.w); *(u32x4*)(KN + (size_t)row * 512 + c0) = w;
                    }
                    asm volatile("" ::: "memory");
                }
        } else {
            const int b = u.pm >> 3;
#pragma unroll
            for (int ai = 0; ai < 2; ++ai)
#pragma unroll
                for (int m = 0; m < 4; ++m) {
                    const int row = row0 + ai * 128 + m * 16; const f32x4 q = *(const f32x4*)(ssq + (size_t)row * 4);
                    const float rstd = 1.0f / sqrtf(((q.x + q.y) + (q.z + q.w)) * (1.f / 256.f) + RMS_EPS);
                    const int s = (row & 2047 & ~31) | vperm32(row & 31);
#pragma unroll
                    for (int bj = 0; bj < 2; ++bj) {
                        const int c = (u.pn - 2) * 256 + bj * 128 + wc * 32 + 8 * fq; const f32x4 v0 = acc[ai][bj][m][0] * rstd, v1 = acc[ai][bj][m][1] * rstd;
                        GAS bf16* vp = (GAS bf16*)(VAT + ((size_t)b * 512 + c) * SEQ + s);
#pragma unroll
                        for (int j = 0; j < 8; ++j) { *vp = (bf16)f2bf(j < 4 ? v0[j & 3] : v1[j & 3]); vp += SEQ; asm volatile("" : "+v"(vp)); }
                    }
                    asm volatile("" ::: "memory");
                }
        }
    }
};

struct EpiOutProj {
    static constexpr bool PERM = true, HAS_PRE = false;
    const bf16* XB; bf16* RB;
    __device__ __forceinline__ void operator()(const f32x4 (&acc)[2][2][4][2], const pg8::Unit& u, int wr, int wc, int fr, int fq) const {
        const int row0 = u.pm * 256 + wr * 64 + fr, col0 = u.pn * 256 + wc * 32 + 8 * fq;
#pragma unroll
        for (int ai = 0; ai < 2; ++ai) {
            u32x4 xr[4][2];
#pragma unroll
            for (int m = 0; m < 4; ++m) { const size_t off = (size_t)(row0 + ai * 128 + m * 16) * DM + col0; xr[m][0] = *(const u32x4*)(XB + off); xr[m][1] = *(const u32x4*)(XB + off + 128); }
#pragma unroll
            for (int m = 0; m < 4; ++m) { const size_t off = (size_t)(row0 + ai * 128 + m * 16) * DM + col0;
#pragma unroll
                for (int bj = 0; bj < 2; ++bj) { const u32x4 xw = xr[m][bj]; const f32x4 a0 = acc[ai][bj][m][0], a1 = acc[ai][bj][m][1];
                    u32x4 w; w.x = pk2(bflo(xw.x) * DN_ALPHA + a0.x, bfhi(xw.x) * DN_ALPHA + a0.y); w.y = pk2(bflo(xw.y) * DN_ALPHA + a0.z, bfhi(xw.y) * DN_ALPHA + a0.w);
                    w.z = pk2(bflo(xw.z) * DN_ALPHA + a1.x, bfhi(xw.z) * DN_ALPHA + a1.y); w.w = pk2(bflo(xw.w) * DN_ALPHA + a1.z, bfhi(xw.w) * DN_ALPHA + a1.w);
                    *(u32x4*)(RB + off + bj * 128) = w; } }
            asm volatile("" ::: "memory"); }
    }
};

struct EpiGU {
    static constexpr bool PERM = true, HAS_PRE = false;
    bf16* ACT; const float* bgu;
    __device__ __forceinline__ void operator()(const f32x4 (&acc)[2][2][4][2], const pg8::Unit& u, int wr, int wc, int fr, int fq) const {
        const int row0 = u.pm * 256 + wr * 64 + fr; const float* bb = bgu + (size_t)u.e * 1024;
#pragma unroll
        for (int bj = 0; bj < 2; ++bj) {
            const int c0 = u.pn * 256 + bj * 128 + wc * 32 + 8 * fq, j0 = c0 >> 1;
            const f32x4 bg = *(const f32x4*)(bb + j0), bl = *(const f32x4*)(bb + 512 + j0);
#pragma unroll
            for (int ai = 0; ai < 2; ++ai) {
                if (HALF_EPI && ai == 1 && u.hf) break;
#pragma unroll
                for (int m = 0; m < 4; ++m) {
                    const f32x4 v0 = acc[ai][bj][m][0], v1 = acc[ai][bj][m][1];
                    const float gl[4] = {v0.x + bg.x, v0.z + bg.y, v1.x + bg.z, v1.z + bg.w}, li[4] = {v0.y + bl.x, v0.w + bl.y, v1.y + bl.z, v1.w + bl.w}; float o[4];
#pragma unroll
                    for (int j = 0; j < 4; ++j) { const float gcl = fminf(gl[j], 7.0f), lcl = fminf(fmaxf(li[j], -7.0f), 7.0f); o[j] = gcl * sigmoidf_(1.702f * gcl) * (lcl + 1.0f); }
                    u32x2 w; w.x = pk2(o[0], o[1]); w.y = pk2(o[2], o[3]);
                    *(u32x2*)(ACT + (size_t)(row0 + ai * 128 + m * 16) * DFF + j0) = w;
                    asm volatile("" ::: "memory");
                }
            }
        }
    }
};

struct EpiDN {
    static constexpr bool PERM = true, HAS_PRE = true;
    bf16* Y; const float* bdn; const float* lgate; const int* cnt; const LAS int* pstart;
    __device__ __forceinline__ void pre(const pg8::Unit& u, int wr, int fr, float (&gt)[8]) const {
        const int row0 = u.pm * 256 + wr * 64 + fr; const int ps = pstart[u.e], ce = cnt[u.e];
#pragma unroll
        for (int ai = 0; ai < 2; ++ai)
#pragma unroll
            for (int m = 0; m < 4; ++m) { const int slot = row0 + ai * 128 + m * 16 - ps; gt[ai * 4 + m] = slot < ce ? lgate[(size_t)u.e * NTOK + slot] : 0.f; }
    }
    __device__ __forceinline__ void apply(const f32x4 (&acc)[2][2][4][2], const pg8::Unit& u, int wr, int wc, int fr, int fq, const float (&gt)[8]) const {
        const int row0 = u.pm * 256 + wr * 64 + fr; const float* bb = bdn + (size_t)u.e * DM;
        f32x4 bv[2][2];
#pragma unroll
        for (int bj = 0; bj < 2; ++bj) { const int c0 = u.pn * 256 + bj * 128 + wc * 32 + 8 * fq; bv[bj][0] = *(const f32x4*)(bb + c0); bv[bj][1] = *(const f32x4*)(bb + c0 + 4); }
#pragma unroll
        for (int ai = 0; ai < 2; ++ai) {
            if (HALF_EPI && ai == 1 && u.hf) break;
#pragma unroll
            for (int m = 0; m < 4; ++m) {
                const int row = row0 + ai * 128 + m * 16; const float g_ = gt[ai * 4 + m];
#pragma unroll
                for (int bj = 0; bj < 2; ++bj) {
                    const int c0 = u.pn * 256 + bj * 128 + wc * 32 + 8 * fq;
                    const f32x4 v0 = (acc[ai][bj][m][0] + bv[bj][0]) * g_, v1 = (acc[ai][bj][m][1] + bv[bj][1]) * g_;
                    u32x4 w; w.x = pk2(v0.x, v0.y); w.y = pk2(v0.z, v0.w); w.z = pk2(v1.x, v1.y); w.w = pk2(v1.z, v1.w);
                    *(u32x4*)(Y + (size_t)row * DM + c0) = w;
                }
                asm volatile("" ::: "memory");
            }
        }
    }
};

template <bool GATHER>
struct MoeOrder {
    static constexpr bool HAS_HALF = true;
    int nN, nwg, G, c; const LAS unsigned short* tord; const LAS int* pstart; const int* cnt; const int* ltok;
    __device__ __forceinline__ bool next(int i, pg8::Unit& u) const {
        const long L = (long)i * G + c; if (L >= nwg) return false;
        const unsigned o = tord[(int)L / nN]; u.pm = (int)(o & 511u); u.pn = (int)L % nN; u.e = (int)((o >> 9) & 31u); u.hf = (int)(o >> 15); return true;
    }
    __device__ __forceinline__ const char* a_base(const pg8::Unit& u, const pg8::Gemm& g) const { return GATHER ? (const char*)g.A : (const char*)g.A + (size_t)u.pm * 256 * g.lda * 2; }
    __device__ __forceinline__ void a_off(const pg8::Unit& u, const int (&R)[2], const int (&C)[2], int lda, unsigned (&v)[2][2]) const {
        if (GATHER) {
            const int ps = pstart[u.e], ce = cnt[u.e];
#pragma unroll
            for (int h = 0; h < 2; ++h)
#pragma unroll
                for (int i = 0; i < 2; ++i) { const int slot = u.pm * 256 + h * 128 + R[i] - ps; const int tok = slot < ce ? ltok[(size_t)u.e * NTOK + slot] : 0; v[h][i] = (unsigned)(tok * lda + C[i]) * 2u; }
        } else {
#pragma unroll
            for (int h = 0; h < 2; ++h)
#pragma unroll
                for (int i = 0; i < 2; ++i) v[h][i] = (unsigned)((h * 128 + R[i]) * lda + C[i]) * 2u;
        }
    }
};

__device__ __forceinline__ int moe_tables(Frame& F, const int* cnt, LAS int* pstart, LAS unsigned short* tord) {
    frame_refresh(F);
    LAS int* wcnt = pstart + 40;
    if (F.tid == 0) { int acc = 0; for (int e = 0; e < NE; ++e) { pstart[e] = acc; acc += (cnt[e] + 255) / 256 * 256; } pstart[NE] = acc; }
    __syncthreads();
    const int ntiles = pstart[NE] / 256; const int t = F.tid; const bool vt = t < ntiles; int e = 0; bool hf = false;
    if (vt) { while (pstart[e + 1] <= t * 256) ++e; hf = (cnt[e] - (t * 256 - pstart[e])) <= 128; }
    const unsigned long long bh = __ballot(vt && hf);
    if (F.lane == 0) wcnt[F.wave] = (int)__popcll(bh);
    __syncthreads();
    int hb = 0, htot = 0;
#pragma unroll
    for (int w = 0; w < NWAVES; ++w) { const int c = wcnt[w]; hb += (w < F.wave) ? c : 0; htot += c; }
    const int hrank = hb + (int)__popcll(bh & ((1ull << F.lane) - 1ull));
    if (vt) { const int pos = hf ? (ntiles - htot) + hrank : t - hrank; tord[pos] = (unsigned short)(t | (e << 9) | ((hf ? 1 : 0) << 15)); }
    __syncthreads();
    return ntiles;
}

__device__ __forceinline__ void ln_stats(const f32x4 (&v)[8], float& mean, float& rstd) {
    float s = 0.f;
#pragma unroll
    for (int j = 0; j < 8; ++j) s += (v[j].x + v[j].y) + (v[j].z + v[j].w);
    mean = wave_sum(s) * (1.f / DM); float q = 0.f;
#pragma unroll
    for (int j = 0; j < 8; ++j) { const f32x4 d = v[j] - mean; q += (d.x * d.x + d.y * d.y) + (d.z * d.z + d.w * d.w); }
    rstd = 1.0f / sqrtf(wave_sum(q) * (1.f / DM) + LN_EPS);
}

__device__ __forceinline__ void ln_stats32(const float (&v)[4][8], float& mean, float& rstd) {
    float s = 0.f;
#pragma unroll
    for (int j = 0; j < 4; ++j)
#pragma unroll
        for (int t = 0; t < 8; ++t) s += v[j][t];
    mean = wave_sum(s) * (1.f / DM); float q = 0.f;
#pragma unroll
    for (int j = 0; j < 4; ++j)
#pragma unroll
        for (int t = 0; t < 8; ++t) { const float d = v[j][t] - mean; q += d * d; }
    rstd = 1.0f / sqrtf(wave_sum(q) * (1.f / DM) + LN_EPS);
}
__device__ __forceinline__ void unpack8(const u32x4 w, float (&o)[8]) { o[0] = bflo(w.x); o[1] = bfhi(w.x); o[2] = bflo(w.y); o[3] = bfhi(w.y); o[4] = bflo(w.z); o[5] = bfhi(w.z); o[6] = bflo(w.w); o[7] = bfhi(w.w); }
__device__ __forceinline__ void phase_ln1_router(Frame& F, const CAS Args& a, int l) {
    frame_refresh(F);
    const bf16* RB = (const bf16*)(F.ws + WS_R); bf16* HB = (bf16*)(F.ws + WS_HB);
    const float* g1 = a.in[I_LN1G] + l * DM; const float* b1 = a.in[I_LN1B] + l * DM;
    const float* Wr = a.in[I_WR] + (size_t)l * DM * NE; const float* br = a.in[I_BR] + l * NE;
    int* ecnt = (int*)(F.ctl + CW_ECNT + l * 64); int* ltok = (int*)(F.ws + WS_LTOK); float* lgate = (float*)(F.ws + WS_LGATE); int* tslot = (int*)(F.ws + WS_TSLOT);
    LAS float* img = (LAS float*)F.lds;
    LAS float* red = (LAS float*)F.lds;
    constexpr int IST = 2052;
    float wb0[64], wb1[64];
    { const float* wp = Wr + (size_t)(F.wave * 256 + 4 * (F.lane >> 4)) * NE + (F.lane & 15);
#pragma unroll
      for (int sx = 0; sx < 64; ++sx) { const float* q = wp + (size_t)(16 * (sx >> 2) + (sx & 3)) * NE; wb0[sx] = q[0]; wb1[sx] = q[16]; } }
    LAS float* lgt = (LAS float*)(F.lds + 131584);
    u32x4 pr[2][4];
    auto fetch = [&](int un) {
#pragma unroll
        for (int rr = 0; rr < 2; ++rr)
#pragma unroll
            for (int j = 0; j < 4; ++j) pr[rr][j] = __builtin_nontemporal_load((const u32x4*)(RB + (size_t)(un * 16 + F.wave * 2 + rr) * DM + (64 * j + F.lane) * 8));
    };
    const bool aff1 = (F.G % 8 == 0); const int cpg1 = aff1 ? F.G / 8 : F.G; const int ustep = cpg1;
    const int ufirst = aff1 ? (F.vcu / cpg1) * 128 + F.vcu % cpg1 : F.vcu; const int uend = aff1 ? (F.vcu / cpg1) * 128 + 128 : NTOK / 16;
    if (ufirst < uend) fetch(ufirst);
    for (int unit = ufirst; unit < uend; unit += ustep) {
        const int r0 = unit * 16;
#pragma unroll
        for (int rr = 0; rr < 2; ++rr) {
            const int lr = F.wave * 2 + rr, row = r0 + lr; float v[4][8];
#pragma unroll
            for (int j = 0; j < 4; ++j) unpack8(pr[rr][j], v[j]);
            float mean, rstd; ln_stats32(v, mean, rstd);
#pragma unroll
            for (int j = 0; j < 4; ++j) { const int c = (64 * j + F.lane) * 8; const f32x4 ga = *(const f32x4*)(g1 + c), gb = *(const f32x4*)(g1 + c + 4), ba = *(const f32x4*)(b1 + c), bb = *(const f32x4*)(b1 + c + 4);
                const f32x4 y0 = ((f32x4){v[j][0], v[j][1], v[j][2], v[j][3]} - mean) * rstd * ga + ba, y1 = ((f32x4){v[j][4], v[j][5], v[j][6], v[j][7]} - mean) * rstd * gb + bb;
                u32x4 w; w.x = pk2(y0.x, y0.y); w.y = pk2(y0.z, y0.w); w.z = pk2(y1.x, y1.y); w.w = pk2(y1.z, y1.w); *(u32x4*)(HB + (size_t)row * DM + c) = w;
                *(LAS f32x4*)(img + lr * IST + c) = y0; *(LAS f32x4*)(img + lr * IST + c + 4) = y1; }
        }
        asm volatile("" ::: "memory");
        if (unit + ustep < uend) fetch(unit + ustep);
        __syncthreads();
        f32x4 acc0 = {0.f, 0.f, 0.f, 0.f}, acc1 = {0.f, 0.f, 0.f, 0.f};
        const int lm = lane_now();
        { const LAS float* ap = img + (lm & 15) * IST + F.wave * 256 + 4 * (lm >> 4);
#pragma unroll
            for (int s4 = 0; s4 < 16; ++s4) { const f32x4 av = *(const LAS f32x4*)(ap + 16 * s4);
#pragma unroll
                for (int t = 0; t < 4; ++t) { acc0 = __builtin_amdgcn_mfma_f32_16x16x4f32(av[t], wb0[4 * s4 + t], acc0, 0, 0, 0); acc1 = __builtin_amdgcn_mfma_f32_16x16x4f32(av[t], wb1[4 * s4 + t], acc1, 0, 0, 0); } } }
        __syncthreads();
#pragma unroll
        for (int i = 0; i < 4; ++i) { const int rw = 4 * (lm >> 4) + i; red[(F.wave * 16 + rw) * 32 + (lm & 15)] = acc0[i]; red[(F.wave * 16 + rw) * 32 + 16 + (lm & 15)] = acc1[i]; }
        __syncthreads();
        { const int tq = F.wave * 64 + lm; const int rw = tq >> 5, e = tq & 31; float s = br[e];
#pragma unroll
            for (int w = 0; w < 8; ++w) s += red[(w * 16 + rw) * 32 + e];
            lgt[tq] = s; }
        __syncthreads();
        if (F.wave == 0) {
            int ln = lm; asm volatile("" : "+v"(ln));
            const int row = ln >> 2, part = ln & 3; const LAS float* lg = lgt + row * 32 + part * 8;
            float v[8];
#pragma unroll
            for (int t = 0; t < 8; ++t) v[t] = lg[t];
            float tv[4]; int te[4];
#pragma unroll
            for (int k = 0; k < 4; ++k) {
                float best = -INFINITY; int bi = 99;
#pragma unroll
                for (int t = 0; t < 8; ++t) if (v[t] > best) { best = v[t]; bi = part * 8 + t; }
#pragma unroll
                for (int off = 1; off <= 2; off <<= 1) { const int bb_ = __builtin_bit_cast(int, best); const float ob = __builtin_bit_cast(float, off == 1 ? __builtin_amdgcn_update_dpp(0, bb_, 0xB1, 0xf, 0xf, true) : __builtin_amdgcn_update_dpp(0, bb_, 0x4E, 0xf, 0xf, true)); const int oi = off == 1 ? __builtin_amdgcn_update_dpp(0, bi, 0xB1, 0xf, 0xf, true) : __builtin_amdgcn_update_dpp(0, bi, 0x4E, 0xf, 0xf, true); if (ob > best || (ob == best && oi < bi)) { best = ob; bi = oi; } }
                tv[k] = best; te[k] = bi;
#pragma unroll
                for (int t = 0; t < 8; ++t) if (part * 8 + t == bi) v[t] = -INFINITY;
            }
            const float e1 = __expf(tv[1] - tv[0]), e2 = __expf(tv[2] - tv[0]), e3 = __expf(tv[3] - tv[0]); const float inv = 1.0f / (1.0f + e1 + e2 + e3);
            const int me = part == 0 ? te[0] : part == 1 ? te[1] : part == 2 ? te[2] : te[3];
            const float mg = part == 0 ? inv : part == 1 ? e1 * inv : part == 2 ? e2 * inv : e3 * inv;
            const int tok = r0 + row;
            unsigned long long same = 0ull;
#pragma unroll 8
            for (int e = 0; e < NE; ++e) { const unsigned long long bm = __ballot(me == e); if (me == e) same = bm; }
            const int leader = __ffsll((long long)same) - 1; const int rank = (int)__popcll(same & ((1ull << ln) - 1ull));
            int base = 0;
            if (ln == leader) base = __hip_atomic_fetch_add(ecnt + me, (int)__popcll(same), RLX_AGENT);
            base = __builtin_amdgcn_ds_bpermute(leader << 2, base);
            const int slot = base + rank;
            ltok[(size_t)me * NTOK + slot] = tok; lgate[(size_t)me * NTOK + slot] = mg; tslot[tok * 4 + part] = (me << 16) | slot;
        }
    }
    __syncthreads();
}

__device__ __forceinline__ void phase_ln2(Frame& F, const CAS Args& a, int l) {
    frame_refresh(F);
    const bf16* HB = (const bf16*)(F.ws + WS_HB); const bf16* Y = (const bf16*)(F.ws + WS_Y); const int* tslot = (const int*)(F.ws + WS_TSLOT);
    const int* ecnt = (const int*)(F.ctl + CW_ECNT + l * 64);
    float* XO = a.out; bf16* XB = (bf16*)(F.ws + WS_XB);
    const float* g2 = a.in[I_LN2G] + l * DM; const float* b2 = a.in[I_LN2B] + l * DM;
    LAS int* pstart = (LAS int*)(F.lds);
    if (F.tid == 0) { int acc = 0; for (int e = 0; e < NE; ++e) { pstart[e] = acc; acc += (ecnt[e] + 255) / 256 * 256; } }
    __syncthreads();
    f32x4 gq[4][2], bq[4][2];
#pragma unroll
    for (int j = 0; j < 4; ++j) { const int c = (64 * j + F.lane) * 8; gq[j][0] = *(const f32x4*)(g2 + c); gq[j][1] = *(const f32x4*)(g2 + c + 4); bq[j][0] = *(const f32x4*)(b2 + c); bq[j][1] = *(const f32x4*)(b2 + c + 4); }
    const bool aff2 = (F.G % 8 == 0); const int cpg2 = aff2 ? F.G / 8 : F.G;
    const int rstride = cpg2 * NWAVES; const int rend = aff2 ? (F.vcu / cpg2) * SEQ + SEQ : NTOK;
    int row = aff2 ? (F.vcu / cpg2) * SEQ + (F.vcu % cpg2) * NWAVES + F.wave : F.vcu * NWAVES + F.wave;
    int4 tsn = {0, 0, 0, 0};
    u32x4 dh[4], dy[4][4];
    auto issue = [&](int r, const int4& ts) {
        const int tsv[4] = {ts.x, ts.y, ts.z, ts.w};
#pragma unroll
        for (int j = 0; j < 4; ++j) dh[j] = __builtin_nontemporal_load((const u32x4*)(HB + (size_t)r * DM + (64 * j + F.lane) * 8));
#pragma unroll
        for (int k = 0; k < 4; ++k) { const size_t yr = (size_t)(pstart[tsv[k] >> 16] + (tsv[k] & 0xffff)) * DM;
#pragma unroll
            for (int j = 0; j < 4; ++j) dy[k][j] = __builtin_nontemporal_load((const u32x4*)(Y + yr + (64 * j + F.lane) * 8)); }
    };
    if (row < rend) { const int4 ts0 = *(const int4*)(tslot + row * 4); if (row + rstride < rend) tsn = *(const int4*)(tslot + (row + rstride) * 4); issue(row, ts0); }
    for (; row < rend; row += rstride) {
        float v[4][8];
#pragma unroll
        for (int j = 0; j < 4; ++j) { unpack8(dh[j], v[j]);
#pragma unroll
            for (int t = 0; t < 8; ++t) v[j][t] *= DN_ALPHA; }
#pragma unroll
        for (int k = 0; k < 4; ++k)
#pragma unroll
            for (int j = 0; j < 4; ++j) { float y[8]; unpack8(dy[k][j], y);
#pragma unroll
                for (int t = 0; t < 8; ++t) v[j][t] += y[t]; }
        asm volatile("" ::: "memory"); __builtin_amdgcn_sched_barrier(0);
        if (row + rstride < rend) { issue(row + rstride, tsn); if (row + 2 * rstride < rend) tsn = *(const int4*)(tslot + (row + 2 * rstride) * 4); }
        asm volatile("" ::: "memory"); __builtin_amdgcn_sched_barrier(0);
        float mean, rstd; ln_stats32(v, mean, rstd);
#pragma unroll
        for (int j = 0; j < 4; ++j) { const int c = (64 * j + F.lane) * 8; const f32x4 ga = gq[j][0], gb = gq[j][1], ba = bq[j][0], bb = bq[j][1];
            const f32x4 y0 = ((f32x4){v[j][0], v[j][1], v[j][2], v[j][3]} - mean) * rstd * ga + ba, y1 = ((f32x4){v[j][4], v[j][5], v[j][6], v[j][7]} - mean) * rstd * gb + bb;
            if (l == DEPTH - 1) { *(f32x4*)(XO + (size_t)row * DM + c) = y0; *(f32x4*)(XO + (size_t)row * DM + c + 4) = y1; }
            else { u32x4 w; w.x = pk2(y0.x, y0.y); w.y = pk2(y0.z, y0.w); w.z = pk2(y1.x, y1.y); w.w = pk2(y1.z, y1.w); *(u32x4*)(XB + (size_t)row * DM + c) = w; } }
    }
    __syncthreads();
}

__device__ __forceinline__ f32x4 mma16(f32x4 acc, const LAS bf16* A, int lda, const LAS bf16* B, int ldb, int K, int lane) {
    const LAS bf16* ap = A + (lane & 15) * lda + 8 * (lane >> 4); const LAS bf16* bp = B + (lane & 15) * ldb + 8 * (lane >> 4);
    for (int k = 0; k < K; k += 32) acc = __builtin_amdgcn_mfma_f32_16x16x32_bf16(*(const LAS bf16x8*)(ap + k), *(const LAS bf16x8*)(bp + k), acc, 0, 0, 0);
    return acc;
}
__device__ __forceinline__ float ret_lg2gamma(int h) { return log2f(1.0f - exp2f(-5.0f - (float)h)); }

__device__ __forceinline__ void ret_stage1(Frame& F, int unit) {
    const int b = unit >> 6, h = (unit >> 4) & 3, n = unit & 15; const int tok0 = b * SEQ + n * 128;
    const bf16* P = (const bf16*)(F.ws + WS_P); float* BKV = (float*)(F.ws + WS_BKV) + (size_t)unit * 8192;
    LAS bf16* KT = (LAS bf16*)F.lds;
    LAS bf16* VT = KT + 64 * 136;
    const float lg = ret_lg2gamma(h);
#pragma unroll
    for (int ps = 0; ps < 2; ++ps) { const int i_ = F.tid + 512 * ps, c = i_ & 127, ch = i_ >> 7;
        const u32x4 w = *(const u32x4*)(P + (size_t)(tok0 + c) * NP + PC_BK + 64 * h + 8 * ch);
        const float sc = fast_exp2(lg * (float)(127 - c)); const unsigned ww[4] = {w.x, w.y, w.z, w.w};
#pragma unroll
        for (int j = 0; j < 4; ++j) { KT[(8 * ch + 2 * j) * 136 + c] = (bf16)f2bf(bflo(ww[j]) * sc); KT[(8 * ch + 2 * j + 1) * 136 + c] = (bf16)f2bf(bfhi(ww[j]) * sc); } }
#pragma unroll
    for (int ps = 0; ps < 4; ++ps) { const int i_ = F.tid + 512 * ps, c = i_ & 127, ch = i_ >> 7; const u32x4 w = *(const u32x4*)(P + (size_t)(tok0 + c) * NP + PC_BV + 128 * h + 8 * ch);
        const unsigned ww[4] = {w.x, w.y, w.z, w.w};
#pragma unroll
        for (int j = 0; j < 4; ++j) { VT[(8 * ch + 2 * j) * 136 + c] = (bf16)(ww[j] & 0xffffu); VT[(8 * ch + 2 * j + 1) * 136 + c] = (bf16)(ww[j] >> 16); } }
    __syncthreads();
    const int dt = F.wave & 3, e0 = (F.wave >> 2) * 4;
#pragma unroll
    for (int et = 0; et < 4; ++et) {
        f32x4 acc = {0.f, 0.f, 0.f, 0.f};
        acc = mma16(acc, KT + dt * 16 * 136, 136, VT + (e0 + et) * 16 * 136, 136, 128, F.lane);
        *(f32x4*)(BKV + (size_t)((e0 + et) * 16 + (F.lane & 15)) * 64 + dt * 16 + 4 * (F.lane >> 4)) = acc;
    }
    __syncthreads();
}

__device__ __forceinline__ void ret_stage2(Frame& F, int unit) {
    const int b = unit >> 6, h = (unit >> 4) & 3, n = unit & 15; const int tok0 = b * SEQ + n * 128;
    const bf16* P = (const bf16*)(F.ws + WS_P); const float* BKV = (const float*)(F.ws + WS_BKV) + (size_t)(unit - n) * 8192; bf16* HEADS = (bf16*)(F.ws + WS_HEADS);
    LAS bf16* Qs = (LAS bf16*)F.lds;
    LAS bf16* Ks = Qs + 128 * 72;
    LAS bf16* VT = Ks + 128 * 72;
    LAS bf16* SC = VT + 128 * 136;
    LAS bf16* PT = SC + 128 * 136;
    const float lg = ret_lg2gamma(h);
#pragma unroll
    for (int ps = 0; ps < 2; ++ps) { const int c = (F.tid >> 3) + 64 * ps, ch = F.tid & 7; const size_t ro = (size_t)(tok0 + c) * NP;
        *(LAS u32x4*)(Qs + c * 72 + 8 * ch) = *(const u32x4*)(P + ro + PC_BQ + 64 * h + 8 * ch); *(LAS u32x4*)(Ks + c * 72 + 8 * ch) = *(const u32x4*)(P + ro + PC_BK + 64 * h + 8 * ch); }
#pragma unroll
    for (int ps = 0; ps < 4; ++ps) { const int i_ = F.tid + 512 * ps, c = i_ & 127, ch = i_ >> 7; const u32x4 w = *(const u32x4*)(P + (size_t)(tok0 + c) * NP + PC_BV + 128 * h + 8 * ch);
        const unsigned ww[4] = {w.x, w.y, w.z, w.w};
#pragma unroll
        for (int j = 0; j < 4; ++j) { VT[(8 * ch + 2 * j) * 136 + c] = (bf16)(ww[j] & 0xffffu); VT[(8 * ch + 2 * j + 1) * 136 + c] = (bf16)(ww[j] >> 16); } }
    {
        float z_ = 0.f; asm volatile("" : "+v"(z_));
#pragma unroll
        for (int ps = 0; ps < 4; ++ps) { const int idx = (F.tid + 512 * ps) * 4; f32x4 s = {z_, z_, z_, z_};
            for (int m = 0; m < n; ++m) { const float wgt = fast_exp2(lg * 128.0f * (float)(n - 1 - m)); s += *(const f32x4*)(BKV + (size_t)m * 8192 + idx) * wgt; }
            const int e = idx >> 6, d = idx & 63; u32x2 w; w.x = pk2(s.x, s.y); w.y = pk2(s.z, s.w); *(LAS u32x2*)(PT + e * 72 + d) = w; }
    }
    __syncthreads();
    const int w = F.wave, li = F.lane & 15, g = F.lane >> 4;
    for (int jt = 0; jt <= (w | 1); ++jt) {
        f32x4 acc = {0.f, 0.f, 0.f, 0.f};
        if (jt <= w) acc = mma16(acc, Ks + jt * 16 * 72, 72, Qs + w * 16 * 72, 72, 64, F.lane);
        const int i = 16 * w + li; float v[4];
#pragma unroll
        for (int r = 0; r < 4; ++r) { const int j = 16 * jt + 4 * g + r; v[r] = (j <= i) ? acc[r] * fast_exp2(lg * (float)(i - j)) : 0.f; }
        u32x2 pw; pw.x = pk2(v[0], v[1]); pw.y = pk2(v[2], v[3]); *(LAS u32x2*)(SC + i * 136 + 16 * jt + 4 * g) = pw;
    }
    asm volatile("s_waitcnt lgkmcnt(0)" ::: "memory");
    const int kext = 16 * ((w | 1) + 1);
    const int tok = tok0 + 16 * w + li; const float fin = fast_exp2(lg * (float)(16 * w + li + 1));
    f32x4 o[8]; float ss = 0.f;
#pragma unroll
    for (int et = 0; et < 8; ++et) {
        f32x4 a1 = {0.f, 0.f, 0.f, 0.f}, a2 = {0.f, 0.f, 0.f, 0.f};
        a1 = mma16(a1, VT + et * 16 * 136, 136, SC + w * 16 * 136, 136, kext, F.lane);
        a2 = mma16(a2, PT + et * 16 * 72, 72, Qs + w * 16 * 72, 72, 64, F.lane);
        o[et] = a1 + a2 * fin; ss += (o[et].x * o[et].x + o[et].y * o[et].y) + (o[et].z * o[et].z + o[et].w * o[et].w);
    }
    ss = sum_x16_x32(ss);
    const float rstd = 1.0f / sqrtf(ss * (1.f / 128.f) + RMS_EPS);
#pragma unroll
    for (int et = 0; et < 8; ++et) { const int e = 16 * et + 4 * g; const u32x2 gw = *(const u32x2*)(P + (size_t)tok * NP + PC_BG + 128 * h + e);
        const float g0 = bflo(gw.x), g1 = bfhi(gw.x), g2 = bflo(gw.y), g3 = bfhi(gw.y);
        u32x2 ow; ow.x = pk2(o[et].x * rstd * g0 * sigmoidf_(g0), o[et].y * rstd * g1 * sigmoidf_(g1)); ow.y = pk2(o[et].z * rstd * g2 * sigmoidf_(g2), o[et].w * rstd * g3 * sigmoidf_(g3));
        *(u32x2*)(HEADS + (size_t)tok * DM + 512 + 128 * h + e) = ow; }
    __syncthreads();
}

__device__ __forceinline__ float rowmax4(float x) {
    float a = x, b = x; swap16(a, b); x = fmaxf(a, b);
    a = x; b = x; swap32(a, b); return fmaxf(a, b);
}
struct AttnSrc { const bf16* q0; const bf16* q1; const bf16* k0; const bf16* k1; int sq0, sq1, sk0, sk1; const bf16* vt; const unsigned long long* mask; };
template <int D0, int D1, bool MASK, int RG>
__device__ __forceinline__ void attn_unit(Frame& F, const AttnSrc& A, int qb0  , f32x4 (&ot)[RG][8]) {
    constexpr int DK = D0 + D1, KST = DK + 8, NKS = DK / 32, KCH = DK / 8;
    constexpr int KBUF = 64 * KST, VBUF = 128 * 72;
    LAS bf16* Kl = (LAS bf16*)F.lds;
    LAS bf16* Vl = Kl + 2 * KBUF;
    const int w = F.wave, li = F.lane & 15, g = F.lane >> 4;
    const int qw0 = qb0 + 16 * RG * w;
    bf16x8 qf[RG][NKS];
#pragma unroll
    for (int r = 0; r < RG; ++r)
#pragma unroll
        for (int ks = 0; ks < NKS; ++ks) { const int d = 32 * ks + 8 * g; const int qpos = qw0 + 16 * r + li;
            if constexpr (D1 == 0) qf[r][ks] = *(const bf16x8*)(A.q0 + (size_t)qpos * A.sq0 + d);
            else qf[r][ks] = (d < D0) ? *(const bf16x8*)(A.q0 + (size_t)qpos * A.sq0 + d) : *(const bf16x8*)(A.q1 + (size_t)qpos * A.sq1 + (d - D0)); }
    float m_run[RG], l_run[RG];
#pragma unroll
    for (int r = 0; r < RG; ++r) { m_run[r] = -INFINITY; l_run[r] = 0.f;
#pragma unroll
        for (int et = 0; et < 8; ++et) ot[r][et] = (f32x4){0.f, 0.f, 0.f, 0.f}; }
    const int nkt = (qb0 + 128 * RG) / 64;
    constexpr int NKL = (64 * KCH + NTHR - 1) / NTHR;
    u32x4 kreg[NKL], vreg[2]; unsigned long long mreg[RG], mcur[RG];
#pragma unroll
    for (int r = 0; r < RG; ++r) { mreg[r] = 0ull; mcur[r] = 0ull; }
    auto issue = [&](int kt) {
#pragma unroll
        for (int i = 0; i < NKL; ++i) { const int c = F.tid + i * NTHR; if (c < 64 * KCH) { const int rr = c / KCH, ch = c % KCH, d = 8 * ch; const int key = 64 * kt + rr;
            if constexpr (D1 == 0) kreg[i] = *(const u32x4*)(A.k0 + (size_t)key * A.sk0 + d);
            else kreg[i] = (d < D0) ? *(const u32x4*)(A.k0 + (size_t)key * A.sk0 + d) : *(const u32x4*)(A.k1 + (size_t)key * A.sk1 + (d - D0)); } }
#pragma unroll
        for (int i = 0; i < 2; ++i) { const int c = F.tid + i * NTHR, e = c >> 3, ch = c & 7; vreg[i] = *(const u32x4*)(A.vt + (size_t)e * SEQ + 64 * kt + 8 * ch); }
        if (MASK) {
#pragma unroll
            for (int r = 0; r < RG; ++r) mreg[r] = A.mask[(size_t)(qw0 + 16 * r + li) * 32 + kt]; }
    };
    auto commit = [&](int buf) {
#pragma unroll
        for (int i = 0; i < NKL; ++i) { const int c = F.tid + i * NTHR; if (c < 64 * KCH) { const int rr = c / KCH, ch = c % KCH; *(LAS u32x4*)(Kl + buf * KBUF + rr * KST + 8 * ch) = kreg[i]; } }
#pragma unroll
        for (int i = 0; i < 2; ++i) { const int c = F.tid + i * NTHR, e = c >> 3, ch = c & 7; *(LAS u32x4*)(Vl + buf * VBUF + e * 72 + 8 * ch) = vreg[i]; }
    };
    issue(0); commit(0);
#pragma unroll
    for (int r = 0; r < RG; ++r) mcur[r] = mreg[r];
    __syncthreads();
    for (int kt = 0; kt < nkt; ++kt) {
        const int buf = kt & 1;
        if (kt + 1 < nkt) issue(kt + 1);
        if (64 * kt <= qw0 + 16 * RG - 1) {
            const LAS bf16* Kb = Kl + buf * KBUF; const LAS bf16* Vb = Vl + buf * VBUF;
            const bool diag = (64 * kt + 63 > qw0);
            f32x4 st[RG][4];
            unsigned nmw[RG][2];
            if constexpr (MASK) {
#pragma unroll
                for (int r = 0; r < RG; ++r) { nmw[r][0] = ~(unsigned)mcur[r] >> (4 * g); nmw[r][1] = ~(unsigned)(mcur[r] >> 32) >> (4 * g); } }
#pragma unroll
            for (int t4 = 0; t4 < 4; ++t4) {
#pragma unroll
                for (int r = 0; r < RG; ++r) {
                    if constexpr (MASK) {
#pragma unroll
                        for (int c = 0; c < 4; ++c) st[r][t4][c] = __builtin_bit_cast(float, __builtin_amdgcn_sbfe((int)nmw[r][t4 >> 1], 16 * (t4 & 1) + c, 1) & (int)0xff800000);
                    } else st[r][t4] = (f32x4){0.f, 0.f, 0.f, 0.f};
                }
#pragma unroll
                for (int ks = 0; ks < NKS; ++ks) { const bf16x8 kf = *(const LAS bf16x8*)(Kb + (16 * t4 + li) * KST + 32 * ks + 8 * g);
#pragma unroll
                    for (int r = 0; r < RG; ++r) st[r][t4] = __builtin_amdgcn_mfma_f32_16x16x32_bf16(kf, qf[r][ks], st[r][t4], 0, 0, 0); } }
            __builtin_amdgcn_sched_barrier(0);
            bf16x8 pf[RG][2]; float alpha[RG]; bool resc = false;
#pragma unroll
            for (int r = 0; r < RG; ++r) {
                const int qpos = qw0 + 16 * r + li; float mx = -INFINITY;
                if (!MASK && diag) {
#pragma unroll
                    for (int t4 = 0; t4 < 4; ++t4)
#pragma unroll
                        for (int c = 0; c < 4; ++c) { const int kin = 16 * t4 + 4 * g + c; const bool ok = (64 * kt + kin) <= qpos;
                            st[r][t4][c] = ok ? st[r][t4][c] : -INFINITY; }
                }
#pragma unroll
                for (int t4 = 0; t4 < 4; ++t4) mx = fmaxf(fmaxf(mx, fmaxf(st[r][t4][0], st[r][t4][1])), fmaxf(st[r][t4][2], st[r][t4][3]));
                mx = rowmax4(mx);
                const float m_new = fmaxf(m_run[r], mx);
                const float msafe = (m_new == -INFINITY) ? 0.f : m_new;
                alpha[r] = fast_exp2(m_run[r] - msafe);
                resc = resc || (m_new != m_run[r]);
                m_run[r] = m_new;
                float ps = 0.f; unsigned pw[8];
#pragma unroll
                for (int t4 = 0; t4 < 4; ++t4) { const float p0 = fast_exp2(st[r][t4][0] - msafe), p1 = fast_exp2(st[r][t4][1] - msafe), p2 = fast_exp2(st[r][t4][2] - msafe), p3 = fast_exp2(st[r][t4][3] - msafe);
                    ps += (p0 + p1) + (p2 + p3); pw[2 * t4] = pk2(p0, p1); pw[2 * t4 + 1] = pk2(p2, p3); }
                pf[r][0] = __builtin_bit_cast(bf16x8, (u32x4){pw[0], pw[1], pw[2], pw[3]}); pf[r][1] = __builtin_bit_cast(bf16x8, (u32x4){pw[4], pw[5], pw[6], pw[7]});
                l_run[r] = l_run[r] * alpha[r] + ps;
            }
            __builtin_amdgcn_sched_barrier(0);
            if (__any(resc)) {
#pragma unroll
                for (int r = 0; r < RG; ++r)
#pragma unroll
                    for (int et = 0; et < 8; ++et) ot[r][et] = ot[r][et] * alpha[r];
            }
#pragma unroll
            for (int et = 0; et < 8; ++et)
#pragma unroll
                for (int k2 = 0; k2 < 2; ++k2) { const bf16x8 vf = *(const LAS bf16x8*)(Vb + (16 * et + li) * 72 + 32 * k2 + 8 * g);
#pragma unroll
                    for (int r = 0; r < RG; ++r) ot[r][et] = __builtin_amdgcn_mfma_f32_16x16x32_bf16(vf, pf[r][k2], ot[r][et], 0, 0, 0); }
        }
        if (kt + 1 < nkt) { commit(buf ^ 1);
#pragma unroll
            for (int r = 0; r < RG; ++r) mcur[r] = mreg[r]; }
        __syncthreads();
    }
#pragma unroll
    for (int r = 0; r < RG; ++r) { float l = sum_x16_x32(l_run[r]); const float inv = 1.0f / l;
#pragma unroll
        for (int et = 0; et < 8; ++et) ot[r][et] = ot[r][et] * inv; }
}

__device__ __forceinline__ void cvt_transpose_unit(Frame& F, int unit) {
    const int b = unit >> 6, h = (unit >> 4) & 3, n = unit & 15; const int tok0 = b * SEQ + n * 128;
    const bf16* P = (const bf16*)(F.ws + WS_P); bf16* CVT = (bf16*)(F.ws + WS_CVT) + (size_t)(b * 4 + h) * 128 * SEQ + n * 128;
    LAS bf16* T = (LAS bf16*)F.lds;
#pragma unroll
    for (int ps = 0; ps < 4; ++ps) { const int c = (F.tid >> 4) + 32 * ps, ch = F.tid & 15; *(LAS u32x4*)(T + c * 136 + 8 * ch) = *(const u32x4*)(P + (size_t)(tok0 + c) * NP + PC_CV + 128 * h + 8 * ch); }
    __syncthreads();
#pragma unroll
    for (int ps = 0; ps < 4; ++ps) { const int it = F.tid + 512 * ps, e = it & 127, cc = it >> 7;
        unsigned wv[4];
#pragma unroll
        for (int j = 0; j < 4; ++j) {
            const int blk = cc >> 2, gg = cc & 3, j0 = 2 * j, j1 = 2 * j + 1; const int t0 = 32 * blk + 16 * (j0 >> 2) + 4 * gg + (j0 & 3), t1 = 32 * blk + 16 * (j1 >> 2) + 4 * gg + (j1 & 3);
            wv[j] = (unsigned)T[t0 * 136 + e] | ((unsigned)T[t1 * 136 + e] << 16); }
        *(u32x4*)(CVT + (size_t)e * SEQ + 8 * cc) = (u32x4){wv[0], wv[1], wv[2], wv[3]}; }
    __syncthreads();
}

constexpr int ATT_RG = 2;
__device__ __forceinline__ void diffattn_unit(Frame& F, const CAS Args& a, int l, int unit) {
    const int b = unit >> 5, h = (unit >> 3) & 3, qb = 7 - (unit & 7);
    const bf16* P = (const bf16*)(F.ws + WS_P) + (size_t)b * SEQ * NP; bf16* HEADS = (bf16*)(F.ws + WS_HEADS);
    const float* lam = a.in[I_CLAM] + l * 256; const float* sg = a.in[I_CSUB] + l * 128;
    const float l1 = wave_sum(lam[F.lane] * lam[64 + F.lane]), l2 = wave_sum(lam[128 + F.lane] * lam[192 + F.lane]);
    const float lam_init = 0.8f - 0.6f * __expf(-0.3f * (float)l); const float lam_full = __expf(l1) - __expf(l2) + lam_init;
    f32x4 o2[ATT_RG][8];
    float* O1 = (float*)(F.ws + WS_H);
    AttnSrc S; S.q1 = nullptr; S.k1 = nullptr; S.sq1 = 0; S.sk1 = 0; S.sq0 = NP; S.sk0 = NP; S.mask = nullptr;
    S.vt = (const bf16*)(F.ws + WS_CVT) + (size_t)(b * 4 + h) * 128 * SEQ;
    S.q0 = P + PC_CQ + 64 * (2 * h); S.k0 = P + PC_CK + 64 * (2 * h);
    const int li = F.lane & 15, g = F.lane >> 4;
    attn_unit<64, 0, false, ATT_RG>(F, S, qb * 128 * ATT_RG, o2);
#pragma unroll
    for (int r = 0; r < ATT_RG; ++r) { const int tok = b * SEQ + qb * 128 * ATT_RG + 16 * ATT_RG * F.wave + 16 * r + li;
#pragma unroll
        for (int et = 0; et < 8; ++et) *(f32x4*)(O1 + ((size_t)tok * 4 + h) * 128 + 16 * et + 4 * g) = o2[r][et]; }
    S.q0 = P + PC_CQ + 64 * (2 * h + 1); S.k0 = P + PC_CK + 64 * (2 * h + 1);
    attn_unit<64, 0, false, ATT_RG>(F, S, qb * 128 * ATT_RG, o2);
#pragma unroll
    for (int r = 0; r < ATT_RG; ++r) {
        const int tok = b * SEQ + qb * 128 * ATT_RG + 16 * ATT_RG * F.wave + 16 * r + li;
        float ss = 0.f; f32x4 o1[1][8];
#pragma unroll
        for (int et = 0; et < 8; ++et) o1[0][et] = *(const f32x4*)(O1 + ((size_t)tok * 4 + h) * 128 + 16 * et + 4 * g);
#pragma unroll
        for (int et = 0; et < 8; ++et) { o1[0][et] = o1[0][et] - o2[r][et] * lam_full; ss += (o1[0][et].x * o1[0][et].x + o1[0][et].y * o1[0][et].y) + (o1[0][et].z * o1[0][et].z + o1[0][et].w * o1[0][et].w); }
        ss = sum_x16_x32(ss);
        const float rs = (1.0f - lam_init) / sqrtf(ss * (1.f / 128.f) + RMS_EPS);
#pragma unroll
        for (int et = 0; et < 8; ++et) { const int e = 16 * et + 4 * g; const f32x4 gv = *(const f32x4*)(sg + e); const f32x4 y = o1[0][et] * gv * rs;
            u32x2 ow; ow.x = pk2(y.x, y.y); ow.y = pk2(y.z, y.w); *(u32x2*)(HEADS + (size_t)tok * DM + 1024 + 128 * h + e) = ow; }
    }
}

__device__ __forceinline__ unsigned ord_f32(float x) { unsigned u = __builtin_bit_cast(unsigned, x); if (u == 0x80000000u) u = 0u; return (u & 0x80000000u) ? ~u : (u | 0x80000000u); }
__device__ __forceinline__ void cnt_ge(int& c, unsigned v, unsigned cand) {
    asm volatile("v_cmp_ge_u32_e32 vcc, %1, %2\n\tv_addc_co_u32_e32 %0, vcc, 0, %0, vcc" : "+v"(c) : "v"(v), "v"(cand) : "vcc"); }
__device__ __forceinline__ void cnt_tie(int& c, unsigned v, unsigned T, int key, int mid, int big) {
    int t;
    asm volatile("v_cmp_eq_u32_e32 vcc, %2, %3\n\tv_cndmask_b32_e32 %1, %6, %4, vcc\n\tv_cmp_le_i32_e32 vcc, %1, %5\n\tv_addc_co_u32_e32 %0, vcc, 0, %0, vcc"
                 : "+v"(c), "=&v"(t) : "v"(v), "v"(T), "v"(key), "v"(mid), "v"(big) : "vcc"); }
__device__ __forceinline__ void sel_bit(unsigned& nib, unsigned v, unsigned T, int key, int X, int big, int zero) {
    int t;
    asm volatile("v_cmp_eq_u32_e32 vcc, %2, %3\n\tv_cndmask_b32_e32 %1, %6, %4, vcc\n\tv_cmp_gt_u32_e32 vcc, %2, %3\n\tv_cndmask_b32_e32 %1, %1, %7, vcc\n\tv_cmp_le_i32_e32 vcc, %1, %5\n\tv_addc_co_u32_e32 %0, vcc, %0, %0, vcc"
                 : "+v"(nib), "=&v"(t) : "v"(v), "v"(T), "v"(key), "v"(X), "v"(big), "v"(zero) : "vcc"); }
__device__ __forceinline__ void cnt_ge_s(int& c, unsigned v, unsigned cand) {
    unsigned long long m; int t;
    asm volatile("v_cmp_ge_u32_e64 %1, %3, %4\n\ts_bcnt1_i32_b64 %2, %1\n\ts_add_i32 %0, %0, %2" : "+s"(c), "=&s"(m), "=&s"(t) : "v"(v), "s"(cand) : "scc"); }
__device__ __forceinline__ void cnt_tie_s(int& c, unsigned v, unsigned T, int key, int mid) {
    unsigned long long m, n; int t;
    asm volatile("v_cmp_eq_u32_e64 %1, %4, %5\n\tv_cmp_le_i32_e64 %2, %6, %7\n\ts_and_b64 %1, %1, %2\n\ts_bcnt1_i32_b64 %3, %1\n\ts_add_i32 %0, %0, %3"
                 : "+s"(c), "=&s"(m), "=&s"(n), "=&s"(t) : "v"(v), "s"(T), "v"(key), "s"(mid) : "scc"); }
__device__ __forceinline__ void cnt_le_sv(int& c, unsigned cand, unsigned v) {
    asm volatile("v_cmp_le_u32_e32 vcc, %1, %2\n\tv_addc_co_u32_e32 %0, vcc, 0, %0, vcc" : "+v"(c) : "s"(cand), "v"(v) : "vcc"); }
__device__ __forceinline__ int wave_sum_dpp(int v) {
    v += __builtin_amdgcn_update_dpp(0, v, 0x111, 0xf, 0xf, false);
    v += __builtin_amdgcn_update_dpp(0, v, 0x112, 0xf, 0xf, false);
    v += __builtin_amdgcn_update_dpp(0, v, 0x114, 0xf, 0xf, false);
    v += __builtin_amdgcn_update_dpp(0, v, 0x118, 0xf, 0xf, false);
    v += __builtin_amdgcn_update_dpp(0, v, 0x142, 0xa, 0xf, false);
    v += __builtin_amdgcn_update_dpp(0, v, 0x143, 0xc, 0xf, false);
    return __builtin_amdgcn_readlane(v, 63);
}
__device__ __forceinline__ void indexer_unit(Frame& F, int unit) {
    const int b = unit >> 7, qi = 127 - (unit & 127), q0 = qi * 16;
    const bf16* P = (const bf16*)(F.ws + WS_P) + (size_t)b * SEQ * NP; const float* IW = (const float*)(F.ws + WS_IW) + (size_t)b * SEQ * 8;
    unsigned* M32 = (unsigned*)(F.ws + WS_MASK) + (size_t)b * SEQ * 64;
    constexpr int VST = 2052;
    LAS unsigned* V = (LAS unsigned*)F.lds;
    const int w = F.wave, li = F.lane & 15, g = F.lane >> 4, q = q0 + li;
#pragma unroll 1
    for (int rep1 = 0; rep1 < 1 + REP2(12); ++rep1) {
        bf16x8 qf[8][2]; float iwv[8];
#pragma unroll
        for (int h = 0; h < 8; ++h) { iwv[h] = IW[(size_t)q * 8 + h];
#pragma unroll
            for (int ks = 0; ks < 2; ++ks) qf[h][ks] = *(const bf16x8*)(P + (size_t)q * NP + PC_AIQ + 64 * h + 32 * ks + 8 * g); }
        const int NT = qi + 1;
        bf16x8 a0n, a1n, a0m, a1m;
        const GAS bf16* kp = (const GAS bf16*)(P + (size_t)(16 * w + li) * NP + PC_AIK + 8 * g);
        int kidx = 16 * w + 4 * g;
        a0n = *(const GAS bf16x8*)kp; a1n = *(const GAS bf16x8*)(kp + 32);
        kp += (size_t)128 * NP; asm volatile("" : "+v"(kp));
        a0m = a0n; a1m = a1n;
        if (w + 8 < NT) { a0m = *(const GAS bf16x8*)kp; a1m = *(const GAS bf16x8*)(kp + 32); }
        LAS unsigned* vrow = V + li * VST;
#pragma unroll
        for (int ti = 0; ti < 16; ++ti) {
            const int t = w + 8 * ti;
            if (t < NT) {
                const bf16x8 a0 = a0n, a1 = a1n;
                a0n = a0m; a1n = a1m;
                kp += (size_t)128 * NP; asm volatile("" : "+v"(kp));
                if (ti + 2 < 16 && t + 16 < NT) { a0m = *(const GAS bf16x8*)kp; a1m = *(const GAS bf16x8*)(kp + 32); }
                asm volatile("" ::: "memory");
                f32x4 idx = {0.f, 0.f, 0.f, 0.f};
#pragma unroll
                for (int h = 0; h < 8; ++h) { f32x4 c = {0.f, 0.f, 0.f, 0.f}; c = __builtin_amdgcn_mfma_f32_16x16x32_bf16(a0, qf[h][0], c, 0, 0, 0); c = __builtin_amdgcn_mfma_f32_16x16x32_bf16(a1, qf[h][1], c, 0, 0, 0);
#pragma unroll
                    for (int r = 0; r < 4; ++r) idx[r] += fmaxf(c[r], 0.f) * iwv[h]; }
                u32x4 o;
#pragma unroll
                for (int r = 0; r < 4; ++r) o[r] = (kidx + r <= q) ? ord_f32(idx[r]) : 0u;
                const int G = 4 * t + g; *(LAS u32x4*)(vrow + 4 * (G ^ ((G >> 4) & 15))) = o;
                kidx += 128; asm volatile("" : "+v"(kidx));
                __builtin_amdgcn_sched_barrier(0);
            }
        }
    }
    __syncthreads();
    int big = 0x7fffffff, zero = 0; asm volatile("" : "+v"(big), "+v"(zero));
#pragma unroll 1
    for (int qq2 = 0; qq2 < 2 * (1 + REP2(13)); ++qq2) {
        const int qq = qq2 & 1;
        const int ql = 2 * w + qq, qg = q0 + ql; const int L = F.lane, kbase = 32 * L;
        unsigned val[32];
#pragma unroll
        for (int m8 = 0; m8 < 8; ++m8) { const int G = 8 * L + m8; const u32x4 x = *(const LAS u32x4*)(V + ql * VST + 4 * (G ^ ((G >> 4) & 15)));
#pragma unroll
            for (int c = 0; c < 4; ++c) val[4 * m8 + c] = (kbase + 4 * m8 + c <= qg) ? x[c] : 0u; }
        unsigned T = 0u; int cge = -1;
        for (int bit = 31; bit >= 0; --bit) { const unsigned cand = T | (1u << bit); int cl = 0;
#pragma unroll
            for (int m = 0; m < 32; ++m) cnt_le_sv(cl, cand, val[m]);
            const int c = wave_sum_dpp(cl);
            if (c >= 256) { T = cand; if (c == 256) { cge = 256; break; } } }
        int X = 4096;
        if (cge < 0 && T != 0u) {
            int c1 = 0, c2 = 0;
            { int cl = 0;
#pragma unroll
              for (int m = 0; m < 32; ++m) cnt_le_sv(cl, T, val[m]);
              c1 = wave_sum_dpp(cl); }
            if (T != 0xffffffffu) { int cl = 0;
#pragma unroll
                for (int m = 0; m < 32; ++m) cnt_le_sv(cl, T + 1u, val[m]);
                c2 = wave_sum_dpp(cl); }
            if (c1 > 256) {
                const int want = 256 - c2; int lo = 0, hi = 2047;
                for (int it = 0; it < 11; ++it) { const int mid = (lo + hi) >> 1; int c = 0;
#pragma unroll
                    for (int m = 0; m < 32; ++m) cnt_tie_s(c, val[m], T, kbase + m, mid);
                    if (c >= want) hi = mid; else lo = mid + 1; }
                X = hi;
            }
        }
        unsigned word = 0u; const unsigned T1 = T > 1u ? T : 1u;
#pragma unroll
        for (int m = 31; m >= 0; --m) sel_bit(word, val[m], T1, kbase + m, X, big, zero);
        M32[(size_t)qg * 64 + L] = word;
    }
    __syncthreads();
}

__device__ __forceinline__ void dsa_attn_unit(Frame& F, int unit) {
    const int b = unit >> 6, h = (unit >> 4) & 3, qb = 15 - (unit & 15);
    const bf16* P = (const bf16*)(F.ws + WS_P) + (size_t)b * SEQ * NP; bf16* HEADS = (bf16*)(F.ws + WS_HEADS);
    AttnSrc S; S.q0 = P + PC_AQN + 128 * h; S.q1 = P + PC_AQR + 64 * h; S.sq0 = NP; S.sq1 = NP;
    S.k0 = (const bf16*)(F.ws + WS_KN) + (size_t)b * SEQ * 512 + 128 * h; S.sk0 = 512; S.k1 = P + PC_AKR; S.sk1 = NP;
    S.vt = (const bf16*)(F.ws + WS_VAT) + (size_t)(b * 4 + h) * 128 * SEQ; S.mask = (const unsigned long long*)(F.ws + WS_MASK) + (size_t)b * SEQ * 32;
    f32x4 o[1][8];
    attn_unit<128, 64, true, 1>(F, S, qb * 128, o);
    const int li = F.lane & 15, g = F.lane >> 4;
#pragma unroll
    for (int r = 0; r < 1; ++r) { const int tok = b * SEQ + qb * 128 + 16 * F.wave + li;
#pragma unroll
        for (int et = 0; et < 8; ++et) { u32x2 ow; ow.x = pk2(o[r][et].x, o[r][et].y); ow.y = pk2(o[r][et].z, o[r][et].w); *(u32x2*)(HEADS + (size_t)tok * DM + 128 * h + 16 * et + 4 * g) = ow; } }
}

__device__ __forceinline__ void gdn_prep_unit(Frame& F, const CAS Args& a, int l, int unit) {
    const int b = unit >> 7, h = (unit >> 5) & 3, n = unit & 31; const int tok0 = b * SEQ + n * 64;
    const bf16* P = (const bf16*)(F.ws + WS_P); const float* GB = (const float*)(F.ws + WS_GB);
    const float* cw = a.in[I_DCONV] + (size_t)l * 4 * 1536;
    bf16* DW = (bf16*)(F.ws + WS_DW) + (size_t)unit * 8192; bf16* DQG = (bf16*)(F.ws + WS_DQG) + (size_t)unit * 8192; bf16* DKDT = (bf16*)(F.ws + WS_DKDT) + (size_t)unit * 8192;
    bf16* DATT = (bf16*)(F.ws + WS_DATT) + (size_t)unit * 4096; float* DUT = (float*)(F.ws + WS_DUT) + (size_t)unit * 8192; float* DDL = (float*)(F.ws + WS_DDL);
    LAS bf16* Xq = (LAS bf16*)F.lds;
    LAS bf16* Xk = Xq + 64 * 136;
    LAS bf16* KT = Xk + 64 * 136;
    LAS bf16* VT = KT + 128 * 72;
    LAS bf16* T1 = VT + 128 * 72;
    LAS bf16* T2 = T1 + 64 * 72;
    LAS float* Lm = (LAS float*)(T2 + 64 * 72);
    LAS float* part = Lm + 64 * 68;
    LAS float* vG = part + 64 * 32;
    LAS float* vB = vG + 64;
    LAS float* vRq = vB + 64;
    LAS float* vRk = vRq + 64;
    const int w = F.wave, li = F.lane & 15, g = F.lane >> 4;
#pragma unroll 1
    for (int it = F.tid; it < 768; it += NTHR) {
        const int rb = it & 15, cg = it >> 4, sect = cg >> 4, c8 = 8 * (cg & 15); const int ch = sect * 512 + 128 * h + c8;
        f32x4 wt[4][2];
#pragma unroll
        for (int tap = 0; tap < 4; ++tap) { wt[tap][0] = *(const f32x4*)(cw + tap * 1536 + ch); wt[tap][1] = *(const f32x4*)(cw + tap * 1536 + ch + 4); }
        u32x4 xr[7];
#pragma unroll
        for (int i = 0; i < 7; ++i) { const int pos = n * 64 + 4 * rb - 3 + i; xr[i] = (u32x4){0u, 0u, 0u, 0u}; if (pos >= 0) xr[i] = *(const u32x4*)(P + (size_t)(tok0 + 4 * rb - 3 + i) * NP + PC_DQKV + ch); }
#pragma unroll
        for (int rr = 0; rr < 4; ++rr) {
            const int r = 4 * rb + rr; float acc[8];
#pragma unroll
            for (int j = 0; j < 8; ++j) acc[j] = 0.f;
#pragma unroll
            for (int tap = 0; tap < 4; ++tap) { const u32x4 xw = xr[rr + tap]; const f32x4 w0 = wt[tap][0], w1 = wt[tap][1];
                acc[0] += bflo(xw.x) * w0.x; acc[1] += bfhi(xw.x) * w0.y; acc[2] += bflo(xw.y) * w0.z; acc[3] += bfhi(xw.y) * w0.w;
                acc[4] += bflo(xw.z) * w1.x; acc[5] += bfhi(xw.z) * w1.y; acc[6] += bflo(xw.w) * w1.z; acc[7] += bfhi(xw.w) * w1.w; }
            float ss = 0.f;
#pragma unroll
            for (int j = 0; j < 8; ++j) { acc[j] = acc[j] * sigmoidf_(acc[j]); ss += acc[j] * acc[j]; }
            if (sect < 2) { part[r * 32 + cg] = ss; u32x4 o; o.x = pk2(acc[0], acc[1]); o.y = pk2(acc[2], acc[3]); o.z = pk2(acc[4], acc[5]); o.w = pk2(acc[6], acc[7]);
                *(LAS u32x4*)((sect == 0 ? Xq : Xk) + r * 136 + c8) = o; }
            else {
#pragma unroll
                for (int j = 0; j < 8; ++j) VT[(c8 + j) * 72 + r] = (bf16)f2bf(acc[j]); }
        }
    }
    __syncthreads();
    if (w == 0) {
        const int r = F.lane; float sq = 0.f, sk = 0.f;
#pragma unroll
        for (int c = 0; c < 16; ++c) { sq += part[r * 32 + c]; sk += part[r * 32 + 16 + c]; }
        vRq[r] = 0.08838834764831845f / sqrtf(sq + RMS_EPS); vRk[r] = 1.0f / sqrtf(sk + RMS_EPS);
        float gc = GB[(size_t)(tok0 + r) * 8 + 4 + h];
#pragma unroll
        for (int o = 1; o < 64; o <<= 1) { const float t = __builtin_bit_cast(float, __builtin_amdgcn_ds_bpermute((r - o) << 2, __builtin_bit_cast(int, gc))); if (r >= o) gc += t; }
        vG[r] = gc; vB[r] = GB[(size_t)(tok0 + r) * 8 + h];
        if (r == 63) DDL[unit] = __expf(gc);
    }
    __syncthreads();
#pragma unroll
    for (int i = 0; i < 4; ++i) {
        const int it = F.tid + 512 * i, isk = it >> 10, r = it & 63, c8 = 8 * ((it >> 6) & 15);
        LAS bf16* X = isk ? Xk : Xq; const float sc = isk ? vRk[r] : vRq[r];
        const u32x4 xw = *(const LAS u32x4*)(X + r * 136 + c8); const unsigned ww[4] = {xw.x, xw.y, xw.z, xw.w}; float v[8];
#pragma unroll
        for (int j = 0; j < 4; ++j) { v[2 * j] = bflo(ww[j]) * sc; v[2 * j + 1] = bfhi(ww[j]) * sc; }
        u32x4 o; o.x = pk2(v[0], v[1]); o.y = pk2(v[2], v[3]); o.z = pk2(v[4], v[5]); o.w = pk2(v[6], v[7]);
        *(LAS u32x4*)(X + r * 136 + c8) = o;
        if (isk) {
#pragma unroll
            for (int j = 0; j < 8; ++j) KT[(c8 + j) * 72 + r] = (bf16)f2bf(v[j]); }
        else { const float eg = __expf(vG[r]); u32x4 q; q.x = pk2(v[0] * eg, v[1] * eg); q.y = pk2(v[2] * eg, v[3] * eg); q.z = pk2(v[4] * eg, v[5] * eg); q.w = pk2(v[6] * eg, v[7] * eg);
            *(u32x4*)(DQG + r * 128 + c8) = q; }
    }
    __syncthreads();
#pragma unroll
    for (int tq = 0; tq < 4; ++tq) {
        const int tt = w * 4 + tq, isq = tt >> 4, it_ = (tt >> 2) & 3, jt = tt & 3;
        f32x4 acc = {0.f, 0.f, 0.f, 0.f};
        if (jt <= it_) acc = mma16(acc, Xk + jt * 16 * 136, 136, (isq ? Xq : Xk) + it_ * 16 * 136, 136, 128, F.lane);
        const int i = 16 * it_ + li; const float Gi = vG[i], bi = vB[i]; float v[4];
#pragma unroll
        for (int r = 0; r < 4; ++r) { const int j = 16 * jt + 4 * g + r; const float dec = __expf(Gi - vG[j]);
            v[r] = isq ? ((j <= i) ? acc[r] * dec : 0.f) : ((j < i) ? acc[r] * dec * bi : 0.f); }
        if (isq) { u32x2 o; o.x = pk2(v[0], v[1]); o.y = pk2(v[2], v[3]); *(u32x2*)(DATT + i * 64 + 16 * jt + 4 * g) = o; }
        else *(LAS f32x4*)(Lm + i * 68 + 16 * jt + 4 * g) = (f32x4){v[0], v[1], v[2], v[3]};
    }
    __syncthreads();
    LAS float* Tm = (LAS float*)Xq;
    LAS float* PS = (LAS float*)Xk + w * 272;
    auto blk_mma = [&](f32x4 acc, const LAS float* Ab, int lda, const LAS float* Bb, int ldb) -> f32x4 {
#pragma unroll
        for (int ks = 0; ks < 4; ++ks) acc = __builtin_amdgcn_mfma_f32_16x16x4f32(Ab[(F.lane & 15) * lda + 4 * ks + (F.lane >> 4)], Bb[(4 * ks + (F.lane >> 4)) * ldb + (F.lane & 15)], acc, 0, 0, 0);
        return acc; };
    auto blk_finish = [&](f32x4 p, int bi, int bj) {
#pragma unroll
        for (int r = 0; r < 4; ++r) PS[(4 * (F.lane >> 4) + r) * 17 + (F.lane & 15)] = p[r];
        asm volatile("s_waitcnt lgkmcnt(0)" ::: "memory");
        f32x4 t = {0.f, 0.f, 0.f, 0.f}; t = blk_mma(t, Tm + (16 * bi) * 68 + 16 * bi, 68, PS, 17);
#pragma unroll
        for (int r = 0; r < 4; ++r) Tm[(16 * bi + 4 * (F.lane >> 4) + r) * 68 + 16 * bj + (F.lane & 15)] = -t[r]; };
    if (w < 4) {
        if (F.lane < 16) {
            const LAS float* Lb = Lm + (16 * w) * 68 + 16 * w; float tcb[16];
#pragma unroll
            for (int k = 0; k < 16; ++k) tcb[k] = 0.f;
#pragma unroll
            for (int i = 0; i < 16; ++i) { float sacc_ = Lb[i * 68 + F.lane];
#pragma unroll
                for (int k = 0; k < i; ++k) sacc_ += Lb[i * 68 + k] * tcb[k];
                tcb[i] = -sacc_; }
            LAS float* Tb = Tm + (16 * w) * 68 + 16 * w + F.lane;
#pragma unroll
            for (int i = 0; i < 16; ++i) Tb[i * 68] = tcb[i] + (i == F.lane ? 1.0f : 0.0f);
        }
    } else {
        const float Gl = vG[63];
        for (int it = F.tid - 256; it < 1024; it += 256) { const int d = it >> 3, j8 = 8 * (it & 7);
            const u32x4 kw = *(const LAS u32x4*)(KT + d * 72 + j8); const unsigned ww[4] = {kw.x, kw.y, kw.z, kw.w}; unsigned o[4];
#pragma unroll
            for (int j = 0; j < 4; ++j) o[j] = pk2(bflo(ww[j]) * __expf(Gl - vG[j8 + 2 * j]), bfhi(ww[j]) * __expf(Gl - vG[j8 + 2 * j + 1]));
            *(u32x4*)(DKDT + d * 64 + j8) = (u32x4){o[0], o[1], o[2], o[3]}; }
    }
    __syncthreads();
    if (w < 3) { f32x4 p = {0.f, 0.f, 0.f, 0.f}; p = blk_mma(p, Lm + (16 * (w + 1)) * 68 + 16 * w, 68, Tm + (16 * w) * 68 + 16 * w, 68); blk_finish(p, w + 1, w); }
    __syncthreads();
    if (w < 2) { f32x4 p = {0.f, 0.f, 0.f, 0.f}; p = blk_mma(p, Lm + (16 * (w + 2)) * 68 + 16 * w, 68, Tm + (16 * w) * 68 + 16 * w, 68);
                 p = blk_mma(p, Lm + (16 * (w + 2)) * 68 + 16 * (w + 1), 68, Tm + (16 * (w + 1)) * 68 + 16 * w, 68); blk_finish(p, w + 2, w); }
    __syncthreads();
    if (w == 0) { f32x4 p = {0.f, 0.f, 0.f, 0.f}; p = blk_mma(p, Lm + 48 * 68, 68, Tm, 68); p = blk_mma(p, Lm + 48 * 68 + 16, 68, Tm + 16 * 68, 68); p = blk_mma(p, Lm + 48 * 68 + 32, 68, Tm + 32 * 68, 68); blk_finish(p, 3, 0); }
    __syncthreads();
    {
        const int i = F.tid >> 3, j8 = 8 * (F.tid & 7); float t1[8], t2[8];
#pragma unroll
        for (int c = 0; c < 8; ++c) { const int j = j8 + c; const float t = ((i >> 4) >= (j >> 4)) ? Tm[i * 68 + j] : 0.f; const float bj = vB[j]; t1[c] = t * bj; t2[c] = t * bj * __expf(vG[j]); }
        u32x4 a1, a2; a1.x = pk2(t1[0], t1[1]); a1.y = pk2(t1[2], t1[3]); a1.z = pk2(t1[4], t1[5]); a1.w = pk2(t1[6], t1[7]);
        a2.x = pk2(t2[0], t2[1]); a2.y = pk2(t2[2], t2[3]); a2.z = pk2(t2[4], t2[5]); a2.w = pk2(t2[6], t2[7]);
        *(LAS u32x4*)(T1 + i * 72 + j8) = a1; *(LAS u32x4*)(T2 + i * 72 + j8) = a2;
    }
    __syncthreads();
#pragma unroll
    for (int tq = 0; tq < 4; ++tq) { const int tt = w * 4 + tq, dt = tt >> 2, it_ = tt & 3;
        f32x4 acc = {0.f, 0.f, 0.f, 0.f}; acc = mma16(acc, KT + dt * 16 * 72, 72, T2 + it_ * 16 * 72, 72, 64, F.lane);
        u32x2 o; o.x = pk2(acc.x, acc.y); o.y = pk2(acc.z, acc.w); *(u32x2*)(DW + (16 * it_ + li) * 128 + 16 * dt + 4 * g) = o; }
#pragma unroll
    for (int tq = 0; tq < 4; ++tq) { const int tt = w * 4 + tq, it_ = tt >> 3, et = tt & 7;
        f32x4 acc = {0.f, 0.f, 0.f, 0.f}; acc = mma16(acc, T1 + it_ * 16 * 72, 72, VT + et * 16 * 72, 72, 64, F.lane);
        *(f32x4*)(DUT + (16 * et + li) * 64 + 16 * it_ + 4 * g) = acc; }
    __syncthreads();
}

struct GdnRegsA { bf16x8 wf[4]; f32x4 u[4]; };
struct GdnRegsB { bf16x8 qf[4], af[2], kf[2]; float dl; };
__device__ __forceinline__ void gdn_load_a(GdnRegsA& R, const unsigned char* ws, int unit, int w, int li, int g) {
    const int jb = w & 3, eh = w >> 2;
    const bf16* DW = (const bf16*)(ws + WS_DW) + (size_t)unit * 8192 + (16 * jb + li) * 128 + 8 * g; const float* DUT = (const float*)(ws + WS_DUT) + (size_t)unit * 8192;
#pragma unroll
    for (int ks = 0; ks < 4; ++ks) R.wf[ks] = *(const bf16x8*)(DW + 32 * ks);
#pragma unroll
    for (int t = 0; t < 4; ++t) R.u[t] = *(const f32x4*)(DUT + (16 * (4 * eh + t) + li) * 64 + 16 * jb + 4 * g);
}
__device__ __forceinline__ void gdn_load_b(GdnRegsB& R, const unsigned char* ws, int unit, int w, int li, int g) {
    const int jb = w & 3;
    const bf16* DQG = (const bf16*)(ws + WS_DQG) + (size_t)unit * 8192 + (16 * jb + li) * 128 + 8 * g;
    const bf16* DATT = (const bf16*)(ws + WS_DATT) + (size_t)unit * 4096 + (16 * jb + li) * 64 + 8 * g; const bf16* DKDT = (const bf16*)(ws + WS_DKDT) + (size_t)unit * 8192 + (16 * w + li) * 64 + 8 * g;
#pragma unroll
    for (int ks = 0; ks < 4; ++ks) R.qf[ks] = *(const bf16x8*)(DQG + 32 * ks);
#pragma unroll
    for (int ks = 0; ks < 2; ++ks) { R.af[ks] = *(const bf16x8*)(DATT + 32 * ks); R.kf[ks] = *(const bf16x8*)(DKDT + 32 * ks); }
    R.dl = ((const float*)(ws + WS_DDL))[unit];
}
__device__ __forceinline__ void gdn_scan_unit(Frame& F, const CAS Args& a, int l, int bh) {
    const int b = bh >> 2, h = bh & 3;
    const bf16* P = (const bf16*)(F.ws + WS_P); bf16* HEADS = (bf16*)(F.ws + WS_HEADS); const float* ng = a.in[I_DNORM] + l * 128;
    LAS bf16* ST = (LAS bf16*)F.lds;
    LAS bf16* VN = ST + 128 * 136;
    LAS float* red = (LAS float*)(VN + 128 * 72);
    const int w = F.wave, li = F.lane & 15, g = F.lane >> 4, jb = w & 3, eh = w >> 2;
    for (int i = F.tid; i < 128 * 136 / 2; i += NTHR) ((LAS unsigned*)ST)[i] = 0u;
    f32x4 sacc[8];
#pragma unroll
    for (int et = 0; et < 8; ++et) sacc[et] = (f32x4){0.f, 0.f, 0.f, 0.f};
    GdnRegsA cur, nxt; GdnRegsB cb;
    gdn_load_a(cur, F.ws, bh * 32, w, li, g);
    __syncthreads();
    for (int n = 0; n < 32; ++n) {
        gdn_load_b(cb, F.ws, bh * 32 + n, w, li, g);
        gdn_load_a(nxt, F.ws, bh * 32 + (n < 31 ? n + 1 : n), w, li, g);
        const int tok = b * SEQ + n * 64 + 16 * jb + li;
        u32x2 zw[4];
#pragma unroll
        for (int t = 0; t < 4; ++t) zw[t] = *(const u32x2*)(P + (size_t)tok * NP + PC_DZ + 128 * h + 16 * (4 * eh + t) + 4 * g);
#pragma unroll
        for (int t = 0; t < 4; ++t) { f32x4 acc = {0.f, 0.f, 0.f, 0.f}; const LAS bf16* sp = ST + (16 * (4 * eh + t) + li) * 136 + 8 * g;
#pragma unroll
            for (int ks = 0; ks < 4; ++ks) acc = __builtin_amdgcn_mfma_f32_16x16x32_bf16(cur.wf[ks], *(const LAS bf16x8*)(sp + 32 * ks), acc, 0, 0, 0);
            const f32x4 vn = cur.u[t] - acc; u32x2 o; o.x = pk2(vn.x, vn.y); o.y = pk2(vn.z, vn.w);
            *(LAS u32x2*)(VN + (16 * (4 * eh + t) + li) * 72 + 16 * jb + 4 * g) = o; }
        __syncthreads();
        f32x4 oacc[4]; float ss = 0.f;
#pragma unroll
        for (int t = 0; t < 4; ++t) { f32x4 acc = {0.f, 0.f, 0.f, 0.f}; const LAS bf16* sp = ST + (16 * (4 * eh + t) + li) * 136 + 8 * g; const LAS bf16* vp = VN + (16 * (4 * eh + t) + li) * 72 + 8 * g;
#pragma unroll
            for (int ks = 0; ks < 4; ++ks) acc = __builtin_amdgcn_mfma_f32_16x16x32_bf16(*(const LAS bf16x8*)(sp + 32 * ks), cb.qf[ks], acc, 0, 0, 0);
#pragma unroll
            for (int ks = 0; ks < 2; ++ks) acc = __builtin_amdgcn_mfma_f32_16x16x32_bf16(*(const LAS bf16x8*)(vp + 32 * ks), cb.af[ks], acc, 0, 0, 0);
            oacc[t] = acc; ss += (acc.x * acc.x + acc.y * acc.y) + (acc.z * acc.z + acc.w * acc.w); }
        ss = sum_x16_x32(ss);
        if (g == 0) red[eh * 64 + 16 * jb + li] = ss;
        __syncthreads();
#pragma unroll
        for (int et = 0; et < 8; ++et) { f32x4 acc = sacc[et] * cb.dl; const LAS bf16* vp = VN + (16 * et + li) * 72 + 8 * g;
#pragma unroll
            for (int ks = 0; ks < 2; ++ks) acc = __builtin_amdgcn_mfma_f32_16x16x32_bf16(cb.kf[ks], *(const LAS bf16x8*)(vp + 32 * ks), acc, 0, 0, 0);
            sacc[et] = acc; u32x2 o; o.x = pk2(acc.x, acc.y); o.y = pk2(acc.z, acc.w); *(LAS u32x2*)(ST + (16 * et + li) * 136 + 16 * w + 4 * g) = o; }
        { const float tot = red[16 * jb + li] + red[64 + 16 * jb + li]; const float rstd = 1.0f / sqrtf(tot * (1.f / 128.f) + RMS_EPS);
#pragma unroll
          for (int t = 0; t < 4; ++t) { const int e = 16 * (4 * eh + t) + 4 * g; const f32x4 gv = *(const f32x4*)(ng + e);
              const float z0 = bflo(zw[t].x), z1 = bfhi(zw[t].x), z2 = bflo(zw[t].y), z3 = bfhi(zw[t].y);
              u32x2 o; o.x = pk2(oacc[t].x * rstd * gv.x * z0 * sigmoidf_(z0), oacc[t].y * rstd * gv.y * z1 * sigmoidf_(z1)); o.y = pk2(oacc[t].z * rstd * gv.z * z2 * sigmoidf_(z2), oacc[t].w * rstd * gv.w * z3 * sigmoidf_(z3));
              *(u32x2*)(HEADS + (size_t)tok * DM + 1536 + 128 * h + e) = o; } }
        cur = nxt;
        __syncthreads();
    }
}

__device__ __forceinline__ int queue_next(Frame& F, int* head, int base = 0);
struct QGroup { int x, nb, cpg, j; };
__device__ __forceinline__ QGroup qgroup(const Frame& F) { QGroup q; if (F.G % 8 == 0) { q.cpg = F.G / 8; q.x = F.vcu / q.cpg; q.j = F.vcu % q.cpg; q.nb = 1; } else { q.cpg = F.G; q.x = 0; q.j = F.vcu; q.nb = 8; } return q; }
constexpr int CW_XQ = 32768;
__device__ __forceinline__ int* xq_head(const Frame& F, int l, int q, int x) { return (int*)(F.ctl + CW_XQ + ((l * 8 + q) * 8 + x) * 64); }
#define XQ_B(g, i) ((g).nb * (g).x + (i) % (g).nb)
#define XQ_R(g, i) ((i) / (g).nb)
__device__ __forceinline__ void phase_prep_mixers(Frame& F, const CAS Args& a, int l, int qoff) {
    (void)qoff;
    frame_refresh(F);
    const QGroup g = qgroup(F);
    for (int i = g.j; i < (g.nb << 6); i += g.cpg) ret_stage1(F, (XQ_B(g, i) << 6) | XQ_R(g, i));
    for (int i = g.j; i < (g.nb << 6); i += g.cpg) cvt_transpose_unit(F, (XQ_B(g, i) << 6) | XQ_R(g, i));
    frame_refresh(F);
    { const int n = g.nb << 7, base = g.cpg < n ? g.cpg : n; int* qh = xq_head(F, l, 0, g.x);
      for (int i = g.j < n ? g.j : n; i < n; i = queue_next(F, qh, base)) indexer_unit(F, (XQ_B(g, i) << 7) | XQ_R(g, i)); }
    frame_refresh(F);
    { const int n = g.nb << 7; int* qh = xq_head(F, l, 1, g.x);
      for (int i = queue_next(F, qh); i < n; i = queue_next(F, qh)) gdn_prep_unit(F, a, l, (XQ_B(g, i) << 7) | XQ_R(g, i)); }
}

__device__ __forceinline__ int queue_next(Frame& F, int* head, int base) {
    LAS int* qslot = (LAS int*)(F.lds + MISC_OFF + 64);
    if (F.tid == 0) *qslot = __hip_atomic_fetch_add(head, 1, RLX_AGENT) + base;
    __syncthreads();
    const int item = *qslot;
    __syncthreads();
    return item;
}
__device__ __forceinline__ void phase_mix(Frame& F, const CAS Args& a, int l, int qoff) {
    (void)qoff;
    frame_refresh(F);
    const QGroup g = qgroup(F);
    { const int n = g.nb << 2, base = g.cpg < n ? g.cpg : n; int* qh = xq_head(F, l, 2, g.x);
      for (int i = g.j < n ? g.j : n; i < n; i = queue_next(F, qh, base)) gdn_scan_unit(F, a, l, (XQ_B(g, i) << 2) | XQ_R(g, i)); }
    frame_refresh(F);
    { const int n = g.nb << 5; int* qh = xq_head(F, l, 3, g.x);
      for (int i = queue_next(F, qh); i < n; i = queue_next(F, qh)) { const int r = XQ_R(g, i); diffattn_unit(F, a, l, (XQ_B(g, i) << 5) | ((r & 3) << 3) | (r >> 2)); } }
    frame_refresh(F);
    { const int n = g.nb << 6; int* qh = xq_head(F, l, 4, g.x);
      for (int i = queue_next(F, qh); i < n; i = queue_next(F, qh)) { const int r = XQ_R(g, i); dsa_attn_unit(F, (XQ_B(g, i) << 6) | ((r & 3) << 4) | (r >> 2)); } }
    frame_refresh(F);
    { const int n = g.nb << 6; int* qh = xq_head(F, l, 5, g.x);
      for (int i = queue_next(F, qh); i < n; i = queue_next(F, qh)) ret_stage2(F, (XQ_B(g, i) << 6) | XQ_R(g, i)); }
}

__device__ __forceinline__ void phase_zero_heads(Frame& F) {
    frame_refresh(F);
    u32x4* hp = (u32x4*)(F.ws + WS_HEADS); const size_t n = (size_t)NTOK * DM * 2 / 16;
    unsigned z = 0u; asm volatile("" : "+v"(z));
    for (size_t i = (size_t)(F.vcu * NTHR + F.tid); i < n; i += (size_t)F.G * NTHR) hp[i] = (u32x4){z, z, z, z};
}

constexpr int PH_PER_LAYER = 8;
constexpr int N_PHASES = 1 + DEPTH * PH_PER_LAYER;

__global__ void __launch_bounds__(NTHR, 2) mega_fwd(Args args) {
    extern __shared__ __attribute__((aligned(16))) unsigned char lds_raw[];
    Frame F;
    F.lds = (LAS unsigned char*)lds_raw; F.tid = threadIdx.x; F.lane = F.tid & 63; F.wave = __builtin_amdgcn_readfirstlane(F.tid >> 6); F.wv = F.wave;
    F.G = gridDim.x; { const int bx = blockIdx.x; F.vcu = (F.G % 8 == 0) ? (bx % 8) * (F.G / 8) + bx / 8 : bx; }
    F.ws = args.ws; F.ctl = (unsigned*)(args.ws + WS_CTL);
    volatile LAS unsigned* MISC = (volatile LAS unsigned*)(F.lds + MISC_OFF);
    if (F.tid < 64) MISC[F.tid] = 0u;
    __syncthreads();
#if ONE_LAUNCH
    XcdBarrier bar = xcd_barrier_post(F.ctl + CW_BAR, MISC + 8);
#define GRID_BAR() xcd_barrier(bar)
#define LOCAL_BAR() xcd_local_barrier(bar)
#else
#define GRID_BAR() do {} while (0)
#define LOCAL_BAR() do {} while (0)
#endif
    const int lo = args.ph_lo, hi = args.ph_hi;
#define IN(k) (lo <= (k) && (k) < hi)
#define SEAM(k) do { if (IN(k) && IN((k) + 1)) GRID_BAR(); } while (0)
#define LSEAM(k) do { if (IN(k) && IN((k) + 1)) { if (use_local) LOCAL_BAR(); else GRID_BAR(); } } while (0)
    int use_local = 0;

    if (PHON(0) && IN(0)) { phase_prologue(F, kargs()); __syncthreads(); if (REP2(0)) { phase_prologue(F, kargs()); __syncthreads(); } }
    if (threadIdx.x == 0 && !((F.G % 8 == 0) && xb_xcc_id() == (blockIdx.x & 7u))) (void)xb_add(F.ctl + 2048, 1u);
    SEAM(0);
    if (IN(0) && IN(1)) use_local = __builtin_amdgcn_readfirstlane((int)(xb_ld(F.ctl + 2048) == 0u));
    for (int l = 0; l < DEPTH; ++l) {
        const int p0 = 1 + l * PH_PER_LAYER;
        if (p0 + PH_PER_LAYER <= lo || p0 >= hi) continue;
        if (PHON(1) && IN(p0 + 0)) {
            pg8::Gemm g{(const bf16*)(F.ws + WS_XB), (const bf16*)(F.ws + WS_WIN) + (size_t)l * NP * DM, DM, DM, 0};
            pg8::DenseOrder S; S.init(NTOK, NP, F.G, (int)blockIdx.x);
            EpiInProj E{(bf16*)(F.ws + WS_P), (const f32x2*)(F.ws + WS_CS), (float*)(F.ws + WS_GB), (float*)(F.ws + WS_IW), (float*)(F.ws + WS_SSQ), kargs().in[I_DALOG] + l * 4, kargs().in[I_DDT] + l * 4};
            pg8::gemm_phase<false>(F.lds, g, S, E, F.wv);
            if (REP2(1)) pg8::gemm_phase<false>(F.lds, g, S, E, F.wv);
            if (PHON(2)) {
                unsigned long long own = 0ull; { pg8::Unit u; for (int i = 0; S.next(i, u); ++i) if (u.pn == PC_CKV / 256) own |= 1ull << u.pm; }
                pg8::Gemm gk{(const bf16*)(F.ws + WS_P) + PC_CKV, (const bf16*)(F.ws + WS_WKV) + (size_t)l * 1024 * 256, NP, 256, 0};
                pg8::OwnOrder S2{own, 4, 4 * (int)__builtin_popcountll(own)};
                EpiKvUp E2{(bf16*)(F.ws + WS_KN), (bf16*)(F.ws + WS_VAT), (const float*)(F.ws + WS_SSQ)};
                pg8::gemm_phase<false>(F.lds, gk, S2, E2, F.wv);
            }
        }
        LSEAM(p0 + 0);
        if (PHON(2) && IN(p0 + 1)) {
            phase_prep_mixers(F, kargs(), l, 0);
            if (REP2(2)) phase_prep_mixers(F, kargs(), l, 32);
        }
        LSEAM(p0 + 1);
        if (PHON(3) && IN(p0 + 2)) { phase_mix(F, kargs(), l, 0); if (REP2(3)) phase_mix(F, kargs(), l, 32); }
        LSEAM(p0 + 2);
        if (PHON(5) && IN(p0 + 3)) {
            pg8::Gemm g{(const bf16*)(F.ws + WS_HEADS), (const bf16*)(F.ws + WS_WOUT) + (size_t)l * DM * DM, DM, DM, 0};
            pg8::DenseOrder S; S.init(NTOK, DM, F.G, (int)blockIdx.x);
            EpiOutProj E{(const bf16*)(F.ws + WS_XB), (bf16*)(F.ws + WS_R)};
            pg8::gemm_phase<false>(F.lds, g, S, E, F.wv);
            if (REP2(5)) pg8::gemm_phase<false>(F.lds, g, S, E, F.wv);
        }
        LSEAM(p0 + 3);
        if (PHON(6) && IN(p0 + 4)) phase_ln1_router(F, kargs(), l);
        SEAM(p0 + 4);
        if (PHON(7) && IN(p0 + 5)) {
            LAS int* pstart = (LAS int*)(F.lds + RING_BYTES); LAS unsigned short* tord = (LAS unsigned short*)(F.lds + RING_BYTES + 512);
            const int* ecnt = (const int*)(F.ctl + CW_ECNT + l * 64);
            const int ntiles = moe_tables(F, ecnt, pstart, tord);
            pg8::Gemm g{(const bf16*)(F.ws + WS_HB), (const bf16*)(F.ws + WS_WGU) + (size_t)l * NE * 1024 * DM, DM, DM, (size_t)1024 * DM * 2};
            MoeOrder<true> S{4, ntiles * 4, F.G, F.vcu, tord, pstart, ecnt, (const int*)(F.ws + WS_LTOK)};
            EpiGU E{(bf16*)(F.ws + WS_ACT), kargs().in[I_BGU] + (size_t)l * NE * 1024};
            pg8::gemm_phase<true>(F.lds, g, S, E, F.wv);
            if (REP2(7)) pg8::gemm_phase<true>(F.lds, g, S, E, F.wv);
        }
        SEAM(p0 + 5);
        if (PHON(8) && IN(p0 + 6)) {
            LAS int* pstart = (LAS int*)(F.lds + RING_BYTES); LAS unsigned short* tord = (LAS unsigned short*)(F.lds + RING_BYTES + 512);
            const int* ecnt = (const int*)(F.ctl + CW_ECNT + l * 64);
            const int ntiles = moe_tables(F, ecnt, pstart, tord);
            pg8::Gemm g{(const bf16*)(F.ws + WS_ACT), (const bf16*)(F.ws + WS_WDN) + (size_t)l * NE * DM * DFF, DFF, DFF, (size_t)DM * DFF * 2};
            MoeOrder<false> S{8, ntiles * 8, F.G, F.vcu, tord, pstart, ecnt, nullptr};
            EpiDN E{(bf16*)(F.ws + WS_Y), kargs().in[I_BDN] + (size_t)l * NE * DM, (const float*)(F.ws + WS_LGATE), ecnt, pstart};
            pg8::gemm_phase<false>(F.lds, g, S, E, F.wv);
            if (REP2(8)) pg8::gemm_phase<false>(F.lds, g, S, E, F.wv);
        }
        SEAM(p0 + 6);
        if (PHON(9) && IN(p0 + 7)) { phase_ln2(F, kargs(), l); if (REP2(9)) phase_ln2(F, kargs(), l); }
        LSEAM(p0 + 7);
    }
#undef IN
#undef SEAM
}

extern "C" void kernel_launch(void* const* d_in, const int* in_sizes, int n_in, void* d_out, int out_size, void* d_ws, size_t ws_size, hipStream_t stream) {
    static int grid = 0;
    if (grid == 0) {
        if (n_in != 23 || out_size != NTOK * DM || ws_size < WS_END) { fprintf(stderr, "kernel_launch: unexpected shapes (n_in %d out %d ws %zu need %zu)\n", n_in, out_size, ws_size, (size_t)WS_END); grid = -1; return; }
        int dev = 0, cus = 0, per_cu = 0;
        if (hipGetDevice(&dev) != hipSuccess || hipDeviceGetAttribute(&cus, hipDeviceAttributeMultiprocessorCount, dev) != hipSuccess) { grid = -1; return; }
        if (hipFuncSetAttribute((const void*)mega_fwd, hipFuncAttributeMaxDynamicSharedMemorySize, LDS_BYTES) != hipSuccess) { fprintf(stderr, "kernel_launch: hipFuncSetAttribute failed\n"); grid = -1; return; }
        if (hipOccupancyMaxActiveBlocksPerMultiprocessor(&per_cu, (const void*)mega_fwd, NTHR, LDS_BYTES) != hipSuccess || per_cu < 1) fprintf(stderr, "kernel_launch: occupancy query says %d\n", per_cu);
        (void)hipGetLastError();
        grid = cus;
    }
    if (grid < 0) return;
    (void)hipMemsetAsync((char*)d_ws + WS_CTL, 0, CTL_ZERO_BYTES, stream);
    Args a{};
    for (int i = 0; i < 23; ++i) a.in[i] = (const float*)d_in[i];
    a.out = (float*)d_out; a.ws = (unsigned char*)d_ws;
#if ONE_LAUNCH
    a.ph_lo = 0; a.ph_hi = N_PHASES;
    hipLaunchKernelGGL(mega_fwd, dim3(grid), dim3(NTHR), LDS_BYTES, stream, a);
#else
    for (int p = 0; p < N_PHASES; ++p) { a.ph_lo = p; a.ph_hi = p + 1; hipLaunchKernelGGL(mega_fwd, dim3(grid), dim3(NTHR), LDS_BYTES, stream, a); }
#endif
}
```

```cpp
#include <hip/hip_runtime.h>
#include <cstdio>
#include <cstdint>

#ifndef ONE_LAUNCH
#define ONE_LAUNCH 1
#endif
#ifndef PHASE_MASK
#define PHASE_MASK 0xfffff
#endif
#define NO_MOE 0
#define PHON(k) ((PHASE_MASK >> (k)) & 1)
#ifndef HALF_MMA
#define HALF_MMA 1
#endif
#ifndef HALF_EPI
#define HALF_EPI 1
#endif
#ifndef REP_MASK
#define REP_MASK 0
#endif
#define REP2(k) ((REP_MASK >> (k)) & 1)

#define LAS __attribute__((address_space(3)))
#define GAS __attribute__((address_space(1)))
typedef unsigned short bf16;
typedef short bf16x8 __attribute__((ext_vector_type(8)));
typedef float f32x4 __attribute__((ext_vector_type(4)));
typedef float f32x2 __attribute__((ext_vector_type(2)));
typedef unsigned u32x4 __attribute__((ext_vector_type(4)));
typedef unsigned u32x2 __attribute__((ext_vector_type(2)));

constexpr int DM = 2048, NBATCH = 8, SEQ = 2048, NTOK = NBATCH * SEQ, DEPTH = 4;
constexpr int INTOT = 6800, NP = 6912;
constexpr int NE = 32, TOPK = 4, DFF = 512;
constexpr int NWAVES = 8, NTHR = 512;
constexpr float LN_EPS = 1e-5f, RMS_EPS = 1e-6f;
constexpr float DN_ALPHA = 1.681792830507429f;
constexpr float LOG2E = 1.4426950408889634f;
constexpr int MAXROWS = NTOK * TOPK + NE * 256;

constexpr int PC_AQN = 0, PC_AQR = 512, PC_CKV = 768, PC_AKR = 1024, PC_AIK = 1088, PC_AIQ = 1152, PC_AIW = 1664;
constexpr int PC_BQ = 1728, PC_BK = 1984, PC_BV = 2240, PC_BG = 2752;
constexpr int PC_CQ = 3264, PC_CK = 3776, PC_CV = 4288;
constexpr int PC_DQKV = 4800, PC_DZ = 6336, PC_DBA = 6848;
constexpr int SC_AQ = 0, SC_CKV = 768, SC_AKR = 1024, SC_AIQ = 1088, SC_AIK = 1600, SC_AIW = 1664, SC_BQ = 1672, SC_BK = 1928, SC_BV = 2184, SC_BG = 2696;
constexpr int SC_CQ = 3208, SC_CK = 3720, SC_CV = 4232, SC_DQKV = 4744, SC_DZ = 6280, SC_DB = 6792;

constexpr size_t MiB = 1u << 20;
constexpr size_t WS_CTL = 0, CTL_ZERO_BYTES = 1 * MiB;
constexpr size_t WS_CS = 1 * MiB;
constexpr size_t WS_WIN = 8 * MiB;
constexpr size_t WS_WKV = WS_WIN + 108 * MiB;
constexpr size_t WS_WOUT = WS_WKV + 2 * MiB;
constexpr size_t WS_WGU = WS_WOUT + 32 * MiB;
constexpr size_t WS_WDN = WS_WGU + 512 * MiB;
constexpr size_t WS_X = WS_WDN + 256 * MiB;
constexpr size_t WS_XB = WS_X + 128 * MiB;
constexpr size_t WS_P = WS_XB + 64 * MiB;
constexpr size_t WS_SIDE = WS_P + 216 * MiB;
constexpr size_t WS_GB = WS_SIDE, WS_IW = WS_SIDE + 512 * 1024, WS_SSQ = WS_SIDE + 1024 * 1024;
constexpr size_t WS_KN = WS_SIDE + 2 * MiB;
constexpr size_t WS_VAT = WS_KN + 16 * MiB;
constexpr size_t WS_HEADS = WS_VAT + 16 * MiB;
constexpr size_t WS_R = WS_HEADS + 64 * MiB;
constexpr size_t WS_H = WS_R + 128 * MiB;
constexpr size_t WS_HB = WS_H + 128 * MiB;
constexpr size_t WS_ACT = WS_HB + 64 * MiB;
constexpr size_t WS_Y = WS_ACT + 72 * MiB;
constexpr size_t WS_LTOK = WS_Y + 288 * MiB;
constexpr size_t WS_LGATE = WS_LTOK + 2 * MiB;
constexpr size_t WS_TSLOT = WS_LGATE + 2 * MiB;
constexpr size_t WS_MIX = WS_TSLOT + 1 * MiB;
constexpr size_t WS_BKV = WS_MIX;
constexpr size_t WS_CVT = WS_BKV + 16 * MiB;
constexpr size_t WS_MASK = WS_CVT + 16 * MiB;
constexpr size_t WS_DPRE = WS_MASK + 4 * MiB;
constexpr size_t WS_DW = WS_DPRE;
constexpr size_t WS_DQG = WS_DW + 16 * MiB;
constexpr size_t WS_DKDT = WS_DQG + 16 * MiB;
constexpr size_t WS_DATT = WS_DKDT + 16 * MiB;
constexpr size_t WS_DUT = WS_DATT + 8 * MiB;
constexpr size_t WS_DDL = WS_DUT + 32 * MiB;
constexpr size_t WS_END = WS_MIX + 512 * MiB;

constexpr int CW_BAR = 4096;
constexpr int CW_ECNT = 16384;
constexpr int CW_QUEUE = 20480;

constexpr int RING_BYTES = 131072;
constexpr int MISC_OFF = 135168;
constexpr int LDS_BYTES = 147456;

#define RLX_AGENT __ATOMIC_RELAXED, __HIP_MEMORY_SCOPE_AGENT
__device__ __forceinline__ unsigned f2bf(float f) { unsigned u = __builtin_bit_cast(unsigned, f); return (u + 0x7fffu + ((u >> 16) & 1u)) >> 16; }
typedef __bf16 bf16x2_t __attribute__((ext_vector_type(2)));
__device__ __forceinline__ unsigned pk2(float lo, float hi) { const f32x2 v = {lo, hi}; const bf16x2_t b = __builtin_convertvector(v, bf16x2_t); return __builtin_bit_cast(unsigned, b); }
__device__ __forceinline__ float bf2f(unsigned short h) { return __builtin_bit_cast(float, (unsigned)h << 16); }
__device__ __forceinline__ float bflo(unsigned w) { return __builtin_bit_cast(float, w << 16); }
__device__ __forceinline__ float bfhi(unsigned w) { return __builtin_bit_cast(float, w & 0xffff0000u); }
#define DPP_ADDF(v, ctrl, rmask) v += __builtin_bit_cast(float, __builtin_amdgcn_update_dpp(0, __builtin_bit_cast(int, v), ctrl, rmask, 0xf, false))
__device__ __forceinline__ float wave_sum(float v) {
    DPP_ADDF(v, 0x111, 0xf); DPP_ADDF(v, 0x112, 0xf); DPP_ADDF(v, 0x114, 0xf); DPP_ADDF(v, 0x118, 0xf);
    DPP_ADDF(v, 0x142, 0xa); DPP_ADDF(v, 0x143, 0xc);
    return __builtin_bit_cast(float, __builtin_amdgcn_readlane(__builtin_bit_cast(int, v), 63));
}
__device__ __forceinline__ void swap16(float& a, float& b) { asm volatile("s_nop 1\n\tv_permlane16_swap_b32 %0, %1\n\ts_nop 1" : "+v"(a), "+v"(b)); }
__device__ __forceinline__ void swap32(float& a, float& b) { asm volatile("s_nop 1\n\tv_permlane32_swap_b32 %0, %1\n\ts_nop 1" : "+v"(a), "+v"(b)); }
__device__ __forceinline__ float sum_x16_x32(float x) {
    float a = x, b = x; swap16(a, b); x = a + b;
    a = x; b = x; swap32(a, b); return a + b;
}
__device__ __forceinline__ float fast_exp2(float x) { return __builtin_amdgcn_exp2f(x); }
__device__ __forceinline__ float sigmoidf_(float x) { return 1.0f / (1.0f + __expf(-x)); }

#define XB_TMO      128
#define XB_XCNT(j)  (256  + 64 * (j))
#define XB_XSUB(j)  (1280 + 64 * (j))
#define XB_XGEN(j)  (2304 + 64 * (j))
#define XB_TOP      3328
#define XB_TOPGEN   3392
#define XCD_BAR_WORDS 3456
#define XB_SPIN_CAP (1u << 22)
__device__ __forceinline__ unsigned xb_ld(unsigned* p)              { return __hip_atomic_load(p, __ATOMIC_RELAXED, __HIP_MEMORY_SCOPE_AGENT); }
__device__ __forceinline__ unsigned xb_add(unsigned* p, unsigned v) { return __hip_atomic_fetch_add(p, v, __ATOMIC_RELAXED, __HIP_MEMORY_SCOPE_AGENT); }
__device__ __forceinline__ unsigned xb_xcc_id() { return (unsigned)__builtin_amdgcn_s_getreg((3 << 11) | 20) & 0xFu; }
#define XB_SPIN(cond, bar) do { unsigned _sp = 0; while (cond) { __builtin_amdgcn_s_sleep(1); \
    if ((++_sp & 255u) == 0u) { if (xb_ld(&(bar)[XB_TMO])) break; if (_sp > XB_SPIN_CAP) { atomicAdd(&(bar)[XB_TMO], 1u); break; } } } } while (0)
__device__ __forceinline__ int lane_now() { int l; asm volatile("v_mbcnt_lo_u32_b32 %0, -1, 0\n\tv_mbcnt_hi_u32_b32 %0, -1, %0" : "=v"(l)); return l; }
struct XcdBarrier { unsigned* bar; unsigned x; volatile LAS unsigned* st; int wv; };
__device__ __forceinline__ XcdBarrier xcd_barrier_post(unsigned* bar, volatile LAS unsigned* st) {
    XcdBarrier b; b.bar = bar; b.x = xb_xcc_id(); b.st = st; b.wv = __builtin_amdgcn_readfirstlane((int)threadIdx.x >> 6);
    if (threadIdx.x == 0) (void)xb_add(&bar[XB_XCNT(b.x)], 1u);
    return b;
}
__device__ __forceinline__ void xcd_barrier_complete(unsigned* bar, unsigned x, unsigned& nloc, unsigned& nx) {
    const unsigned G = gridDim.x * gridDim.y * gridDim.z;
    unsigned sum, cnt, mine, sp = 0u;
    for (;;) {
        sum = 0u; cnt = 0u; mine = 0u;
#pragma unroll
        for (unsigned j = 0; j < 16; ++j) { const unsigned c = xb_ld(&bar[XB_XCNT(j)]); sum += c; cnt += (c > 0u) ? 1u : 0u; mine = (j == x) ? c : mine; }
        if (sum == G) break;
        __builtin_amdgcn_s_sleep(1);
        if ((++sp & 255u) == 0u) { if (xb_ld(&bar[XB_TMO])) break; if (sp > XB_SPIN_CAP) { atomicAdd(&bar[XB_TMO], 1u); break; } }
    }
    nloc = mine > 0u ? mine : 1u; nx = cnt > 0u ? cnt : 1u;
}
#define XB_LSUB(j)  (3584 + 64 * (j))
#define XB_LGEN(j)  (4608 + 64 * (j))
__device__ __forceinline__ void xcd_local_barrier(const XcdBarrier& b) {
    asm volatile("s_waitcnt vmcnt(0)" ::: "memory");
    __syncthreads();
    if (b.wv == 0 && lane_now() == 0) {
        unsigned* bar = b.bar;
        __builtin_amdgcn_s_waitcnt(0);
        unsigned nloc = b.st[0], nx = b.st[1];
        if (nloc == 0u) { xcd_barrier_complete(bar, b.x, nloc, nx); b.st[0] = nloc; b.st[1] = nx; }
        const unsigned old = xb_add(&bar[XB_LSUB(b.x)], 1u);
        const unsigned gen = old / nloc;
        if (old + 1u == (gen + 1u) * nloc) xb_add(&bar[XB_LGEN(b.x)], 1u);
        else XB_SPIN(xb_ld(&bar[XB_LGEN(b.x)]) == gen, bar);
        __builtin_amdgcn_fence(__ATOMIC_ACQUIRE, "agent");
        asm volatile("s_waitcnt vmcnt(0)" ::: "memory");
    }
    __syncthreads();
}
__device__ __forceinline__ void xcd_barrier(const XcdBarrier& b) {
    asm volatile("s_waitcnt vmcnt(0)" ::: "memory");
    __syncthreads();
    if (b.wv == 0 && lane_now() == 0) {
        unsigned* bar = b.bar;
        __builtin_amdgcn_s_waitcnt(0);
        unsigned nloc = b.st[0], nx = b.st[1];
        if (nloc == 0u) { xcd_barrier_complete(bar, b.x, nloc, nx); b.st[0] = nloc; b.st[1] = nx; }
        const unsigned old = xb_add(&bar[XB_XSUB(b.x)], 1u);
        const unsigned gen = old / nloc;
        if (old + 1u == (gen + 1u) * nloc) {
            __builtin_amdgcn_fence(__ATOMIC_RELEASE, "agent");
            asm volatile("s_waitcnt vmcnt(0)" ::: "memory");
            const unsigned og = xb_add(&bar[XB_TOP], 1u);
            const unsigned tg = og / nx;
            if (og + 1u == (tg + 1u) * nx) xb_add(&bar[XB_TOPGEN], 1u);
            else XB_SPIN(xb_ld(&bar[XB_TOPGEN]) == tg, bar);
            __builtin_amdgcn_fence(__ATOMIC_ACQUIRE, "agent");
            xb_add(&bar[XB_XGEN(b.x)], 1u);
            asm volatile("s_waitcnt vmcnt(0)" ::: "memory");
        } else {
            XB_SPIN(xb_ld(&bar[XB_XGEN(b.x)]) == gen, bar);
            __builtin_amdgcn_fence(__ATOMIC_ACQUIRE, "agent");
            asm volatile("s_waitcnt vmcnt(0)" ::: "memory");
        }
    }
    __syncthreads();
}

namespace pg8 {
constexpr int BM = 256, BK = 64, HALF = 128, HTB = HALF * BK * 2, STAGE_BYTES = 8 * HTB;
__host__ __device__ __forceinline__ int lds_byte(int r, int c) { const int st = (r >> 4) * 2 + (c >> 5), rr = r & 15, cc = c & 31, ob = rr * 64 + cc * 2; return st * 1024 + (ob ^ (((ob >> 9) & 1) << 5)); }
__host__ __device__ __forceinline__ void stage_rc(int b, int& R, int& C) { const int st = b / 1024, sb = b % 1024, swz = sb ^ (((sb >> 9) & 1) << 5); R = (st >> 1) * 16 + swz / 64; C = (st & 1) * 32 + (swz % 64) / 2; }
__host__ __device__ __forceinline__ int perm32(int rho) { const int n = rho >> 4, i = rho & 15; return 8 * (i >> 2) + 4 * n + (i & 3); }

struct Unit { int pm, pn, e, hf; };
struct Gemm { const bf16* A; const bf16* Bt; int lda; int K; size_t b_estride; };

template <bool GATHER, class Epi, class Sched>
__device__ __forceinline__ void gemm_phase(LAS unsigned char* lds, const Gemm g, const Sched& S, const Epi& E, int wv) {
    int tid_ = wv * 64 + lane_now(); asm volatile("" : "+v"(tid_));
    const int tid = tid_, wid = __builtin_amdgcn_readfirstlane(tid >> 6), lane = tid & 63, wr = wid >> 2, wc = wid & 3, fr = lane & 15, fq = lane >> 4;
    const int K = g.K, nt = K / BK;
    int Rst[2], Cst[2]; unsigned voffB[2], voffA[2];
#pragma unroll
    for (int i = 0; i < 2; ++i) { int R, C; stage_rc(tid * 16 + i * 8192, R, C); Rst[i] = R; Cst[i] = C; const int Rb = Epi::PERM ? ((R & ~31) + perm32(R & 31)) : R; voffB[i] = (unsigned)(Rb * K + C) * 2u; voffA[i] = (unsigned)(R * g.lda + C) * 2u; }
    const size_t kstep = (size_t)(BK * 2);
    const size_t hstepB = (size_t)HALF * K * 2, hstepA = (size_t)HALF * g.lda * 2;
    const unsigned ldsw = (unsigned)wid * 1024u;
    const int aoff = lds_byte(wr * 64 + fr, fq * 8), boff = lds_byte(wc * 32 + fr, fq * 8);
#define PG8_SA(b, h) (((b) * 2 + (h)) * HTB)
#define PG8_SB(b, h) ((4 + (b) * 2 + (h)) * HTB)
#define PG8_STAGE(bufoff, gbase, v0, v1) do { \
        __builtin_amdgcn_global_load_lds((const unsigned*)((const char*)(gbase) + (v0)), (LAS unsigned*)(lds + (bufoff) + ldsw), 16, 0, 0); \
        __builtin_amdgcn_global_load_lds((const unsigned*)((const char*)(gbase) + (v1)), (LAS unsigned*)(lds + (bufoff) + ldsw + 8192), 16, 0, 0); } while (0)
#define PG8_STB(bufoff, gbase) PG8_STAGE(bufoff, gbase, voffB[0], voffB[1])
#define PG8_STA_CUR(bufoff, gbase, h) do { if constexpr (GATHER) PG8_STAGE(bufoff, gbase, vc[h][0], vc[h][1]); else PG8_STAGE(bufoff, (gbase) + (h) * hstepA, voffA[0], voffA[1]); } while (0)
#define PG8_STA_SEL(bufoff, gbase, h) do { if constexpr (GATHER) PG8_STAGE(bufoff, gbase, vs[h][0], vs[h][1]); else PG8_STAGE(bufoff, (gbase) + (h) * hstepA, voffA[0], voffA[1]); } while (0)
#define PG8_LDA(dst, b, h) do { _Pragma("unroll") for (int m = 0; m < 4; ++m) _Pragma("unroll") for (int k = 0; k < 2; ++k) dst[m][k] = *(const LAS bf16x8*)(lds + PG8_SA(b, h) + aoff + m * 2048 + k * 1024); } while (0)
#define PG8_LDB(dst, b, h) do { _Pragma("unroll") for (int n = 0; n < 2; ++n) _Pragma("unroll") for (int k = 0; k < 2; ++k) dst[n][k] = *(const LAS bf16x8*)(lds + PG8_SB(b, h) + boff + n * 2048 + k * 1024); } while (0)
#define PG8_MMA(ai, bj, At, Bt) do { __builtin_amdgcn_s_setprio(1); _Pragma("unroll") for (int m = 0; m < 4; ++m) _Pragma("unroll") for (int n = 0; n < 2; ++n) _Pragma("unroll") for (int k = 0; k < 2; ++k) \
        acc[ai][bj][m][n] = __builtin_amdgcn_mfma_f32_16x16x32_bf16(Bt[n][k], At[m][k], acc[ai][bj][m][n], 0, 0, 0); __builtin_amdgcn_s_setprio(0); } while (0)
#define PG8_WAIT_V(n) asm volatile("s_waitcnt vmcnt(" #n ")" ::: "memory")
#define PG8_WAIT_L(n) asm volatile("s_waitcnt lgkmcnt(" #n ")" ::: "memory")
#define PG8_BAR __builtin_amdgcn_s_barrier()
#define PG8_SCHED __builtin_amdgcn_sched_barrier(0)
    Unit cur, nxt; int ui = 0;
    if (!S.next(0, cur)) return;
    f32x4 acc[2][2][4][2];
#pragma unroll
    for (int a = 0; a < 2; ++a)
#pragma unroll
        for (int b = 0; b < 2; ++b)
#pragma unroll
            for (int m = 0; m < 4; ++m)
#pragma unroll
                for (int n = 0; n < 2; ++n) acc[a][b][m][n] = (f32x4){0.f, 0.f, 0.f, 0.f};
    bf16x8 At[4][2], B0[2][2], B1[2][2];
    unsigned vc[2][2], vn[2][2];
    if constexpr (GATHER) S.a_off(cur, Rst, Cst, g.lda, vc);
    const char* cA = S.a_base(cur, g); const char* cB = (const char*)g.Bt + (size_t)cur.e * g.b_estride + (size_t)cur.pn * 2 * hstepB;
    PG8_STB(PG8_SB(0, 0), cB); PG8_STB(PG8_SB(0, 1), cB + hstepB); PG8_STA_CUR(PG8_SA(0, 0), cA, 0); PG8_STA_CUR(PG8_SA(0, 1), cA, 1);
    if (wr == 1) PG8_BAR;
    PG8_WAIT_V(2); PG8_BAR;
    PG8_STB(PG8_SB(1, 0), cB + kstep); PG8_STA_CUR(PG8_SA(1, 0), cA + kstep, 0); PG8_STB(PG8_SB(1, 1), cB + hstepB + kstep);
    PG8_WAIT_V(6); PG8_BAR;
    for (;;) {
        const bool has_next = S.next(ui + 1, nxt);
        const char* nA = cA; const char* nB = cB;
        if constexpr (GATHER) {
#pragma unroll
            for (int h = 0; h < 2; ++h) { vn[h][0] = vc[h][0]; vn[h][1] = vc[h][1]; } }
        if (has_next) { nA = S.a_base(nxt, g); nB = (const char*)g.Bt + (size_t)nxt.e * g.b_estride + (size_t)nxt.pn * 2 * hstepB; if constexpr (GATHER) S.a_off(nxt, Rst, Cst, g.lda, vn); }
        float pre[8];
        if constexpr (Epi::HAS_PRE) E.pre(cur, wr, fr, pre);
        if (HALF_MMA && Sched::HAS_HALF && cur.hf) {
#pragma nounroll
        for (int t = 0; t < nt; t += 2) {
            const bool last = (t == nt - 2);
            const char* a1 = cA + (size_t)(t + 1) * kstep;
            const char* a2 = last ? nA : cA + (size_t)(t + 2) * kstep; const char* b2 = last ? nB : cB + (size_t)(t + 2) * kstep;
            const char* a3 = a2 + kstep; const char* b3 = b2 + kstep;
            unsigned vs[2][2];
            if constexpr (GATHER) { vs[0][0] = last ? vn[0][0] : vc[0][0]; vs[0][1] = last ? vn[0][1] : vc[0][1]; vs[1][0] = last ? vn[1][0] : vc[1][0]; vs[1][1] = last ? vn[1][1] : vc[1][1]; }
            PG8_LDB(B0, 0, 0); PG8_LDB(B1, 0, 1); PG8_SCHED; PG8_LDA(At, 0, 0); PG8_STA_CUR(PG8_SA(1, 1), a1, 1);
            PG8_WAIT_V(8); PG8_WAIT_L(0); PG8_BAR; PG8_MMA(0, 0, At, B0); PG8_MMA(0, 1, At, B1); PG8_BAR; PG8_SCHED;
            PG8_LDA(At, 0, 1); PG8_STB(PG8_SB(0, 0), b2); PG8_STB(PG8_SB(0, 1), b2 + hstepB); PG8_STA_SEL(PG8_SA(0, 0), a2, 0);
            PG8_WAIT_V(8); PG8_WAIT_L(0); PG8_BAR;  PG8_BAR; PG8_SCHED;
            PG8_LDB(B0, 1, 0); PG8_LDB(B1, 1, 1); PG8_SCHED; PG8_LDA(At, 1, 0); PG8_STA_SEL(PG8_SA(0, 1), a2, 1);
            PG8_WAIT_V(8); PG8_WAIT_L(0); PG8_BAR; PG8_MMA(0, 0, At, B0); PG8_MMA(0, 1, At, B1); PG8_BAR; PG8_SCHED;
            PG8_LDA(At, 1, 1); PG8_STB(PG8_SB(1, 0), b3); PG8_STB(PG8_SB(1, 1), b3 + hstepB); PG8_STA_SEL(PG8_SA(1, 0), a3, 0);
            PG8_WAIT_V(8); PG8_WAIT_L(0); PG8_BAR;  PG8_BAR; PG8_SCHED;
        }
        } else {
#pragma nounroll
        for (int t = 0; t < nt; t += 2) {
            const bool last = (t == nt - 2);
            const char* a1 = cA + (size_t)(t + 1) * kstep;
            const char* a2 = last ? nA : cA + (size_t)(t + 2) * kstep; const char* b2 = last ? nB : cB + (size_t)(t + 2) * kstep;
            const char* a3 = a2 + kstep; const char* b3 = b2 + kstep;
            unsigned vs[2][2];
            if constexpr (GATHER) { vs[0][0] = last ? vn[0][0] : vc[0][0]; vs[0][1] = last ? vn[0][1] : vc[0][1]; vs[1][0] = last ? vn[1][0] : vc[1][0]; vs[1][1] = last ? vn[1][1] : vc[1][1]; }
            PG8_LDB(B0, 0, 0); PG8_LDB(B1, 0, 1); PG8_SCHED; PG8_LDA(At, 0, 0); PG8_STA_CUR(PG8_SA(1, 1), a1, 1);
            PG8_WAIT_V(8); PG8_WAIT_L(0); PG8_BAR; PG8_MMA(0, 0, At, B0); PG8_MMA(0, 1, At, B1); PG8_BAR; PG8_SCHED;
            PG8_LDA(At, 0, 1); PG8_STB(PG8_SB(0, 0), b2); PG8_STB(PG8_SB(0, 1), b2 + hstepB); PG8_STA_SEL(PG8_SA(0, 0), a2, 0);
            PG8_WAIT_V(8); PG8_WAIT_L(0); PG8_BAR; PG8_MMA(1, 0, At, B0); PG8_MMA(1, 1, At, B1); PG8_BAR; PG8_SCHED;
            PG8_LDB(B0, 1, 0); PG8_LDB(B1, 1, 1); PG8_SCHED; PG8_LDA(At, 1, 0); PG8_STA_SEL(PG8_SA(0, 1), a2, 1);
            PG8_WAIT_V(8); PG8_WAIT_L(0); PG8_BAR; PG8_MMA(0, 0, At, B0); PG8_MMA(0, 1, At, B1); PG8_BAR; PG8_SCHED;
            PG8_LDA(At, 1, 1); PG8_STB(PG8_SB(1, 0), b3); PG8_STB(PG8_SB(1, 1), b3 + hstepB); PG8_STA_SEL(PG8_SA(1, 0), a3, 0);
            PG8_WAIT_V(8); PG8_WAIT_L(0); PG8_BAR; PG8_MMA(1, 0, At, B0); PG8_MMA(1, 1, At, B1); PG8_BAR; PG8_SCHED;
        }
        }
        if (wr == 0) PG8_BAR;
        if constexpr (Epi::HAS_PRE) E.apply(acc, cur, wr, wc, fr, fq, pre); else E(acc, cur, wr, wc, fr, fq);
        if (!has_next) break;
#pragma unroll
        for (int a = 0; a < 2; ++a)
#pragma unroll
            for (int b = 0; b < 2; ++b)
#pragma unroll
                for (int m = 0; m < 4; ++m)
#pragma unroll
                    for (int n = 0; n < 2; ++n) acc[a][b][m][n] = (f32x4){0.f, 0.f, 0.f, 0.f};
        cur = nxt; cA = nA; cB = nB; ++ui;
        if constexpr (GATHER) {
#pragma unroll
            for (int h = 0; h < 2; ++h) { vc[h][0] = vn[h][0]; vc[h][1] = vn[h][1]; } }
        if (wr == 1) PG8_BAR;
    }
    PG8_WAIT_V(0);
    PG8_BAR;
#undef PG8_SA
#undef PG8_SB
#undef PG8_STAGE
#undef PG8_STB
#undef PG8_STA_CUR
#undef PG8_STA_SEL
#undef PG8_LDA
#undef PG8_LDB
#undef PG8_MMA
#undef PG8_WAIT_V
#undef PG8_WAIT_L
#undef PG8_BAR
#undef PG8_SCHED
}

struct DenseOrder {
    static constexpr bool HAS_HALF = false;
    int nM, nN, nwg, G, c, e;
    __device__ void init(int M, int N, int G_, int c_) { nM = M / BM; nN = N / BM; nwg = nM * nN; G = G_; c = c_; e = 0; }
    __device__ __forceinline__ bool next(int i, Unit& u) const {
        const long L = (long)i * G + c; if (L >= nwg) return false;
        int wgid = (int)L; { const int q = nwg / 8, r = nwg % 8, xcd = wgid % 8, off = wgid / 8; wgid = (xcd < r ? xcd * (q + 1) : r * (q + 1) + (xcd - r) * q) + off; }
        const int nig = 8 * nN, gid = wgid / nig, fm = gid * 8, gsz = (nM - fm) < 8 ? (nM - fm) : 8;
        u.pm = fm + ((wgid % nig) % gsz); u.pn = (wgid % nig) / gsz; u.e = e; u.hf = 0; return true;
    }
    __device__ __forceinline__ const char* a_base(const Unit& u, const Gemm& g) const { return (const char*)g.A + (size_t)u.pm * 256 * g.lda * 2; }
    __device__ __forceinline__ void a_off(const Unit&, const int (&R)[2], const int (&C)[2], int lda, unsigned (&v)[2][2]) const {
#pragma unroll
        for (int h = 0; h < 2; ++h)
#pragma unroll
            for (int i = 0; i < 2; ++i) v[h][i] = (unsigned)((h * 128 + R[i]) * lda + C[i]) * 2u;
    }
};
struct OwnOrder {
    static constexpr bool HAS_HALF = false;
    unsigned long long own; int nN, n;
    __device__ __forceinline__ bool next(int i, Unit& u) const {
        if (i >= n) return false;
        unsigned long long m = own; const int k = i / nN;
        for (int j = 0; j < k; ++j) m &= m - 1ull;
        u.pm = __builtin_ctzll(m); u.pn = i % nN; u.e = 0; u.hf = 0; return true;
    }
    __device__ __forceinline__ const char* a_base(const Unit& u, const Gemm& g) const { return (const char*)g.A + (size_t)u.pm * 256 * g.lda * 2; }
    __device__ __forceinline__ void a_off(const Unit&, const int (&R)[2], const int (&C)[2], int lda, unsigned (&v)[2][2]) const {
#pragma unroll
        for (int h = 0; h < 2; ++h)
#pragma unroll
            for (int i = 0; i < 2; ++i) v[h][i] = (unsigned)((h * 128 + R[i]) * lda + C[i]) * 2u;
    }
};
}

struct Args {
    const float* in[23]; float* out; unsigned char* ws; int ph_lo, ph_hi;
};
enum { I_X = 0, I_POS, I_WIN, I_WOUT, I_KVN, I_WUK, I_WUV, I_CLAM, I_CSUB, I_DCONV, I_DALOG, I_DDT, I_DNORM, I_LN1G, I_LN1B, I_WR, I_BR, I_WGU, I_BGU, I_WDN, I_BDN, I_LN2G, I_LN2B };

struct Frame {
    LAS unsigned char* lds; int tid, lane, wave, G, vcu, wv; unsigned char* ws; unsigned* ctl;
};
#define CAS __attribute__((address_space(4)))
__device__ __forceinline__ const CAS Args& kargs() { const CAS Args* p = (const CAS Args*)__builtin_amdgcn_kernarg_segment_ptr(); asm volatile("" : "+s"(p)); return *p; }
__device__ __forceinline__ void frame_refresh(Frame& F) { int t = F.wv * 64 + lane_now(); asm volatile("" : "+v"(t)); F.tid = t; F.lane = t & 63; F.wave = __builtin_amdgcn_readfirstlane(t >> 6); }

__device__ __forceinline__ void cvt_item(const float* W, int ldw, int k0, bf16* dst, int Kdst, int r0, int srccol, float scale, const float* kscale, LAS float* scr, int lane) {
#pragma unroll
    for (int kk = 0; kk < 64; ++kk) {
        float v = 0.f;
        if (srccol >= 0) v = __builtin_nontemporal_load(W + (size_t)(k0 + kk) * ldw + srccol) * scale;
        if (kscale) v *= kscale[k0 + kk];
        scr[kk * 65 + lane] = v;
    }
    asm volatile("s_waitcnt lgkmcnt(0)" ::: "memory");
    const int c = lane & 7;
#pragma unroll
    for (int j = 0; j < 8; ++j) {
        const int n = (lane >> 3) + 8 * j; const LAS float* s = scr + (8 * c) * 65 + n;
        u32x4 o; o.x = pk2(s[0], s[65]); o.y = pk2(s[2 * 65], s[3 * 65]); o.z = pk2(s[4 * 65], s[5 * 65]); o.w = pk2(s[6 * 65], s[7 * 65]);
        *(u32x4*)(dst + (size_t)(r0 + n) * Kdst + k0 + 8 * c) = o;
    }
    asm volatile("s_waitcnt lgkmcnt(0)" ::: "memory");
}

__device__ __forceinline__ bool inproj_is_rot(int g) { return (g >= 8 && g < 12) || (g >= 16 && g < 26) || (g >= 27 && g < 35) || (g >= 51 && g < 67); }
__device__ __forceinline__ void inproj_map(int r, int& sc, float& scale) {
    const int g = r >> 6; int p = r & 63; scale = 1.f;
    if (inproj_is_rot(g)) p = (p >> 1) + 32 * (p & 1);
    const float qa = 0.07216878364870322f * LOG2E;
    if (g < 8) { const int h = g >> 1; sc = SC_AQ + h * 192 + (g & 1) * 64 + p; scale = qa; }
    else if (g < 12) { sc = SC_AQ + (g - 8) * 192 + 128 + p; scale = qa; }
    else if (g < 16) sc = SC_CKV + (g - 12) * 64 + p;
    else if (g == 16) sc = SC_AKR + p;
    else if (g == 17) sc = SC_AIK + p;
    else if (g < 26) sc = SC_AIQ + (g - 18) * 64 + p;
    else if (g == 26) { sc = p < 8 ? SC_AIW + p : -1; scale = 0.04419417382415922f; }
    else if (g < 31) sc = SC_BQ + (g - 27) * 64 + p;
    else if (g < 35) { sc = SC_BK + (g - 31) * 64 + p; scale = 0.125f; }
    else if (g < 43) sc = SC_BV + (g - 35) * 64 + p;
    else if (g < 51) sc = SC_BG + (g - 43) * 64 + p;
    else if (g < 59) { sc = SC_CQ + (g - 51) * 64 + p; scale = 0.125f * LOG2E; }
    else if (g < 67) sc = SC_CK + (g - 59) * 64 + p;
    else if (g < 75) sc = SC_CV + (g - 67) * 64 + p;
    else if (g < 99) sc = SC_DQKV + (g - 75) * 64 + p;
    else if (g < 107) sc = SC_DZ + (g - 99) * 64 + p;
    else sc = p < 8 ? SC_DB + p : -1;
}

struct CvtP { const float* W; int ldw, k0; bf16* dst; int Kdst, r0, srccol; float scale; const float* ks; };
__device__ __forceinline__ void phase_prologue(Frame& F, const CAS Args& a) {
    LAS float* scr = (LAS float*)(F.lds + F.wave * 16640);
    const int gw = F.vcu * NWAVES + F.wave, NGW = F.G * NWAVES;
    bf16* Win = (bf16*)(F.ws + WS_WIN); bf16* Wkv = (bf16*)(F.ws + WS_WKV); bf16* Wout = (bf16*)(F.ws + WS_WOUT); bf16* Wgu = (bf16*)(F.ws + WS_WGU); bf16* Wdn = (bf16*)(F.ws + WS_WDN);
    constexpr int I_IN = DEPTH * (NP / 64) * (DM / 64);
    constexpr int I_KV = DEPTH * (1024 / 64) * (256 / 64);
    constexpr int I_OUT = DEPTH * (DM / 64) * (DM / 64);
    constexpr int I_GU = DEPTH * NE * (1024 / 64) * (DM / 64);
    constexpr int I_DN = DEPTH * NE * (DM / 64) * (DFF / 64);
    constexpr int NITEMS = I_IN + I_KV + I_OUT + I_GU + I_DN;
    auto decode = [&](int it, CvtP& p) {
        int r = it;
        if (r < I_IN) { const int l = r / ((NP / 64) * 32), q = r % ((NP / 64) * 32), rb = q / 32, kb = q % 32; int sc; float s; inproj_map(rb * 64 + F.lane, sc, s);
            p = CvtP{a.in[I_WIN] + (size_t)l * DM * INTOT, INTOT, kb * 64, Win + (size_t)l * NP * DM, DM, rb * 64, sc, s, nullptr}; return; }
        r -= I_IN;
        if (r < I_KV) { const int l = r / 64, q = r % 64, rb = q / 4, kb = q % 4; const int row = rb * 64 + F.lane;
            const float* src = (row < 512 ? a.in[I_WUK] : a.in[I_WUV]) + (size_t)l * 256 * 512;
            p = CvtP{src, 512, kb * 64, Wkv + (size_t)l * 1024 * 256, 256, rb * 64, row & 511, 1.f, a.in[I_KVN] + l * 256}; return; }
        r -= I_KV;
        if (r < I_OUT) { const int l = r / 1024, q = r % 1024, rb = q / 32, kb = q % 32;
            p = CvtP{a.in[I_WOUT] + (size_t)l * DM * DM, DM, kb * 64, Wout + (size_t)l * DM * DM, DM, rb * 64, rb * 64 + F.lane, 1.f, nullptr}; return; }
        r -= I_OUT;
        if (r < I_GU) { const int le = r / 512, q = r % 512, rb = q / 32, kb = q % 32; const int row = rb * 64 + F.lane;
            p = CvtP{a.in[I_WGU] + (size_t)le * DM * 1024, 1024, kb * 64, Wgu + (size_t)le * 1024 * DM, DM, rb * 64, (row >> 1) + 512 * (row & 1), 1.f, nullptr}; return; }
        r -= I_GU;
        { const int le = r / 256, q = r % 256, rb = q / 8, kb = q % 8;
            p = CvtP{a.in[I_WDN] + (size_t)le * DFF * DM, DM, kb * 64, Wdn + (size_t)le * DM * DFF, DFF, rb * 64, rb * 64 + F.lane, 1.f, nullptr}; }
    };
    CvtP pc; float rv[64];
    auto loadraw = [&](const CvtP& p) {
#pragma unroll
        for (int kk = 0; kk < 64; ++kk) rv[kk] = (p.srccol >= 0) ? __builtin_nontemporal_load(p.W + (size_t)(p.k0 + kk) * p.ldw + p.srccol) : 0.f;
    };
    int it = gw;
    if (it < NITEMS) { decode(it, pc); loadraw(pc); }
    while (it < NITEMS) {
#pragma unroll
        for (int kk = 0; kk < 64; ++kk) { float v = rv[kk] * pc.scale; if (pc.ks) v *= pc.ks[pc.k0 + kk]; scr[kk * 65 + F.lane] = v; }
        asm volatile("s_waitcnt lgkmcnt(0)" ::: "memory");
        const int nx = it + NGW; CvtP pn = pc;
        if (nx < NITEMS) { decode(nx, pn); loadraw(pn); }
        const int c = F.lane & 7;
#pragma unroll
        for (int j = 0; j < 8; ++j) {
            const int n = (F.lane >> 3) + 8 * j; const LAS float* sp = scr + (8 * c) * 65 + n;
            u32x4 o; o.x = pk2(sp[0], sp[65]); o.y = pk2(sp[2 * 65], sp[3 * 65]); o.z = pk2(sp[4 * 65], sp[5 * 65]); o.w = pk2(sp[6 * 65], sp[7 * 65]);
            *(u32x4*)(pc.dst + (size_t)(pc.r0 + n) * pc.Kdst + pc.k0 + 8 * c) = o;
        }
        asm volatile("s_waitcnt lgkmcnt(0)" ::: "memory");
        pc = pn; it = nx;
    }
    {
        const f32x4* x4 = (const f32x4*)a.in[I_X]; u32x2* xb = (u32x2*)(F.ws + WS_XB);
        const size_t n4 = (size_t)NTOK * DM / 4;
        const size_t stride = (size_t)F.G * NTHR;
        for (size_t i0 = (size_t)(F.vcu * NTHR + F.tid); i0 < n4; i0 += 8 * stride) {
            f32x4 v[8];
#pragma unroll
            for (int u = 0; u < 8; ++u) { const size_t i = i0 + u * stride; v[u] = (i < n4) ? __builtin_nontemporal_load(x4 + i) : (f32x4){0.f, 0.f, 0.f, 0.f}; }
#pragma unroll
            for (int u = 0; u < 8; ++u) { const size_t i = i0 + u * stride; if (i < n4) { u32x2 o; o.x = pk2(v[u].x, v[u].y); o.y = pk2(v[u].z, v[u].w); xb[i] = o; } }
        }
    }
    {
        const int* pos = (const int*)a.in[I_POS]; f32x2* cs = (f32x2*)(F.ws + WS_CS);
        for (int i = F.vcu * NTHR + F.tid; i < NTOK * 32; i += F.G * NTHR) {
            const int tok = i >> 5, j = i & 31; const double inv = exp2(-(double)j * (13.287712379549449 / 32.0));
            const float angf = (float)pos[tok] * (float)inv;
            double s, c; sincos((double)angf, &s, &c); cs[i] = (f32x2){(float)c, (float)s};
        }
    }
}

__host__ __device__ __forceinline__ int vperm32(int k) { return 8 * ((k >> 2) & 3) + 4 * (k >> 4) + (k & 3); }
struct EpiInProj {
    static constexpr bool PERM = true, HAS_PRE = false;
    bf16* P; const f32x2* cs; float* gb; float* iw; float* ssq; const float* a_log; const float* dt_bias;
    __device__ __forceinline__ void operator()(const f32x4 (&acc)[2][2][4][2], const pg8::Unit& u, int wr, int wc, int fr, int fq) const {
        const int row0 = u.pm * 256 + wr * 64 + fr;
#pragma unroll
        for (int bj = 0; bj < 2; ++bj) {
            const int c0 = u.pn * 256 + bj * 128 + wc * 32 + 8 * fq; const int g = c0 >> 6;
            if (inproj_is_rot(g)) {
                const int j0 = (c0 & 63) >> 1;
#pragma unroll
                for (int ai = 0; ai < 2; ++ai) {
                    f32x4 csa[4], csb[4];
#pragma unroll
                    for (int m = 0; m < 4; ++m) { const int row = row0 + ai * 128 + m * 16; csa[m] = *(const f32x4*)(cs + (size_t)row * 32 + j0); csb[m] = *(const f32x4*)(cs + (size_t)row * 32 + j0 + 2); }
#pragma unroll
                    for (int m = 0; m < 4; ++m) {
                        const int row = row0 + ai * 128 + m * 16; const f32x4 v0 = acc[ai][bj][m][0], v1 = acc[ai][bj][m][1];
                        const f32x4 cs01 = csa[m], cs23 = csb[m];
                        const float a0 = v0.x * cs01.x - v0.y * cs01.y, b0 = v0.y * cs01.x + v0.x * cs01.y;
                        const float a1 = v0.z * cs01.z - v0.w * cs01.w, b1 = v0.w * cs01.z + v0.z * cs01.w;
                        const float a2 = v1.x * cs23.x - v1.y * cs23.y, b2 = v1.y * cs23.x + v1.x * cs23.y;
                        const float a3 = v1.z * cs23.z - v1.w * cs23.w, b3 = v1.w * cs23.z + v1.z * cs23.w;
                        bf16* rp = P + (size_t)row * NP + (g << 6) + j0;
                        u32x2 lo, hi; lo.x = pk2(a0, a1); lo.y = pk2(a2, a3); hi.x = pk2(b0, b1); hi.y = pk2(b2, b3);
                        *(u32x2*)rp = lo; *(u32x2*)(rp + 32) = hi;
                    }
                    asm volatile("" ::: "memory");
                }
            } else {
#pragma unroll
                for (int ai = 0; ai < 2; ++ai)
#pragma unroll
                    for (int m = 0; m < 4; ++m) {
                        const int row = row0 + ai * 128 + m * 16; const f32x4 v0 = acc[ai][bj][m][0], v1 = acc[ai][bj][m][1];
                        u32x4 w; w.x = pk2(v0.x, v0.y); w.y = pk2(v0.z, v0.w); w.z = pk2(v1.x, v1.y); w.w = pk2(v1.z, v1.w);
                        *(u32x4*)(P + (size_t)row * NP + c0) = w;
                        if (g == 26 && (c0 & 63) == 0) { *(f32x4*)(iw + (size_t)row * 8) = v0; *(f32x4*)(iw + (size_t)row * 8 + 4) = v1; }
                        if (g == 107 && (c0 & 63) == 0) {
                            f32x4 be, gg;
#pragma unroll
                            for (int h = 0; h < 4; ++h) { be[h] = sigmoidf_(v0[h]); const float z = v1[h] + dt_bias[h]; const float ez = __expf(z); const float sp = z > 20.f ? z : (ez < 1e-4f ? ez * (1.f - 0.5f * ez) : __logf(1.f + ez));     gg[h] = -__expf(a_log[h]) * sp; }
                            *(f32x4*)(gb + (size_t)row * 8) = be; *(f32x4*)(gb + (size_t)row * 8 + 4) = gg;
                        }
                        asm volatile("" ::: "memory");
                    }
            }
        }
        if (u.pn == 3) {
#pragma unroll
            for (int ai = 0; ai < 2; ++ai)
#pragma unroll
                for (int m = 0; m < 4; ++m) {
                    float s = 0.f;
#pragma unroll
                    for (int bj = 0; bj < 2; ++bj)
#pragma unroll
                        for (int n = 0; n < 2; ++n) { const f32x4 v = acc[ai][bj][m][n]; s += (v.x * v.x + v.y * v.y) + (v.z * v.z + v.w * v.w); }
                    s = sum_x16_x32(s);
                    if (fq == 0) ssq[(size_t)(row0 + ai * 128 + m * 16) * 4 + wc] = s;
                }
        }
    }
};

struct EpiKvUp {
    static constexpr bool PERM = true, HAS_PRE = false;
    bf16* KN; bf16* VAT; const float* ssq;
    __device__ __forceinline__ void operator()(const f32x4 (&acc)[2][2][4][2], const pg8::Unit& u, int wr, int wc, int fr, int fq) const {
        const int row0 = u.pm * 256 + wr * 64 + fr;
        if (u.pn < 2) {
#pragma unroll
            for (int ai = 0; ai < 2; ++ai)
#pragma unroll
                for (int m = 0; m < 4; ++m) {
                    const int row = row0 + ai * 128 + m * 16; const f32x4 q = *(const f32x4*)(ssq + (size_t)row * 4);
                    const float rstd = 1.0f / sqrtf(((q.x + q.y) + (q.z + q.w)) * (1.f / 256.f) + RMS_EPS);
#pragma unroll
                    for (int bj = 0; bj < 2; ++bj) {
                        const int c0 = u.pn * 256 + bj * 128 + wc * 32 + 8 * fq; const f32x4 v0 = acc[ai][bj][m][0] * rstd, v1 = acc[ai][bj][m][1] * rstd;
                        u32x4 w; w.x = pk2(v0.x, v0.y); w.y = pk2(v0.z, v0.w); w.z = pk2(v1.x, v1.y); w.w = pk2(v1.z, v1.w); *(u32x4*)(KN + (size_t)row * 512 + c0) = w;
                    }
                    asm volatile("" ::: "memory");
                }
        } else {
            const int b = u.pm >> 3;
#pragma unroll
            for (int ai = 0; ai < 2; ++ai)
#pragma unroll
                for (int m = 0; m < 4; ++m) {
                    const int row = row0 + ai * 128 + m * 16; const f32x4 q = *(const f32x4*)(ssq + (size_t)row * 4);
                    const float rstd = 1.0f / sqrtf(((q.x + q.y) + (q.z + q.w)) * (1.f / 256.f) + RMS_EPS);
                    const int s = (row & 2047 & ~31) | vperm32(row & 31);
#pragma unroll
                    for (int bj = 0; bj < 2; ++bj) {
                        const int c = (u.pn - 2) * 256 + bj * 128 + wc * 32 + 8 * fq; const f32x4 v0 = acc[ai][bj][m][0] * rstd, v1 = acc[ai][bj][m][1] * rstd;
                        GAS bf16* vp = (GAS bf16*)(VAT + ((size_t)b * 512 + c) * SEQ + s);
#pragma unroll
                        for (int j = 0; j < 8; ++j) { *vp = (bf16)f2bf(j < 4 ? v0[j & 3] : v1[j & 3]); vp += SEQ; asm volatile("" : "+v"(vp)); }
                    }
                    asm volatile("" ::: "memory");
                }
        }
    }
};

struct EpiOutProj {
    static constexpr bool PERM = true, HAS_PRE = false;
    const bf16* XB; bf16* RB;
    __device__ __forceinline__ void operator()(const f32x4 (&acc)[2][2][4][2], const pg8::Unit& u, int wr, int wc, int fr, int fq) const {
        const int row0 = u.pm * 256 + wr * 64 + fr, col0 = u.pn * 256 + wc * 32 + 8 * fq;
#pragma unroll
        for (int ai = 0; ai < 2; ++ai) {
            u32x4 xr[4][2];
#pragma unroll
            for (int m = 0; m < 4; ++m) { const size_t off = (size_t)(row0 + ai * 128 + m * 16) * DM + col0; xr[m][0] = *(const u32x4*)(XB + off); xr[m][1] = *(const u32x4*)(XB + off + 128); }
#pragma unroll
            for (int m = 0; m < 4; ++m) { const size_t off = (size_t)(row0 + ai * 128 + m * 16) * DM + col0;
#pragma unroll
                for (int bj = 0; bj < 2; ++bj) { const u32x4 xw = xr[m][bj]; const f32x4 a0 = acc[ai][bj][m][0], a1 = acc[ai][bj][m][1];
                    u32x4 w; w.x = pk2(bflo(xw.x) * DN_ALPHA + a0.x, bfhi(xw.x) * DN_ALPHA + a0.y); w.y = pk2(bflo(xw.y) * DN_ALPHA + a0.z, bfhi(xw.y) * DN_ALPHA + a0.w);
                    w.z = pk2(bflo(xw.z) * DN_ALPHA + a1.x, bfhi(xw.z) * DN_ALPHA + a1.y); w.w = pk2(bflo(xw.w) * DN_ALPHA + a1.z, bfhi(xw.w) * DN_ALPHA + a1.w);
                    *(u32x4*)(RB + off + bj * 128) = w; } }
            asm volatile("" ::: "memory"); }
    }
};

struct EpiGU {
    static constexpr bool PERM = true, HAS_PRE = false;
    bf16* ACT; const float* bgu;
    __device__ __forceinline__ void operator()(const f32x4 (&acc)[2][2][4][2], const pg8::Unit& u, int wr, int wc, int fr, int fq) const {
        const int row0 = u.pm * 256 + wr * 64 + fr; const float* bb = bgu + (size_t)u.e * 1024;
#pragma unroll
        for (int bj = 0; bj < 2; ++bj) {
            const int c0 = u.pn * 256 + bj * 128 + wc * 32 + 8 * fq, j0 = c0 >> 1;
            const f32x4 bg = *(const f32x4*)(bb + j0), bl = *(const f32x4*)(bb + 512 + j0);
#pragma unroll
            for (int ai = 0; ai < 2; ++ai) {
                if (HALF_EPI && ai == 1 && u.hf) break;
#pragma unroll
                for (int m = 0; m < 4; ++m) {
                    const f32x4 v0 = acc[ai][bj][m][0], v1 = acc[ai][bj][m][1];
                    const float gl[4] = {v0.x + bg.x, v0.z + bg.y, v1.x + bg.z, v1.z + bg.w}, li[4] = {v0.y + bl.x, v0.w + bl.y, v1.y + bl.z, v1.w + bl.w}; float o[4];
#pragma unroll
                    for (int j = 0; j < 4; ++j) { const float gcl = fminf(gl[j], 7.0f), lcl = fminf(fmaxf(li[j], -7.0f), 7.0f); o[j] = gcl * sigmoidf_(1.702f * gcl) * (lcl + 1.0f); }
                    u32x2 w; w.x = pk2(o[0], o[1]); w.y = pk2(o[2], o[3]);
                    *(u32x2*)(ACT + (size_t)(row0 + ai * 128 + m * 16) * DFF + j0) = w;
                    asm volatile("" ::: "memory");
                }
            }
        }
    }
};

struct EpiDN {
    static constexpr bool PERM = true, HAS_PRE = true;
    bf16* Y; const float* bdn; const float* lgate; const int* cnt; const LAS int* pstart;
    __device__ __forceinline__ void pre(const pg8::Unit& u, int wr, int fr, float (&gt)[8]) const {
        const int row0 = u.pm * 256 + wr * 64 + fr; const int ps = pstart[u.e], ce = cnt[u.e];
#pragma unroll
        for (int ai = 0; ai < 2; ++ai)
#pragma unroll
            for (int m = 0; m < 4; ++m) { const int slot = row0 + ai * 128 + m * 16 - ps; gt[ai * 4 + m] = slot < ce ? lgate[(size_t)u.e * NTOK + slot] : 0.f; }
    }
    __device__ __forceinline__ void apply(const f32x4 (&acc)[2][2][4][2], const pg8::Unit& u, int wr, int wc, int fr, int fq, const float (&gt)[8]) const {
        const int row0 = u.pm * 256 + wr * 64 + fr; const float* bb = bdn + (size_t)u.e * DM;
        f32x4 bv[2][2];
#pragma unroll
        for (int bj = 0; bj < 2; ++bj) { const int c0 = u.pn * 256 + bj * 128 + wc * 32 + 8 * fq; bv[bj][0] = *(const f32x4*)(bb + c0); bv[bj][1] = *(const f32x4*)(bb + c0 + 4); }
#pragma unroll
        for (int ai = 0; ai < 2; ++ai) {
            if (HALF_EPI && ai == 1 && u.hf) break;
#pragma unroll
            for (int m = 0; m < 4; ++m) {
                const int row = row0 + ai * 128 + m * 16; const float g_ = gt[ai * 4 + m];
#pragma unroll
                for (int bj = 0; bj < 2; ++bj) {
                    const int c0 = u.pn * 256 + bj * 128 + wc * 32 + 8 * fq;
                    const f32x4 v0 = (acc[ai][bj][m][0] + bv[bj][0]) * g_, v1 = (acc[ai][bj][m][1] + bv[bj][1]) * g_;
                    u32x4 w; w.x = pk2(v0.x, v0.y); w.y = pk2(v0.z, v0.w); w.z = pk2(v1.x, v1.y); w.w = pk2(v1.z, v1.w);
                    *(u32x4*)(Y + (size_t)row * DM + c0) = w;
                }
                asm volatile("" ::: "memory");
            }
        }
    }
};

template <bool GATHER>
struct MoeOrder {
    static constexpr bool HAS_HALF = true;
    int nN, nwg, G, c; const LAS unsigned short* tord; const LAS int* pstart; const int* cnt; const int* ltok; int mode;
    __device__ __forceinline__ bool next(int i, pg8::Unit& u) const {
        int oi, pn;
        if (mode) {
            const int x = c >> 5, j = c & 31; const int T0 = (nwg / 256) * 256;
            if (i * 256 < T0) { const int uu = i * 32 + j, per = 8 * nN; oi = 64 * (uu / per) + 8 * x + (uu % per) / nN; pn = (uu % per) % nN; }
            else if (i * 256 == T0) { oi = T0 / nN + (j / nN) * 8 + x; pn = j % nN; }
            else return false;
            if (oi * nN >= nwg) return false;
        } else { const long L = (long)i * G + c; if (L >= nwg) return false; oi = (int)L / nN; pn = (int)L % nN; }
        const unsigned o = tord[oi]; u.pm = (int)(o & 511u); u.pn = pn; u.e = (int)((o >> 9) & 31u); u.hf = (int)(o >> 15); return true;
    }
    __device__ __forceinline__ const char* a_base(const pg8::Unit& u, const pg8::Gemm& g) const { return GATHER ? (const char*)g.A : (const char*)g.A + (size_t)u.pm * 256 * g.lda * 2; }
    __device__ __forceinline__ void a_off(const pg8::Unit& u, const int (&R)[2], const int (&C)[2], int lda, unsigned (&v)[2][2]) const {
        if (GATHER) {
            const int ps = pstart[u.e], ce = cnt[u.e];
#pragma unroll
            for (int h = 0; h < 2; ++h)
#pragma unroll
                for (int i = 0; i < 2; ++i) { const int slot = u.pm * 256 + h * 128 + R[i] - ps; const int tok = slot < ce ? ltok[(size_t)u.e * NTOK + slot] : 0; v[h][i] = (unsigned)(tok * lda + C[i]) * 2u; }
        } else {
#pragma unroll
            for (int h = 0; h < 2; ++h)
#pragma unroll
                for (int i = 0; i < 2; ++i) v[h][i] = (unsigned)((h * 128 + R[i]) * lda + C[i]) * 2u;
        }
    }
};

__device__ __forceinline__ int moe_tables(Frame& F, const int* cnt, LAS int* pstart, LAS unsigned short* tord) {
    frame_refresh(F);
    LAS int* wcnt = pstart + 40;
    if (F.tid == 0) { int acc = 0; for (int e = 0; e < NE; ++e) { pstart[e] = acc; acc += (cnt[e] + 255) / 256 * 256; } pstart[NE] = acc; }
    __syncthreads();
    const int ntiles = pstart[NE] / 256; const int t = F.tid; const bool vt = t < ntiles; int e = 0; bool hf = false;
    if (vt) { while (pstart[e + 1] <= t * 256) ++e; hf = (cnt[e] - (t * 256 - pstart[e])) <= 128; }
    const unsigned long long bh = __ballot(vt && hf);
    if (F.lane == 0) wcnt[F.wave] = (int)__popcll(bh);
    __syncthreads();
    int hb = 0, htot = 0;
#pragma unroll
    for (int w = 0; w < NWAVES; ++w) { const int c = wcnt[w]; hb += (w < F.wave) ? c : 0; htot += c; }
    const int hrank = hb + (int)__popcll(bh & ((1ull << F.lane) - 1ull));
    if (vt) { const int pos = hf ? (ntiles - htot) + hrank : t - hrank; tord[pos] = (unsigned short)(t | (e << 9) | ((hf ? 1 : 0) << 15)); }
    __syncthreads();
    return ntiles;
}

__device__ __forceinline__ void ln_stats(const f32x4 (&v)[8], float& mean, float& rstd) {
    float s = 0.f;
#pragma unroll
    for (int j = 0; j < 8; ++j) s += (v[j].x + v[j].y) + (v[j].z + v[j].w);
    mean = wave_sum(s) * (1.f / DM); float q = 0.f;
#pragma unroll
    for (int j = 0; j < 8; ++j) { const f32x4 d = v[j] - mean; q += (d.x * d.x + d.y * d.y) + (d.z * d.z + d.w * d.w); }
    rstd = 1.0f / sqrtf(wave_sum(q) * (1.f / DM) + LN_EPS);
}

__device__ __forceinline__ void ln_stats32(const float (&v)[4][8], float& mean, float& rstd) {
    float s = 0.f;
#pragma unroll
    for (int j = 0; j < 4; ++j)
#pragma unroll
        for (int t = 0; t < 8; ++t) s += v[j][t];
    mean = wave_sum(s) * (1.f / DM); float q = 0.f;
#pragma unroll
    for (int j = 0; j < 4; ++j)
#pragma unroll
        for (int t = 0; t < 8; ++t) { const float d = v[j][t] - mean; q += d * d; }
    rstd = 1.0f / sqrtf(wave_sum(q) * (1.f / DM) + LN_EPS);
}
__device__ __forceinline__ void unpack8(const u32x4 w, float (&o)[8]) { o[0] = bflo(w.x); o[1] = bfhi(w.x); o[2] = bflo(w.y); o[3] = bfhi(w.y); o[4] = bflo(w.z); o[5] = bfhi(w.z); o[6] = bflo(w.w); o[7] = bfhi(w.w); }
__device__ __forceinline__ void phase_ln1_router(Frame& F, const CAS Args& a, int l) {
    frame_refresh(F);
    const bf16* RB = (const bf16*)(F.ws + WS_R); bf16* HB = (bf16*)(F.ws + WS_HB);
    const float* g1 = a.in[I_LN1G] + l * DM; const float* b1 = a.in[I_LN1B] + l * DM;
    const float* Wr = a.in[I_WR] + (size_t)l * DM * NE; const float* br = a.in[I_BR] + l * NE;
    int* ecnt = (int*)(F.ctl + CW_ECNT + l * 64); int* ltok = (int*)(F.ws + WS_LTOK); float* lgate = (float*)(F.ws + WS_LGATE); int* tslot = (int*)(F.ws + WS_TSLOT);
    LAS float* img = (LAS float*)F.lds;
    LAS float* red = (LAS float*)F.lds;
    constexpr int IST = 2052;
    float wb0[64], wb1[64];
    { const float* wp = Wr + (size_t)(F.wave * 256 + 4 * (F.lane >> 4)) * NE + (F.lane & 15);
#pragma unroll
      for (int sx = 0; sx < 64; ++sx) { const float* q = wp + (size_t)(16 * (sx >> 2) + (sx & 3)) * NE; wb0[sx] = q[0]; wb1[sx] = q[16]; } }
    LAS float* lgt = (LAS float*)(F.lds + 131584);
    u32x4 pr[2][4];
    auto fetch = [&](int un) {
#pragma unroll
        for (int rr = 0; rr < 2; ++rr)
#pragma unroll
            for (int j = 0; j < 4; ++j) pr[rr][j] = __builtin_nontemporal_load((const u32x4*)(RB + (size_t)(un * 16 + F.wave * 2 + rr) * DM + (64 * j + F.lane) * 8));
    };
    const bool aff1 = (F.G % 8 == 0); const int cpg1 = aff1 ? F.G / 8 : F.G; const int ustep = cpg1;
    const int ufirst = aff1 ? (F.vcu / cpg1) * 128 + F.vcu % cpg1 : F.vcu; const int uend = aff1 ? (F.vcu / cpg1) * 128 + 128 : NTOK / 16;
    if (ufirst < uend) fetch(ufirst);
    for (int unit = ufirst; unit < uend; unit += ustep) {
        const int r0 = unit * 16;
#pragma unroll
        for (int rr = 0; rr < 2; ++rr) {
            const int lr = F.wave * 2 + rr, row = r0 + lr; float v[4][8];
#pragma unroll
            for (int j = 0; j < 4; ++j) unpack8(pr[rr][j], v[j]);
            float mean, rstd; ln_stats32(v, mean, rstd);
#pragma unroll
            for (int j = 0; j < 4; ++j) { const int c = (64 * j + F.lane) * 8; const f32x4 ga = *(const f32x4*)(g1 + c), gb = *(const f32x4*)(g1 + c + 4), ba = *(const f32x4*)(b1 + c), bb = *(const f32x4*)(b1 + c + 4);
                const f32x4 y0 = ((f32x4){v[j][0], v[j][1], v[j][2], v[j][3]} - mean) * rstd * ga + ba, y1 = ((f32x4){v[j][4], v[j][5], v[j][6], v[j][7]} - mean) * rstd * gb + bb;
                u32x4 w; w.x = pk2(y0.x, y0.y); w.y = pk2(y0.z, y0.w); w.z = pk2(y1.x, y1.y); w.w = pk2(y1.z, y1.w); *(u32x4*)(HB + (size_t)row * DM + c) = w;
                *(LAS f32x4*)(img + lr * IST + c) = y0; *(LAS f32x4*)(img + lr * IST + c + 4) = y1; }
        }
        asm volatile("" ::: "memory");
        if (unit + ustep < uend) fetch(unit + ustep);
        __syncthreads();
        f32x4 acc0 = {0.f, 0.f, 0.f, 0.f}, acc1 = {0.f, 0.f, 0.f, 0.f};
        const int lm = lane_now();
        { const LAS float* ap = img + (lm & 15) * IST + F.wave * 256 + 4 * (lm >> 4);
#pragma unroll
            for (int s4 = 0; s4 < 16; ++s4) { const f32x4 av = *(const LAS f32x4*)(ap + 16 * s4);
#pragma unroll
                for (int t = 0; t < 4; ++t) { acc0 = __builtin_amdgcn_mfma_f32_16x16x4f32(av[t], wb0[4 * s4 + t], acc0, 0, 0, 0); acc1 = __builtin_amdgcn_mfma_f32_16x16x4f32(av[t], wb1[4 * s4 + t], acc1, 0, 0, 0); } } }
        __syncthreads();
#pragma unroll
        for (int i = 0; i < 4; ++i) { const int rw = 4 * (lm >> 4) + i; red[(F.wave * 16 + rw) * 32 + (lm & 15)] = acc0[i]; red[(F.wave * 16 + rw) * 32 + 16 + (lm & 15)] = acc1[i]; }
        __syncthreads();
        { const int tq = F.wave * 64 + lm; const int rw = tq >> 5, e = tq & 31; float s = br[e];
#pragma unroll
            for (int w = 0; w < 8; ++w) s += red[(w * 16 + rw) * 32 + e];
            lgt[tq] = s; }
        __syncthreads();
        if (F.wave == 0) {
            int ln = lm; asm volatile("" : "+v"(ln));
            const int row = ln >> 2, part = ln & 3; const LAS float* lg = lgt + row * 32 + part * 8;
            float v[8];
#pragma unroll
            for (int t = 0; t < 8; ++t) v[t] = lg[t];
            float tv[4]; int te[4];
#pragma unroll
            for (int k = 0; k < 4; ++k) {
                float best = -INFINITY; int bi = 99;
#pragma unroll
                for (int t = 0; t < 8; ++t) if (v[t] > best) { best = v[t]; bi = part * 8 + t; }
#pragma unroll
                for (int off = 1; off <= 2; off <<= 1) { const int bb_ = __builtin_bit_cast(int, best); const float ob = __builtin_bit_cast(float, off == 1 ? __builtin_amdgcn_update_dpp(0, bb_, 0xB1, 0xf, 0xf, true) : __builtin_amdgcn_update_dpp(0, bb_, 0x4E, 0xf, 0xf, true)); const int oi = off == 1 ? __builtin_amdgcn_update_dpp(0, bi, 0xB1, 0xf, 0xf, true) : __builtin_amdgcn_update_dpp(0, bi, 0x4E, 0xf, 0xf, true); if (ob > best || (ob == best && oi < bi)) { best = ob; bi = oi; } }
                tv[k] = best; te[k] = bi;
#pragma unroll
                for (int t = 0; t < 8; ++t) if (part * 8 + t == bi) v[t] = -INFINITY;
            }
            const float e1 = __expf(tv[1] - tv[0]), e2 = __expf(tv[2] - tv[0]), e3 = __expf(tv[3] - tv[0]); const float inv = 1.0f / (1.0f + e1 + e2 + e3);
            const int me = part == 0 ? te[0] : part == 1 ? te[1] : part == 2 ? te[2] : te[3];
            const float mg = part == 0 ? inv : part == 1 ? e1 * inv : part == 2 ? e2 * inv : e3 * inv;
            const int tok = r0 + row;
            unsigned long long same = 0ull;
#pragma unroll 8
            for (int e = 0; e < NE; ++e) { const unsigned long long bm = __ballot(me == e); if (me == e) same = bm; }
            const int leader = __ffsll((long long)same) - 1; const int rank = (int)__popcll(same & ((1ull << ln) - 1ull));
            int base = 0;
            if (ln == leader) base = __hip_atomic_fetch_add(ecnt + me, (int)__popcll(same), RLX_AGENT);
            base = __builtin_amdgcn_ds_bpermute(leader << 2, base);
            const int slot = base + rank;
            ltok[(size_t)me * NTOK + slot] = tok; lgate[(size_t)me * NTOK + slot] = mg; tslot[tok * 4 + part] = (me << 16) | slot;
        }
    }
    __syncthreads();
}

__device__ __forceinline__ void phase_ln2(Frame& F, const CAS Args& a, int l) {
    frame_refresh(F);
    const bf16* HB = (const bf16*)(F.ws + WS_HB); const bf16* Y = (const bf16*)(F.ws + WS_Y); const int* tslot = (const int*)(F.ws + WS_TSLOT);
    const int* ecnt = (const int*)(F.ctl + CW_ECNT + l * 64);
    float* XO = a.out; bf16* XB = (bf16*)(F.ws + WS_XB);
    const float* g2 = a.in[I_LN2G] + l * DM; const float* b2 = a.in[I_LN2B] + l * DM;
    LAS int* pstart = (LAS int*)(F.lds);
    if (F.tid == 0) { int acc = 0; for (int e = 0; e < NE; ++e) { pstart[e] = acc; acc += (ecnt[e] + 255) / 256 * 256; } }
    __syncthreads();
    f32x4 gq[4][2], bq[4][2];
#pragma unroll
    for (int j = 0; j < 4; ++j) { const int c = (64 * j + F.lane) * 8; gq[j][0] = *(const f32x4*)(g2 + c); gq[j][1] = *(const f32x4*)(g2 + c + 4); bq[j][0] = *(const f32x4*)(b2 + c); bq[j][1] = *(const f32x4*)(b2 + c + 4); }
    const bool aff2 = (F.G % 8 == 0); const int cpg2 = aff2 ? F.G / 8 : F.G;
    const int rstride = cpg2 * NWAVES; const int rend = aff2 ? (F.vcu / cpg2) * SEQ + SEQ : NTOK;
    int row = aff2 ? (F.vcu / cpg2) * SEQ + (F.vcu % cpg2) * NWAVES + F.wave : F.vcu * NWAVES + F.wave;
    int4 tsn = {0, 0, 0, 0};
    u32x4 dh[4], dy[4][4];
    auto issue = [&](int r, const int4& ts) {
        const int tsv[4] = {ts.x, ts.y, ts.z, ts.w};
#pragma unroll
        for (int j = 0; j < 4; ++j) dh[j] = __builtin_nontemporal_load((const u32x4*)(HB + (size_t)r * DM + (64 * j + F.lane) * 8));
#pragma unroll
        for (int k = 0; k < 4; ++k) { const size_t yr = (size_t)(pstart[tsv[k] >> 16] + (tsv[k] & 0xffff)) * DM;
#pragma unroll
            for (int j = 0; j < 4; ++j) dy[k][j] = __builtin_nontemporal_load((const u32x4*)(Y + yr + (64 * j + F.lane) * 8)); }
    };
    if (row < rend) { const int4 ts0 = *(const int4*)(tslot + row * 4); if (row + rstride < rend) tsn = *(const int4*)(tslot + (row + rstride) * 4); issue(row, ts0); }
    for (; row < rend; row += rstride) {
        float v[4][8];
#pragma unroll
        for (int j = 0; j < 4; ++j) { unpack8(dh[j], v[j]);
#pragma unroll
            for (int t = 0; t < 8; ++t) v[j][t] *= DN_ALPHA; }
#pragma unroll
        for (int k = 0; k < 4; ++k)
#pragma unroll
            for (int j = 0; j < 4; ++j) { float y[8]; unpack8(dy[k][j], y);
#pragma unroll
                for (int t = 0; t < 8; ++t) v[j][t] += y[t]; }
        asm volatile("" ::: "memory"); __builtin_amdgcn_sched_barrier(0);
        if (row + rstride < rend) { issue(row + rstride, tsn); if (row + 2 * rstride < rend) tsn = *(const int4*)(tslot + (row + 2 * rstride) * 4); }
        asm volatile("" ::: "memory"); __builtin_amdgcn_sched_barrier(0);
        float mean, rstd; ln_stats32(v, mean, rstd);
#pragma unroll
        for (int j = 0; j < 4; ++j) { const int c = (64 * j + F.lane) * 8; const f32x4 ga = gq[j][0], gb = gq[j][1], ba = bq[j][0], bb = bq[j][1];
            const f32x4 y0 = ((f32x4){v[j][0], v[j][1], v[j][2], v[j][3]} - mean) * rstd * ga + ba, y1 = ((f32x4){v[j][4], v[j][5], v[j][6], v[j][7]} - mean) * rstd * gb + bb;
            if (l == DEPTH - 1) { *(f32x4*)(XO + (size_t)row * DM + c) = y0; *(f32x4*)(XO + (size_t)row * DM + c + 4) = y1; }
            else { u32x4 w; w.x = pk2(y0.x, y0.y); w.y = pk2(y0.z, y0.w); w.z = pk2(y1.x, y1.y); w.w = pk2(y1.z, y1.w); *(u32x4*)(XB + (size_t)row * DM + c) = w; } }
    }
    __syncthreads();
}

__device__ __forceinline__ f32x4 mma16(f32x4 acc, const LAS bf16* A, int lda, const LAS bf16* B, int ldb, int K, int lane) {
    const LAS bf16* ap = A + (lane & 15) * lda + 8 * (lane >> 4); const LAS bf16* bp = B + (lane & 15) * ldb + 8 * (lane >> 4);
    for (int k = 0; k < K; k += 32) acc = __builtin_amdgcn_mfma_f32_16x16x32_bf16(*(const LAS bf16x8*)(ap + k), *(const LAS bf16x8*)(bp + k), acc, 0, 0, 0);
    return acc;
}
__device__ __forceinline__ float ret_lg2gamma(int h) { return log2f(1.0f - exp2f(-5.0f - (float)h)); }

__device__ __forceinline__ void ret_stage1(Frame& F, int unit) {
    const int b = unit >> 6, h = (unit >> 4) & 3, n = unit & 15; const int tok0 = b * SEQ + n * 128;
    const bf16* P = (const bf16*)(F.ws + WS_P); float* BKV = (float*)(F.ws + WS_BKV) + (size_t)unit * 8192;
    LAS bf16* KT = (LAS bf16*)F.lds;
    LAS bf16* VT = KT + 64 * 136;
    const float lg = ret_lg2gamma(h);
#pragma unroll
    for (int ps = 0; ps < 2; ++ps) { const int i_ = F.tid + 512 * ps, c = i_ & 127, ch = i_ >> 7;
        const u32x4 w = *(const u32x4*)(P + (size_t)(tok0 + c) * NP + PC_BK + 64 * h + 8 * ch);
        const float sc = fast_exp2(lg * (float)(127 - c)); const unsigned ww[4] = {w.x, w.y, w.z, w.w};
#pragma unroll
        for (int j = 0; j < 4; ++j) { KT[(8 * ch + 2 * j) * 136 + c] = (bf16)f2bf(bflo(ww[j]) * sc); KT[(8 * ch + 2 * j + 1) * 136 + c] = (bf16)f2bf(bfhi(ww[j]) * sc); } }
#pragma unroll
    for (int ps = 0; ps < 4; ++ps) { const int i_ = F.tid + 512 * ps, c = i_ & 127, ch = i_ >> 7; const u32x4 w = *(const u32x4*)(P + (size_t)(tok0 + c) * NP + PC_BV + 128 * h + 8 * ch);
        const unsigned ww[4] = {w.x, w.y, w.z, w.w};
#pragma unroll
        for (int j = 0; j < 4; ++j) { VT[(8 * ch + 2 * j) * 136 + c] = (bf16)(ww[j] & 0xffffu); VT[(8 * ch + 2 * j + 1) * 136 + c] = (bf16)(ww[j] >> 16); } }
    __syncthreads();
    const int dt = F.wave & 3, e0 = (F.wave >> 2) * 4;
#pragma unroll
    for (int et = 0; et < 4; ++et) {
        f32x4 acc = {0.f, 0.f, 0.f, 0.f};
        acc = mma16(acc, KT + dt * 16 * 136, 136, VT + (e0 + et) * 16 * 136, 136, 128, F.lane);
        *(f32x4*)(BKV + (size_t)((e0 + et) * 16 + (F.lane & 15)) * 64 + dt * 16 + 4 * (F.lane >> 4)) = acc;
    }
    __syncthreads();
}

__device__ __forceinline__ void ret_stage2(Frame& F, int unit) {
    const int b = unit >> 6, h = (unit >> 4) & 3, n = unit & 15; const int tok0 = b * SEQ + n * 128;
    const bf16* P = (const bf16*)(F.ws + WS_P); const float* BKV = (const float*)(F.ws + WS_BKV) + (size_t)(unit - n) * 8192; bf16* HEADS = (bf16*)(F.ws + WS_HEADS);
    LAS bf16* Qs = (LAS bf16*)F.lds;
    LAS bf16* Ks = Qs + 128 * 72;
    LAS bf16* VT = Ks + 128 * 72;
    LAS bf16* SC = VT + 128 * 136;
    LAS bf16* PT = SC + 128 * 136;
    const float lg = ret_lg2gamma(h);
#pragma unroll
    for (int ps = 0; ps < 2; ++ps) { const int c = (F.tid >> 3) + 64 * ps, ch = F.tid & 7; const size_t ro = (size_t)(tok0 + c) * NP;
        *(LAS u32x4*)(Qs + c * 72 + 8 * ch) = *(const u32x4*)(P + ro + PC_BQ + 64 * h + 8 * ch); *(LAS u32x4*)(Ks + c * 72 + 8 * ch) = *(const u32x4*)(P + ro + PC_BK + 64 * h + 8 * ch); }
#pragma unroll
    for (int ps = 0; ps < 4; ++ps) { const int i_ = F.tid + 512 * ps, c = i_ & 127, ch = i_ >> 7; const u32x4 w = *(const u32x4*)(P + (size_t)(tok0 + c) * NP + PC_BV + 128 * h + 8 * ch);
        const unsigned ww[4] = {w.x, w.y, w.z, w.w};
#pragma unroll
        for (int j = 0; j < 4; ++j) { VT[(8 * ch + 2 * j) * 136 + c] = (bf16)(ww[j] & 0xffffu); VT[(8 * ch + 2 * j + 1) * 136 + c] = (bf16)(ww[j] >> 16); } }
    {
        float z_ = 0.f; asm volatile("" : "+v"(z_));
#pragma unroll
        for (int ps = 0; ps < 4; ++ps) { const int idx = (F.tid + 512 * ps) * 4; f32x4 s = {z_, z_, z_, z_};
            for (int m = 0; m < n; ++m) { const float wgt = fast_exp2(lg * 128.0f * (float)(n - 1 - m)); s += *(const f32x4*)(BKV + (size_t)m * 8192 + idx) * wgt; }
            const int e = idx >> 6, d = idx & 63; u32x2 w; w.x = pk2(s.x, s.y); w.y = pk2(s.z, s.w); *(LAS u32x2*)(PT + e * 72 + d) = w; }
    }
    __syncthreads();
    const int w = F.wave, li = F.lane & 15, g = F.lane >> 4;
    for (int jt = 0; jt <= (w | 1); ++jt) {
        f32x4 acc = {0.f, 0.f, 0.f, 0.f};
        if (jt <= w) acc = mma16(acc, Ks + jt * 16 * 72, 72, Qs + w * 16 * 72, 72, 64, F.lane);
        const int i = 16 * w + li; float v[4];
#pragma unroll
        for (int r = 0; r < 4; ++r) { const int j = 16 * jt + 4 * g + r; v[r] = (j <= i) ? acc[r] * fast_exp2(lg * (float)(i - j)) : 0.f; }
        u32x2 pw; pw.x = pk2(v[0], v[1]); pw.y = pk2(v[2], v[3]); *(LAS u32x2*)(SC + i * 136 + 16 * jt + 4 * g) = pw;
    }
    asm volatile("s_waitcnt lgkmcnt(0)" ::: "memory");
    const int kext = 16 * ((w | 1) + 1);
    const int tok = tok0 + 16 * w + li; const float fin = fast_exp2(lg * (float)(16 * w + li + 1));
    f32x4 o[8]; float ss = 0.f;
#pragma unroll
    for (int et = 0; et < 8; ++et) {
        f32x4 a1 = {0.f, 0.f, 0.f, 0.f}, a2 = {0.f, 0.f, 0.f, 0.f};
        a1 = mma16(a1, VT + et * 16 * 136, 136, SC + w * 16 * 136, 136, kext, F.lane);
        a2 = mma16(a2, PT + et * 16 * 72, 72, Qs + w * 16 * 72, 72, 64, F.lane);
        o[et] = a1 + a2 * fin; ss += (o[et].x * o[et].x + o[et].y * o[et].y) + (o[et].z * o[et].z + o[et].w * o[et].w);
    }
    ss = sum_x16_x32(ss);
    const float rstd = 1.0f / sqrtf(ss * (1.f / 128.f) + RMS_EPS);
#pragma unroll
    for (int et = 0; et < 8; ++et) { const int e = 16 * et + 4 * g; const u32x2 gw = *(const u32x2*)(P + (size_t)tok * NP + PC_BG + 128 * h + e);
        const float g0 = bflo(gw.x), g1 = bfhi(gw.x), g2 = bflo(gw.y), g3 = bfhi(gw.y);
        u32x2 ow; ow.x = pk2(o[et].x * rstd * g0 * sigmoidf_(g0), o[et].y * rstd * g1 * sigmoidf_(g1)); ow.y = pk2(o[et].z * rstd * g2 * sigmoidf_(g2), o[et].w * rstd * g3 * sigmoidf_(g3));
        *(u32x2*)(HEADS + (size_t)tok * DM + 512 + 128 * h + e) = ow; }
    __syncthreads();
}

__device__ __forceinline__ float rowmax4(float x) {
    float a = x, b = x; swap16(a, b); x = fmaxf(a, b);
    a = x; b = x; swap32(a, b); return fmaxf(a, b);
}
struct AttnSrc { const bf16* q0; const bf16* q1; const bf16* k0; const bf16* k1; int sq0, sq1, sk0, sk1; const bf16* vt; const unsigned long long* mask; };
template <int D0, int D1, bool MASK, int RG>
__device__ __forceinline__ void attn_unit(Frame& F, const AttnSrc& A, int qb0  , f32x4 (&ot)[RG][8]) {
    constexpr int DK = D0 + D1, KST = DK + 8, NKS = DK / 32, KCH = DK / 8;
    constexpr int KBUF = 64 * KST, VBUF = 128 * 72;
    LAS bf16* Kl = (LAS bf16*)F.lds;
    LAS bf16* Vl = Kl + 2 * KBUF;
    const int w = F.wave, li = F.lane & 15, g = F.lane >> 4;
    const int qw0 = qb0 + 16 * RG * w;
    bf16x8 qf[RG][NKS];
#pragma unroll
    for (int r = 0; r < RG; ++r)
#pragma unroll
        for (int ks = 0; ks < NKS; ++ks) { const int d = 32 * ks + 8 * g; const int qpos = qw0 + 16 * r + li;
            if constexpr (D1 == 0) qf[r][ks] = *(const bf16x8*)(A.q0 + (size_t)qpos * A.sq0 + d);
            else qf[r][ks] = (d < D0) ? *(const bf16x8*)(A.q0 + (size_t)qpos * A.sq0 + d) : *(const bf16x8*)(A.q1 + (size_t)qpos * A.sq1 + (d - D0)); }
    float m_run[RG], l_run[RG];
#pragma unroll
    for (int r = 0; r < RG; ++r) { m_run[r] = -INFINITY; l_run[r] = 0.f;
#pragma unroll
        for (int et = 0; et < 8; ++et) ot[r][et] = (f32x4){0.f, 0.f, 0.f, 0.f}; }
    const int nkt = (qb0 + 128 * RG) / 64;
    constexpr int NKL = (64 * KCH + NTHR - 1) / NTHR;
    u32x4 kreg[NKL], vreg[2]; unsigned long long mreg[RG], mcur[RG];
#pragma unroll
    for (int r = 0; r < RG; ++r) { mreg[r] = 0ull; mcur[r] = 0ull; }
    auto issue = [&](int kt) {
#pragma unroll
        for (int i = 0; i < NKL; ++i) { const int c = F.tid + i * NTHR; if (c < 64 * KCH) { const int rr = c / KCH, ch = c % KCH, d = 8 * ch; const int key = 64 * kt + rr;
            if constexpr (D1 == 0) kreg[i] = *(const u32x4*)(A.k0 + (size_t)key * A.sk0 + d);
            else kreg[i] = (d < D0) ? *(const u32x4*)(A.k0 + (size_t)key * A.sk0 + d) : *(const u32x4*)(A.k1 + (size_t)key * A.sk1 + (d - D0)); } }
#pragma unroll
        for (int i = 0; i < 2; ++i) { const int c = F.tid + i * NTHR, e = c >> 3, ch = c & 7; vreg[i] = *(const u32x4*)(A.vt + (size_t)e * SEQ + 64 * kt + 8 * ch); }
        if (MASK) {
#pragma unroll
            for (int r = 0; r < RG; ++r) mreg[r] = A.mask[(size_t)(qw0 + 16 * r + li) * 32 + kt]; }
    };
    auto commit = [&](int buf) {
#pragma unroll
        for (int i = 0; i < NKL; ++i) { const int c = F.tid + i * NTHR; if (c < 64 * KCH) { const int rr = c / KCH, ch = c % KCH; *(LAS u32x4*)(Kl + buf * KBUF + rr * KST + 8 * ch) = kreg[i]; } }
#pragma unroll
        for (int i = 0; i < 2; ++i) { const int c = F.tid + i * NTHR, e = c >> 3, ch = c & 7; *(LAS u32x4*)(Vl + buf * VBUF + e * 72 + 8 * ch) = vreg[i]; }
    };
    issue(0); commit(0);
#pragma unroll
    for (int r = 0; r < RG; ++r) mcur[r] = mreg[r];
    __syncthreads();
    for (int kt = 0; kt < nkt; ++kt) {
        const int buf = kt & 1;
        if (kt + 1 < nkt) issue(kt + 1);
        if (64 * kt <= qw0 + 16 * RG - 1) {
            const LAS bf16* Kb = Kl + buf * KBUF; const LAS bf16* Vb = Vl + buf * VBUF;
            const bool diag = (64 * kt + 63 > qw0);
            f32x4 st[RG][4];
            unsigned nmw[RG][2];
            if constexpr (MASK) {
#pragma unroll
                for (int r = 0; r < RG; ++r) { nmw[r][0] = ~(unsigned)mcur[r] >> (4 * g); nmw[r][1] = ~(unsigned)(mcur[r] >> 32) >> (4 * g); } }
#pragma unroll
            for (int t4 = 0; t4 < 4; ++t4) {
#pragma unroll
                for (int r = 0; r < RG; ++r) {
                    if constexpr (MASK) {
#pragma unroll
                        for (int c = 0; c < 4; ++c) st[r][t4][c] = __builtin_bit_cast(float, __builtin_amdgcn_sbfe((int)nmw[r][t4 >> 1], 16 * (t4 & 1) + c, 1) & (int)0xff800000);
                    } else st[r][t4] = (f32x4){0.f, 0.f, 0.f, 0.f};
                }
#pragma unroll
                for (int ks = 0; ks < NKS; ++ks) { const bf16x8 kf = *(const LAS bf16x8*)(Kb + (16 * t4 + li) * KST + 32 * ks + 8 * g);
#pragma unroll
                    for (int r = 0; r < RG; ++r) st[r][t4] = __builtin_amdgcn_mfma_f32_16x16x32_bf16(kf, qf[r][ks], st[r][t4], 0, 0, 0); } }
            __builtin_amdgcn_sched_barrier(0);
            bf16x8 pf[RG][2]; float alpha[RG]; bool resc = false;
#pragma unroll
            for (int r = 0; r < RG; ++r) {
                const int qpos = qw0 + 16 * r + li; float mx = -INFINITY;
                if (!MASK && diag) {
#pragma unroll
                    for (int t4 = 0; t4 < 4; ++t4)
#pragma unroll
                        for (int c = 0; c < 4; ++c) { const int kin = 16 * t4 + 4 * g + c; const bool ok = (64 * kt + kin) <= qpos;
                            st[r][t4][c] = ok ? st[r][t4][c] : -INFINITY; }
                }
#pragma unroll
                for (int t4 = 0; t4 < 4; ++t4) mx = fmaxf(fmaxf(mx, fmaxf(st[r][t4][0], st[r][t4][1])), fmaxf(st[r][t4][2], st[r][t4][3]));
                mx = rowmax4(mx);
                const float m_new = fmaxf(m_run[r], mx);
                const float msafe = (m_new == -INFINITY) ? 0.f : m_new;
                alpha[r] = fast_exp2(m_run[r] - msafe);
                resc = resc || (m_new != m_run[r]);
                m_run[r] = m_new;
                float ps = 0.f; unsigned pw[8];
#pragma unroll
                for (int t4 = 0; t4 < 4; ++t4) { const float p0 = fast_exp2(st[r][t4][0] - msafe), p1 = fast_exp2(st[r][t4][1] - msafe), p2 = fast_exp2(st[r][t4][2] - msafe), p3 = fast_exp2(st[r][t4][3] - msafe);
                    ps += (p0 + p1) + (p2 + p3); pw[2 * t4] = pk2(p0, p1); pw[2 * t4 + 1] = pk2(p2, p3); }
                pf[r][0] = __builtin_bit_cast(bf16x8, (u32x4){pw[0], pw[1], pw[2], pw[3]}); pf[r][1] = __builtin_bit_cast(bf16x8, (u32x4){pw[4], pw[5], pw[6], pw[7]});
                l_run[r] = l_run[r] * alpha[r] + ps;
            }
            __builtin_amdgcn_sched_barrier(0);
            if (__any(resc)) {
#pragma unroll
                for (int r = 0; r < RG; ++r)
#pragma unroll
                    for (int et = 0; et < 8; ++et) ot[r][et] = ot[r][et] * alpha[r];
            }
#pragma unroll
            for (int et = 0; et < 8; ++et)
#pragma unroll
                for (int k2 = 0; k2 < 2; ++k2) { const bf16x8 vf = *(const LAS bf16x8*)(Vb + (16 * et + li) * 72 + 32 * k2 + 8 * g);
#pragma unroll
                    for (int r = 0; r < RG; ++r) ot[r][et] = __builtin_amdgcn_mfma_f32_16x16x32_bf16(vf, pf[r][k2], ot[r][et], 0, 0, 0); }
        }
        if (kt + 1 < nkt) { commit(buf ^ 1);
#pragma unroll
            for (int r = 0; r < RG; ++r) mcur[r] = mreg[r]; }
        __syncthreads();
    }
#pragma unroll
    for (int r = 0; r < RG; ++r) { float l = sum_x16_x32(l_run[r]); const float inv = 1.0f / l;
#pragma unroll
        for (int et = 0; et < 8; ++et) ot[r][et] = ot[r][et] * inv; }
}

__device__ __forceinline__ void cvt_transpose_unit(Frame& F, int unit) {
    const int b = unit >> 6, h = (unit >> 4) & 3, n = unit & 15; const int tok0 = b * SEQ + n * 128;
    const bf16* P = (const bf16*)(F.ws + WS_P); bf16* CVT = (bf16*)(F.ws + WS_CVT) + (size_t)(b * 4 + h) * 128 * SEQ + n * 128;
    LAS bf16* T = (LAS bf16*)F.lds;
#pragma unroll
    for (int ps = 0; ps < 4; ++ps) { const int c = (F.tid >> 4) + 32 * ps, ch = F.tid & 15; *(LAS u32x4*)(T + c * 136 + 8 * ch) = *(const u32x4*)(P + (size_t)(tok0 + c) * NP + PC_CV + 128 * h + 8 * ch); }
    __syncthreads();
#pragma unroll
    for (int ps = 0; ps < 4; ++ps) { const int it = F.tid + 512 * ps, e = it & 127, cc = it >> 7;
        unsigned wv[4];
#pragma unroll
        for (int j = 0; j < 4; ++j) {
            const int blk = cc >> 2, gg = cc & 3, j0 = 2 * j, j1 = 2 * j + 1; const int t0 = 32 * blk + 16 * (j0 >> 2) + 4 * gg + (j0 & 3), t1 = 32 * blk + 16 * (j1 >> 2) + 4 * gg + (j1 & 3);
            wv[j] = (unsigned)T[t0 * 136 + e] | ((unsigned)T[t1 * 136 + e] << 16); }
        *(u32x4*)(CVT + (size_t)e * SEQ + 8 * cc) = (u32x4){wv[0], wv[1], wv[2], wv[3]}; }
    __syncthreads();
}

constexpr int ATT_RG = 2;
__device__ __forceinline__ void diffattn_unit(Frame& F, const CAS Args& a, int l, int unit) {
    const int b = unit >> 5, h = (unit >> 3) & 3, qb = 7 - (unit & 7);
    const bf16* P = (const bf16*)(F.ws + WS_P) + (size_t)b * SEQ * NP; bf16* HEADS = (bf16*)(F.ws + WS_HEADS);
    const float* lam = a.in[I_CLAM] + l * 256; const float* sg = a.in[I_CSUB] + l * 128;
    const float l1 = wave_sum(lam[F.lane] * lam[64 + F.lane]), l2 = wave_sum(lam[128 + F.lane] * lam[192 + F.lane]);
    const float lam_init = 0.8f - 0.6f * __expf(-0.3f * (float)l); const float lam_full = __expf(l1) - __expf(l2) + lam_init;
    f32x4 o2[ATT_RG][8];
    float* O1 = (float*)(F.ws + WS_H);
    AttnSrc S; S.q1 = nullptr; S.k1 = nullptr; S.sq1 = 0; S.sk1 = 0; S.sq0 = NP; S.sk0 = NP; S.mask = nullptr;
    S.vt = (const bf16*)(F.ws + WS_CVT) + (size_t)(b * 4 + h) * 128 * SEQ;
    S.q0 = P + PC_CQ + 64 * (2 * h); S.k0 = P + PC_CK + 64 * (2 * h);
    const int li = F.lane & 15, g = F.lane >> 4;
    attn_unit<64, 0, false, ATT_RG>(F, S, qb * 128 * ATT_RG, o2);
#pragma unroll
    for (int r = 0; r < ATT_RG; ++r) { const int tok = b * SEQ + qb * 128 * ATT_RG + 16 * ATT_RG * F.wave + 16 * r + li;
#pragma unroll
        for (int et = 0; et < 8; ++et) *(f32x4*)(O1 + ((size_t)tok * 4 + h) * 128 + 16 * et + 4 * g) = o2[r][et]; }
    S.q0 = P + PC_CQ + 64 * (2 * h + 1); S.k0 = P + PC_CK + 64 * (2 * h + 1);
    attn_unit<64, 0, false, ATT_RG>(F, S, qb * 128 * ATT_RG, o2);
#pragma unroll
    for (int r = 0; r < ATT_RG; ++r) {
        const int tok = b * SEQ + qb * 128 * ATT_RG + 16 * ATT_RG * F.wave + 16 * r + li;
        float ss = 0.f; f32x4 o1[1][8];
#pragma unroll
        for (int et = 0; et < 8; ++et) o1[0][et] = *(const f32x4*)(O1 + ((size_t)tok * 4 + h) * 128 + 16 * et + 4 * g);
#pragma unroll
        for (int et = 0; et < 8; ++et) { o1[0][et] = o1[0][et] - o2[r][et] * lam_full; ss += (o1[0][et].x * o1[0][et].x + o1[0][et].y * o1[0][et].y) + (o1[0][et].z * o1[0][et].z + o1[0][et].w * o1[0][et].w); }
        ss = sum_x16_x32(ss);
        const float rs = (1.0f - lam_init) / sqrtf(ss * (1.f / 128.f) + RMS_EPS);
#pragma unroll
        for (int et = 0; et < 8; ++et) { const int e = 16 * et + 4 * g; const f32x4 gv = *(const f32x4*)(sg + e); const f32x4 y = o1[0][et] * gv * rs;
            u32x2 ow; ow.x = pk2(y.x, y.y); ow.y = pk2(y.z, y.w); *(u32x2*)(HEADS + (size_t)tok * DM + 1024 + 128 * h + e) = ow; }
    }
}

__device__ __forceinline__ unsigned ord_f32(float x) { unsigned u = __builtin_bit_cast(unsigned, x); if (u == 0x80000000u) u = 0u; return (u & 0x80000000u) ? ~u : (u | 0x80000000u); }
__device__ __forceinline__ void cnt_ge(int& c, unsigned v, unsigned cand) {
    asm volatile("v_cmp_ge_u32_e32 vcc, %1, %2\n\tv_addc_co_u32_e32 %0, vcc, 0, %0, vcc" : "+v"(c) : "v"(v), "v"(cand) : "vcc"); }
__device__ __forceinline__ void cnt_tie(int& c, unsigned v, unsigned T, int key, int mid, int big) {
    int t;
    asm volatile("v_cmp_eq_u32_e32 vcc, %2, %3\n\tv_cndmask_b32_e32 %1, %6, %4, vcc\n\tv_cmp_le_i32_e32 vcc, %1, %5\n\tv_addc_co_u32_e32 %0, vcc, 0, %0, vcc"
                 : "+v"(c), "=&v"(t) : "v"(v), "v"(T), "v"(key), "v"(mid), "v"(big) : "vcc"); }
__device__ __forceinline__ void sel_bit(unsigned& nib, unsigned v, unsigned T, int key, int X, int big, int zero) {
    int t;
    asm volatile("v_cmp_eq_u32_e32 vcc, %2, %3\n\tv_cndmask_b32_e32 %1, %6, %4, vcc\n\tv_cmp_gt_u32_e32 vcc, %2, %3\n\tv_cndmask_b32_e32 %1, %1, %7, vcc\n\tv_cmp_le_i32_e32 vcc, %1, %5\n\tv_addc_co_u32_e32 %0, vcc, %0, %0, vcc"
                 : "+v"(nib), "=&v"(t) : "v"(v), "v"(T), "v"(key), "v"(X), "v"(big), "v"(zero) : "vcc"); }
__device__ __forceinline__ void cnt_ge_s(int& c, unsigned v, unsigned cand) {
    unsigned long long m; int t;
    asm volatile("v_cmp_ge_u32_e64 %1, %3, %4\n\ts_bcnt1_i32_b64 %2, %1\n\ts_add_i32 %0, %0, %2" : "+s"(c), "=&s"(m), "=&s"(t) : "v"(v), "s"(cand) : "scc"); }
__device__ __forceinline__ void cnt_tie_s(int& c, unsigned v, unsigned T, int key, int mid) {
    unsigned long long m, n; int t;
    asm volatile("v_cmp_eq_u32_e64 %1, %4, %5\n\tv_cmp_le_i32_e64 %2, %6, %7\n\ts_and_b64 %1, %1, %2\n\ts_bcnt1_i32_b64 %3, %1\n\ts_add_i32 %0, %0, %3"
                 : "+s"(c), "=&s"(m), "=&s"(n), "=&s"(t) : "v"(v), "s"(T), "v"(key), "s"(mid) : "scc"); }
__device__ __forceinline__ void cnt_le_sv(int& c, unsigned cand, unsigned v) {
    asm volatile("v_cmp_le_u32_e32 vcc, %1, %2\n\tv_addc_co_u32_e32 %0, vcc, 0, %0, vcc" : "+v"(c) : "s"(cand), "v"(v) : "vcc"); }
__device__ __forceinline__ int wave_sum_dpp(int v) {
    v += __builtin_amdgcn_update_dpp(0, v, 0x111, 0xf, 0xf, false);
    v += __builtin_amdgcn_update_dpp(0, v, 0x112, 0xf, 0xf, false);
    v += __builtin_amdgcn_update_dpp(0, v, 0x114, 0xf, 0xf, false);
    v += __builtin_amdgcn_update_dpp(0, v, 0x118, 0xf, 0xf, false);
    v += __builtin_amdgcn_update_dpp(0, v, 0x142, 0xa, 0xf, false);
    v += __builtin_amdgcn_update_dpp(0, v, 0x143, 0xc, 0xf, false);
    return __builtin_amdgcn_readlane(v, 63);
}
__device__ __forceinline__ void indexer_unit(Frame& F, int unit) {
    const int b = unit >> 7, qi = 127 - (unit & 127), q0 = qi * 16;
    const bf16* P = (const bf16*)(F.ws + WS_P) + (size_t)b * SEQ * NP; const float* IW = (const float*)(F.ws + WS_IW) + (size_t)b * SEQ * 8;
    unsigned* M32 = (unsigned*)(F.ws + WS_MASK) + (size_t)b * SEQ * 64;
    constexpr int VST = 2052;
    LAS unsigned* V = (LAS unsigned*)F.lds;
    const int w = F.wave, li = F.lane & 15, g = F.lane >> 4, q = q0 + li;
#pragma unroll 1
    for (int rep1 = 0; rep1 < 1 + REP2(12); ++rep1) {
        bf16x8 qf[8][2]; float iwv[8];
#pragma unroll
        for (int h = 0; h < 8; ++h) { iwv[h] = IW[(size_t)q * 8 + h];
#pragma unroll
            for (int ks = 0; ks < 2; ++ks) qf[h][ks] = *(const bf16x8*)(P + (size_t)q * NP + PC_AIQ + 64 * h + 32 * ks + 8 * g); }
        const int NT = qi + 1;
        bf16x8 a0n, a1n, a0m, a1m;
        const GAS bf16* kp = (const GAS bf16*)(P + (size_t)(16 * w + li) * NP + PC_AIK + 8 * g);
        int kidx = 16 * w + 4 * g;
        a0n = *(const GAS bf16x8*)kp; a1n = *(const GAS bf16x8*)(kp + 32);
        kp += (size_t)128 * NP; asm volatile("" : "+v"(kp));
        a0m = a0n; a1m = a1n;
        if (w + 8 < NT) { a0m = *(const GAS bf16x8*)kp; a1m = *(const GAS bf16x8*)(kp + 32); }
        LAS unsigned* vrow = V + li * VST;
#pragma unroll
        for (int ti = 0; ti < 16; ++ti) {
            const int t = w + 8 * ti;
            if (t < NT) {
                const bf16x8 a0 = a0n, a1 = a1n;
                a0n = a0m; a1n = a1m;
                kp += (size_t)128 * NP; asm volatile("" : "+v"(kp));
                if (ti + 2 < 16 && t + 16 < NT) { a0m = *(const GAS bf16x8*)kp; a1m = *(const GAS bf16x8*)(kp + 32); }
                asm volatile("" ::: "memory");
                f32x4 idx = {0.f, 0.f, 0.f, 0.f};
#pragma unroll
                for (int h = 0; h < 8; ++h) { f32x4 c = {0.f, 0.f, 0.f, 0.f}; c = __builtin_amdgcn_mfma_f32_16x16x32_bf16(a0, qf[h][0], c, 0, 0, 0); c = __builtin_amdgcn_mfma_f32_16x16x32_bf16(a1, qf[h][1], c, 0, 0, 0);
#pragma unroll
                    for (int r = 0; r < 4; ++r) idx[r] += fmaxf(c[r], 0.f) * iwv[h]; }
                u32x4 o;
#pragma unroll
                for (int r = 0; r < 4; ++r) o[r] = (kidx + r <= q) ? ord_f32(idx[r]) : 0u;
                const int G = 4 * t + g; *(LAS u32x4*)(vrow + 4 * (G ^ ((G >> 4) & 15))) = o;
                kidx += 128; asm volatile("" : "+v"(kidx));
                __builtin_amdgcn_sched_barrier(0);
            }
        }
    }
    __syncthreads();
    int big = 0x7fffffff, zero = 0; asm volatile("" : "+v"(big), "+v"(zero));
#pragma unroll 1
    for (int qq2 = 0; qq2 < 2 * (1 + REP2(13)); ++qq2) {
        const int qq = qq2 & 1;
        const int ql = 2 * w + qq, qg = q0 + ql; const int L = F.lane, kbase = 32 * L;
        unsigned val[32];
#pragma unroll
        for (int m8 = 0; m8 < 8; ++m8) { const int G = 8 * L + m8; const u32x4 x = *(const LAS u32x4*)(V + ql * VST + 4 * (G ^ ((G >> 4) & 15)));
#pragma unroll
            for (int c = 0; c < 4; ++c) val[4 * m8 + c] = (kbase + 4 * m8 + c <= qg) ? x[c] : 0u; }
        unsigned T = 0u; int cge = -1;
        for (int bit = 31; bit >= 0; --bit) { const unsigned cand = T | (1u << bit); int cl = 0;
#pragma unroll
            for (int m = 0; m < 32; ++m) cnt_le_sv(cl, cand, val[m]);
            const int c = wave_sum_dpp(cl);
            if (c >= 256) { T = cand; if (c == 256) { cge = 256; break; } } }
        int X = 4096;
        if (cge < 0 && T != 0u) {
            int c1 = 0, c2 = 0;
            { int cl = 0;
#pragma unroll
              for (int m = 0; m < 32; ++m) cnt_le_sv(cl, T, val[m]);
              c1 = wave_sum_dpp(cl); }
            if (T != 0xffffffffu) { int cl = 0;
#pragma unroll
                for (int m = 0; m < 32; ++m) cnt_le_sv(cl, T + 1u, val[m]);
                c2 = wave_sum_dpp(cl); }
            if (c1 > 256) {
                const int want = 256 - c2; int lo = 0, hi = 2047;
                for (int it = 0; it < 11; ++it) { const int mid = (lo + hi) >> 1; int c = 0;
#pragma unroll
                    for (int m = 0; m < 32; ++m) cnt_tie_s(c, val[m], T, kbase + m, mid);
                    if (c >= want) hi = mid; else lo = mid + 1; }
                X = hi;
            }
        }
        unsigned word = 0u; const unsigned T1 = T > 1u ? T : 1u;
#pragma unroll
        for (int m = 31; m >= 0; --m) sel_bit(word, val[m], T1, kbase + m, X, big, zero);
        M32[(size_t)qg * 64 + L] = word;
    }
    __syncthreads();
}

__device__ __forceinline__ void dsa_attn_unit(Frame& F, int unit) {
    const int b = unit >> 6, h = (unit >> 4) & 3, qb = 15 - (unit & 15);
    const bf16* P = (const bf16*)(F.ws + WS_P) + (size_t)b * SEQ * NP; bf16* HEADS = (bf16*)(F.ws + WS_HEADS);
    AttnSrc S; S.q0 = P + PC_AQN + 128 * h; S.q1 = P + PC_AQR + 64 * h; S.sq0 = NP; S.sq1 = NP;
    S.k0 = (const bf16*)(F.ws + WS_KN) + (size_t)b * SEQ * 512 + 128 * h; S.sk0 = 512; S.k1 = P + PC_AKR; S.sk1 = NP;
    S.vt = (const bf16*)(F.ws + WS_VAT) + (size_t)(b * 4 + h) * 128 * SEQ; S.mask = (const unsigned long long*)(F.ws + WS_MASK) + (size_t)b * SEQ * 32;
    f32x4 o[1][8];
    attn_unit<128, 64, true, 1>(F, S, qb * 128, o);
    const int li = F.lane & 15, g = F.lane >> 4;
#pragma unroll
    for (int r = 0; r < 1; ++r) { const int tok = b * SEQ + qb * 128 + 16 * F.wave + li;
#pragma unroll
        for (int et = 0; et < 8; ++et) { u32x2 ow; ow.x = pk2(o[r][et].x, o[r][et].y); ow.y = pk2(o[r][et].z, o[r][et].w); *(u32x2*)(HEADS + (size_t)tok * DM + 128 * h + 16 * et + 4 * g) = ow; } }
}

__device__ __forceinline__ void gdn_prep_unit(Frame& F, const CAS Args& a, int l, int unit) {
    const int b = unit >> 7, h = (unit >> 5) & 3, n = unit & 31; const int tok0 = b * SEQ + n * 64;
    const bf16* P = (const bf16*)(F.ws + WS_P); const float* GB = (const float*)(F.ws + WS_GB);
    const float* cw = a.in[I_DCONV] + (size_t)l * 4 * 1536;
    bf16* DW = (bf16*)(F.ws + WS_DW) + (size_t)unit * 8192; bf16* DQG = (bf16*)(F.ws + WS_DQG) + (size_t)unit * 8192; bf16* DKDT = (bf16*)(F.ws + WS_DKDT) + (size_t)unit * 8192;
    bf16* DATT = (bf16*)(F.ws + WS_DATT) + (size_t)unit * 4096; float* DUT = (float*)(F.ws + WS_DUT) + (size_t)unit * 8192; float* DDL = (float*)(F.ws + WS_DDL);
    LAS bf16* Xq = (LAS bf16*)F.lds;
    LAS bf16* Xk = Xq + 64 * 136;
    LAS bf16* KT = Xk + 64 * 136;
    LAS bf16* VT = KT + 128 * 72;
    LAS bf16* T1 = VT + 128 * 72;
    LAS bf16* T2 = T1 + 64 * 72;
    LAS float* Lm = (LAS float*)(T2 + 64 * 72);
    LAS float* part = Lm + 64 * 68;
    LAS float* vG = part + 64 * 32;
    LAS float* vB = vG + 64;
    LAS float* vRq = vB + 64;
    LAS float* vRk = vRq + 64;
    const int w = F.wave, li = F.lane & 15, g = F.lane >> 4;
#pragma unroll 1
    for (int it = F.tid; it < 768; it += NTHR) {
        const int rb = it & 15, cg = it >> 4, sect = cg >> 4, c8 = 8 * (cg & 15); const int ch = sect * 512 + 128 * h + c8;
        f32x4 wt[4][2];
#pragma unroll
        for (int tap = 0; tap < 4; ++tap) { wt[tap][0] = *(const f32x4*)(cw + tap * 1536 + ch); wt[tap][1] = *(const f32x4*)(cw + tap * 1536 + ch + 4); }
        u32x4 xr[7];
#pragma unroll
        for (int i = 0; i < 7; ++i) { const int pos = n * 64 + 4 * rb - 3 + i; xr[i] = (u32x4){0u, 0u, 0u, 0u}; if (pos >= 0) xr[i] = *(const u32x4*)(P + (size_t)(tok0 + 4 * rb - 3 + i) * NP + PC_DQKV + ch); }
#pragma unroll
        for (int rr = 0; rr < 4; ++rr) {
            const int r = 4 * rb + rr; float acc[8];
#pragma unroll
            for (int j = 0; j < 8; ++j) acc[j] = 0.f;
#pragma unroll
            for (int tap = 0; tap < 4; ++tap) { const u32x4 xw = xr[rr + tap]; const f32x4 w0 = wt[tap][0], w1 = wt[tap][1];
                acc[0] += bflo(xw.x) * w0.x; acc[1] += bfhi(xw.x) * w0.y; acc[2] += bflo(xw.y) * w0.z; acc[3] += bfhi(xw.y) * w0.w;
                acc[4] += bflo(xw.z) * w1.x; acc[5] += bfhi(xw.z) * w1.y; acc[6] += bflo(xw.w) * w1.z; acc[7] += bfhi(xw.w) * w1.w; }
            float ss = 0.f;
#pragma unroll
            for (int j = 0; j < 8; ++j) { acc[j] = acc[j] * sigmoidf_(acc[j]); ss += acc[j] * acc[j]; }
            if (sect < 2) { part[r * 32 + cg] = ss; u32x4 o; o.x = pk2(acc[0], acc[1]); o.y = pk2(acc[2], acc[3]); o.z = pk2(acc[4], acc[5]); o.w = pk2(acc[6], acc[7]);
                *(LAS u32x4*)((sect == 0 ? Xq : Xk) + r * 136 + c8) = o; }
            else {
#pragma unroll
                for (int j = 0; j < 8; ++j) VT[(c8 + j) * 72 + r] = (bf16)f2bf(acc[j]); }
        }
    }
    __syncthreads();
    if (w == 0) {
        const int r = F.lane; float sq = 0.f, sk = 0.f;
#pragma unroll
        for (int c = 0; c < 16; ++c) { sq += part[r * 32 + c]; sk += part[r * 32 + 16 + c]; }
        vRq[r] = 0.08838834764831845f / sqrtf(sq + RMS_EPS); vRk[r] = 1.0f / sqrtf(sk + RMS_EPS);
        float gc = GB[(size_t)(tok0 + r) * 8 + 4 + h];
#pragma unroll
        for (int o = 1; o < 64; o <<= 1) { const float t = __builtin_bit_cast(float, __builtin_amdgcn_ds_bpermute((r - o) << 2, __builtin_bit_cast(int, gc))); if (r >= o) gc += t; }
        vG[r] = gc; vB[r] = GB[(size_t)(tok0 + r) * 8 + h];
        if (r == 63) DDL[unit] = __expf(gc);
    }
    __syncthreads();
#pragma unroll
    for (int i = 0; i < 4; ++i) {
        const int it = F.tid + 512 * i, isk = it >> 10, r = it & 63, c8 = 8 * ((it >> 6) & 15);
        LAS bf16* X = isk ? Xk : Xq; const float sc = isk ? vRk[r] : vRq[r];
        const u32x4 xw = *(const LAS u32x4*)(X + r * 136 + c8); const unsigned ww[4] = {xw.x, xw.y, xw.z, xw.w}; float v[8];
#pragma unroll
        for (int j = 0; j < 4; ++j) { v[2 * j] = bflo(ww[j]) * sc; v[2 * j + 1] = bfhi(ww[j]) * sc; }
        u32x4 o; o.x = pk2(v[0], v[1]); o.y = pk2(v[2], v[3]); o.z = pk2(v[4], v[5]); o.w = pk2(v[6], v[7]);
        *(LAS u32x4*)(X + r * 136 + c8) = o;
        if (isk) {
#pragma unroll
            for (int j = 0; j < 8; ++j) KT[(c8 + j) * 72 + r] = (bf16)f2bf(v[j]); }
        else { const float eg = __expf(vG[r]); u32x4 q; q.x = pk2(v[0] * eg, v[1] * eg); q.y = pk2(v[2] * eg, v[3] * eg); q.z = pk2(v[4] * eg, v[5] * eg); q.w = pk2(v[6] * eg, v[7] * eg);
            *(u32x4*)(DQG + r * 128 + c8) = q; }
    }
    __syncthreads();
#pragma unroll
    for (int tq = 0; tq < 4; ++tq) {
        const int tt = w * 4 + tq, isq = tt >> 4, it_ = (tt >> 2) & 3, jt = tt & 3;
        f32x4 acc = {0.f, 0.f, 0.f, 0.f};
        if (jt <= it_) acc = mma16(acc, Xk + jt * 16 * 136, 136, (isq ? Xq : Xk) + it_ * 16 * 136, 136, 128, F.lane);
        const int i = 16 * it_ + li; const float Gi = vG[i], bi = vB[i]; float v[4];
#pragma unroll
        for (int r = 0; r < 4; ++r) { const int j = 16 * jt + 4 * g + r; const float dec = __expf(Gi - vG[j]);
            v[r] = isq ? ((j <= i) ? acc[r] * dec : 0.f) : ((j < i) ? acc[r] * dec * bi : 0.f); }
        if (isq) { u32x2 o; o.x = pk2(v[0], v[1]); o.y = pk2(v[2], v[3]); *(u32x2*)(DATT + i * 64 + 16 * jt + 4 * g) = o; }
        else *(LAS f32x4*)(Lm + i * 68 + 16 * jt + 4 * g) = (f32x4){v[0], v[1], v[2], v[3]};
    }
    __syncthreads();
    LAS float* Tm = (LAS float*)Xq;
    LAS float* PS = (LAS float*)Xk + w * 272;
    auto blk_mma = [&](f32x4 acc, const LAS float* Ab, int lda, const LAS float* Bb, int ldb) -> f32x4 {
#pragma unroll
        for (int ks = 0; ks < 4; ++ks) acc = __builtin_amdgcn_mfma_f32_16x16x4f32(Ab[(F.lane & 15) * lda + 4 * ks + (F.lane >> 4)], Bb[(4 * ks + (F.lane >> 4)) * ldb + (F.lane & 15)], acc, 0, 0, 0);
        return acc; };
    auto blk_finish = [&](f32x4 p, int bi, int bj) {
#pragma unroll
        for (int r = 0; r < 4; ++r) PS[(4 * (F.lane >> 4) + r) * 17 + (F.lane & 15)] = p[r];
        asm volatile("s_waitcnt lgkmcnt(0)" ::: "memory");
        f32x4 t = {0.f, 0.f, 0.f, 0.f}; t = blk_mma(t, Tm + (16 * bi) * 68 + 16 * bi, 68, PS, 17);
#pragma unroll
        for (int r = 0; r < 4; ++r) Tm[(16 * bi + 4 * (F.lane >> 4) + r) * 68 + 16 * bj + (F.lane & 15)] = -t[r]; };
    if (w < 4) {
        if (F.lane < 16) {
            const LAS float* Lb = Lm + (16 * w) * 68 + 16 * w; float tcb[16];
#pragma unroll
            for (int k = 0; k < 16; ++k) tcb[k] = 0.f;
#pragma unroll
            for (int i = 0; i < 16; ++i) { float sacc_ = Lb[i * 68 + F.lane];
#pragma unroll
                for (int k = 0; k < i; ++k) sacc_ += Lb[i * 68 + k] * tcb[k];
                tcb[i] = -sacc_; }
            LAS float* Tb = Tm + (16 * w) * 68 + 16 * w + F.lane;
#pragma unroll
            for (int i = 0; i < 16; ++i) Tb[i * 68] = tcb[i] + (i == F.lane ? 1.0f : 0.0f);
        }
    } else {
        const float Gl = vG[63];
        for (int it = F.tid - 256; it < 1024; it += 256) { const int d = it >> 3, j8 = 8 * (it & 7);
            const u32x4 kw = *(const LAS u32x4*)(KT + d * 72 + j8); const unsigned ww[4] = {kw.x, kw.y, kw.z, kw.w}; unsigned o[4];
#pragma unroll
            for (int j = 0; j < 4; ++j) o[j] = pk2(bflo(ww[j]) * __expf(Gl - vG[j8 + 2 * j]), bfhi(ww[j]) * __expf(Gl - vG[j8 + 2 * j + 1]));
            *(u32x4*)(DKDT + d * 64 + j8) = (u32x4){o[0], o[1], o[2], o[3]}; }
    }
    __syncthreads();
    if (w < 3) { f32x4 p = {0.f, 0.f, 0.f, 0.f}; p = blk_mma(p, Lm + (16 * (w + 1)) * 68 + 16 * w, 68, Tm + (16 * w) * 68 + 16 * w, 68); blk_finish(p, w + 1, w); }
    __syncthreads();
    if (w < 2) { f32x4 p = {0.f, 0.f, 0.f, 0.f}; p = blk_mma(p, Lm + (16 * (w + 2)) * 68 + 16 * w, 68, Tm + (16 * w) * 68 + 16 * w, 68);
                 p = blk_mma(p, Lm + (16 * (w + 2)) * 68 + 16 * (w + 1), 68, Tm + (16 * (w + 1)) * 68 + 16 * w, 68); blk_finish(p, w + 2, w); }
    __syncthreads();
    if (w == 0) { f32x4 p = {0.f, 0.f, 0.f, 0.f}; p = blk_mma(p, Lm + 48 * 68, 68, Tm, 68); p = blk_mma(p, Lm + 48 * 68 + 16, 68, Tm + 16 * 68, 68); p = blk_mma(p, Lm + 48 * 68 + 32, 68, Tm + 32 * 68, 68); blk_finish(p, 3, 0); }
    __syncthreads();
    {
        const int i = F.tid >> 3, j8 = 8 * (F.tid & 7); float t1[8], t2[8];
#pragma unroll
        for (int c = 0; c < 8; ++c) { const int j = j8 + c; const float t = ((i >> 4) >= (j >> 4)) ? Tm[i * 68 + j] : 0.f; const float bj = vB[j]; t1[c] = t * bj; t2[c] = t * bj * __expf(vG[j]); }
        u32x4 a1, a2; a1.x = pk2(t1[0], t1[1]); a1.y = pk2(t1[2], t1[3]); a1.z = pk2(t1[4], t1[5]); a1.w = pk2(t1[6], t1[7]);
        a2.x = pk2(t2[0], t2[1]); a2.y = pk2(t2[2], t2[3]); a2.z = pk2(t2[4], t2[5]); a2.w = pk2(t2[6], t2[7]);
        *(LAS u32x4*)(T1 + i * 72 + j8) = a1; *(LAS u32x4*)(T2 + i * 72 + j8) = a2;
    }
    __syncthreads();
#pragma unroll
    for (int tq = 0; tq < 4; ++tq) { const int tt = w * 4 + tq, dt = tt >> 2, it_ = tt & 3;
        f32x4 acc = {0.f, 0.f, 0.f, 0.f}; acc = mma16(acc, KT + dt * 16 * 72, 72, T2 + it_ * 16 * 72, 72, 64, F.lane);
        u32x2 o; o.x = pk2(acc.x, acc.y); o.y = pk2(acc.z, acc.w); *(u32x2*)(DW + (16 * it_ + li) * 128 + 16 * dt + 4 * g) = o; }
#pragma unroll
    for (int tq = 0; tq < 4; ++tq) { const int tt = w * 4 + tq, it_ = tt >> 3, et = tt & 7;
        f32x4 acc = {0.f, 0.f, 0.f, 0.f}; acc = mma16(acc, T1 + it_ * 16 * 72, 72, VT + et * 16 * 72, 72, 64, F.lane);
        *(f32x4*)(DUT + (16 * et + li) * 64 + 16 * it_ + 4 * g) = acc; }
    __syncthreads();
}

struct GdnRegsA { bf16x8 wf[4]; f32x4 u[4]; };
struct GdnRegsB { bf16x8 qf[4], af[2], kf[2]; float dl; };
__device__ __forceinline__ void gdn_load_a(GdnRegsA& R, const unsigned char* ws, int unit, int w, int li, int g) {
    const int jb = w & 3, eh = w >> 2;
    const bf16* DW = (const bf16*)(ws + WS_DW) + (size_t)unit * 8192 + (16 * jb + li) * 128 + 8 * g; const float* DUT = (const float*)(ws + WS_DUT) + (size_t)unit * 8192;
#pragma unroll
    for (int ks = 0; ks < 4; ++ks) R.wf[ks] = *(const bf16x8*)(DW + 32 * ks);
#pragma unroll
    for (int t = 0; t < 4; ++t) R.u[t] = *(const f32x4*)(DUT + (16 * (4 * eh + t) + li) * 64 + 16 * jb + 4 * g);
}
__device__ __forceinline__ void gdn_load_b(GdnRegsB& R, const unsigned char* ws, int unit, int w, int li, int g) {
    const int jb = w & 3;
    const bf16* DQG = (const bf16*)(ws + WS_DQG) + (size_t)unit * 8192 + (16 * jb + li) * 128 + 8 * g;
    const bf16* DATT = (const bf16*)(ws + WS_DATT) + (size_t)unit * 4096 + (16 * jb + li) * 64 + 8 * g; const bf16* DKDT = (const bf16*)(ws + WS_DKDT) + (size_t)unit * 8192 + (16 * w + li) * 64 + 8 * g;
#pragma unroll
    for (int ks = 0; ks < 4; ++ks) R.qf[ks] = *(const bf16x8*)(DQG + 32 * ks);
#pragma unroll
    for (int ks = 0; ks < 2; ++ks) { R.af[ks] = *(const bf16x8*)(DATT + 32 * ks); R.kf[ks] = *(const bf16x8*)(DKDT + 32 * ks); }
    R.dl = ((const float*)(ws + WS_DDL))[unit];
}
__device__ __forceinline__ void gdn_scan_unit(Frame& F, const CAS Args& a, int l, int bh) {
    const int b = bh >> 2, h = bh & 3;
    const bf16* P = (const bf16*)(F.ws + WS_P); bf16* HEADS = (bf16*)(F.ws + WS_HEADS); const float* ng = a.in[I_DNORM] + l * 128;
    LAS bf16* ST = (LAS bf16*)F.lds;
    LAS bf16* VN = ST + 128 * 136;
    LAS float* red = (LAS float*)(VN + 128 * 72);
    const int w = F.wave, li = F.lane & 15, g = F.lane >> 4, jb = w & 3, eh = w >> 2;
    for (int i = F.tid; i < 128 * 136 / 2; i += NTHR) ((LAS unsigned*)ST)[i] = 0u;
    f32x4 sacc[8];
#pragma unroll
    for (int et = 0; et < 8; ++et) sacc[et] = (f32x4){0.f, 0.f, 0.f, 0.f};
    GdnRegsA cur, nxt; GdnRegsB cb;
    gdn_load_a(cur, F.ws, bh * 32, w, li, g);
    __syncthreads();
    for (int n = 0; n < 32; ++n) {
        gdn_load_b(cb, F.ws, bh * 32 + n, w, li, g);
        gdn_load_a(nxt, F.ws, bh * 32 + (n < 31 ? n + 1 : n), w, li, g);
        const int tok = b * SEQ + n * 64 + 16 * jb + li;
        u32x2 zw[4];
#pragma unroll
        for (int t = 0; t < 4; ++t) zw[t] = *(const u32x2*)(P + (size_t)tok * NP + PC_DZ + 128 * h + 16 * (4 * eh + t) + 4 * g);
#pragma unroll
        for (int t = 0; t < 4; ++t) { f32x4 acc = {0.f, 0.f, 0.f, 0.f}; const LAS bf16* sp = ST + (16 * (4 * eh + t) + li) * 136 + 8 * g;
#pragma unroll
            for (int ks = 0; ks < 4; ++ks) acc = __builtin_amdgcn_mfma_f32_16x16x32_bf16(cur.wf[ks], *(const LAS bf16x8*)(sp + 32 * ks), acc, 0, 0, 0);
            const f32x4 vn = cur.u[t] - acc; u32x2 o; o.x = pk2(vn.x, vn.y); o.y = pk2(vn.z, vn.w);
            *(LAS u32x2*)(VN + (16 * (4 * eh + t) + li) * 72 + 16 * jb + 4 * g) = o; }
        __syncthreads();
        f32x4 oacc[4]; float ss = 0.f;
#pragma unroll
        for (int t = 0; t < 4; ++t) { f32x4 acc = {0.f, 0.f, 0.f, 0.f}; const LAS bf16* sp = ST + (16 * (4 * eh + t) + li) * 136 + 8 * g; const LAS bf16* vp = VN + (16 * (4 * eh + t) + li) * 72 + 8 * g;
#pragma unroll
            for (int ks = 0; ks < 4; ++ks) acc = __builtin_amdgcn_mfma_f32_16x16x32_bf16(*(const LAS bf16x8*)(sp + 32 * ks), cb.qf[ks], acc, 0, 0, 0);
#pragma unroll
            for (int ks = 0; ks < 2; ++ks) acc = __builtin_amdgcn_mfma_f32_16x16x32_bf16(*(const LAS bf16x8*)(vp + 32 * ks), cb.af[ks], acc, 0, 0, 0);
            oacc[t] = acc; ss += (acc.x * acc.x + acc.y * acc.y) + (acc.z * acc.z + acc.w * acc.w); }
        ss = sum_x16_x32(ss);
        if (g == 0) red[eh * 64 + 16 * jb + li] = ss;
        __syncthreads();
#pragma unroll
        for (int et = 0; et < 8; ++et) { f32x4 acc = sacc[et] * cb.dl; const LAS bf16* vp = VN + (16 * et + li) * 72 + 8 * g;
#pragma unroll
            for (int ks = 0; ks < 2; ++ks) acc = __builtin_amdgcn_mfma_f32_16x16x32_bf16(cb.kf[ks], *(const LAS bf16x8*)(vp + 32 * ks), acc, 0, 0, 0);
            sacc[et] = acc; u32x2 o; o.x = pk2(acc.x, acc.y); o.y = pk2(acc.z, acc.w); *(LAS u32x2*)(ST + (16 * et + li) * 136 + 16 * w + 4 * g) = o; }
        { const float tot = red[16 * jb + li] + red[64 + 16 * jb + li]; const float rstd = 1.0f / sqrtf(tot * (1.f / 128.f) + RMS_EPS);
#pragma unroll
          for (int t = 0; t < 4; ++t) { const int e = 16 * (4 * eh + t) + 4 * g; const f32x4 gv = *(const f32x4*)(ng + e);
              const float z0 = bflo(zw[t].x), z1 = bfhi(zw[t].x), z2 = bflo(zw[t].y), z3 = bfhi(zw[t].y);
              u32x2 o; o.x = pk2(oacc[t].x * rstd * gv.x * z0 * sigmoidf_(z0), oacc[t].y * rstd * gv.y * z1 * sigmoidf_(z1)); o.y = pk2(oacc[t].z * rstd * gv.z * z2 * sigmoidf_(z2), oacc[t].w * rstd * gv.w * z3 * sigmoidf_(z3));
              *(u32x2*)(HEADS + (size_t)tok * DM + 1536 + 128 * h + e) = o; } }
        cur = nxt;
        __syncthreads();
    }
}

__device__ __forceinline__ int queue_next(Frame& F, int* head, int base = 0);
struct QGroup { int x, nb, cpg, j; };
__device__ __forceinline__ QGroup qgroup(const Frame& F) { QGroup q; if (F.G % 8 == 0) { q.cpg = F.G / 8; q.x = F.vcu / q.cpg; q.j = F.vcu % q.cpg; q.nb = 1; } else { q.cpg = F.G; q.x = 0; q.j = F.vcu; q.nb = 8; } return q; }
constexpr int CW_XQ = 32768;
__device__ __forceinline__ int* xq_head(const Frame& F, int l, int q, int x) { return (int*)(F.ctl + CW_XQ + ((l * 8 + q) * 8 + x) * 64); }
#define XQ_B(g, i) ((g).nb * (g).x + (i) % (g).nb)
#define XQ_R(g, i) ((i) / (g).nb)
__device__ __forceinline__ void phase_prep_mixers(Frame& F, const CAS Args& a, int l, int qoff) {
    (void)qoff;
    frame_refresh(F);
    const QGroup g = qgroup(F);
    for (int i = g.j; i < (g.nb << 6); i += g.cpg) ret_stage1(F, (XQ_B(g, i) << 6) | XQ_R(g, i));
    for (int i = g.j; i < (g.nb << 6); i += g.cpg) cvt_transpose_unit(F, (XQ_B(g, i) << 6) | XQ_R(g, i));
    frame_refresh(F);
    { const int n = g.nb << 7, base = g.cpg < n ? g.cpg : n; int* qh = xq_head(F, l, 0, g.x);
      for (int i = g.j < n ? g.j : n; i < n; i = queue_next(F, qh, base)) indexer_unit(F, (XQ_B(g, i) << 7) | XQ_R(g, i)); }
    frame_refresh(F);
    { const int n = g.nb << 7; int* qh = xq_head(F, l, 1, g.x);
      for (int i = queue_next(F, qh); i < n; i = queue_next(F, qh)) gdn_prep_unit(F, a, l, (XQ_B(g, i) << 7) | XQ_R(g, i)); }
}

__device__ __forceinline__ int queue_next(Frame& F, int* head, int base) {
    LAS int* qslot = (LAS int*)(F.lds + MISC_OFF + 64);
    if (F.tid == 0) *qslot = __hip_atomic_fetch_add(head, 1, RLX_AGENT) + base;
    __syncthreads();
    const int item = *qslot;
    __syncthreads();
    return item;
}
__device__ __forceinline__ void phase_mix(Frame& F, const CAS Args& a, int l, int qoff) {
    (void)qoff;
    frame_refresh(F);
    const QGroup g = qgroup(F);
    { const int n = g.nb << 2, base = g.cpg < n ? g.cpg : n; int* qh = xq_head(F, l, 2, g.x);
      for (int i = g.j < n ? g.j : n; i < n; i = queue_next(F, qh, base)) gdn_scan_unit(F, a, l, (XQ_B(g, i) << 2) | XQ_R(g, i)); }
    frame_refresh(F);
    { const int n = g.nb << 5; int* qh = xq_head(F, l, 3, g.x);
      for (int i = queue_next(F, qh); i < n; i = queue_next(F, qh)) { const int r = XQ_R(g, i); diffattn_unit(F, a, l, (XQ_B(g, i) << 5) | ((r & 3) << 3) | (r >> 2)); } }
    frame_refresh(F);
    { const int n = g.nb << 6; int* qh = xq_head(F, l, 4, g.x);
      for (int i = queue_next(F, qh); i < n; i = queue_next(F, qh)) { const int r = XQ_R(g, i); dsa_attn_unit(F, (XQ_B(g, i) << 6) | ((r & 3) << 4) | (r >> 2)); } }
    frame_refresh(F);
    { const int n = g.nb << 6; int* qh = xq_head(F, l, 5, g.x);
      for (int i = queue_next(F, qh); i < n; i = queue_next(F, qh)) ret_stage2(F, (XQ_B(g, i) << 6) | XQ_R(g, i)); }
}

__device__ __forceinline__ void phase_zero_heads(Frame& F) {
    frame_refresh(F);
    u32x4* hp = (u32x4*)(F.ws + WS_HEADS); const size_t n = (size_t)NTOK * DM * 2 / 16;
    unsigned z = 0u; asm volatile("" : "+v"(z));
    for (size_t i = (size_t)(F.vcu * NTHR + F.tid); i < n; i += (size_t)F.G * NTHR) hp[i] = (u32x4){z, z, z, z};
}

constexpr int PH_PER_LAYER = 8;
constexpr int N_PHASES = 1 + DEPTH * PH_PER_LAYER;

__global__ void __launch_bounds__(NTHR, 2) mega_fwd(Args args) {
    extern __shared__ __attribute__((aligned(16))) unsigned char lds_raw[];
    Frame F;
    F.lds = (LAS unsigned char*)lds_raw; F.tid = threadIdx.x; F.lane = F.tid & 63; F.wave = __builtin_amdgcn_readfirstlane(F.tid >> 6); F.wv = F.wave;
    F.G = gridDim.x; { const int bx = blockIdx.x; F.vcu = (F.G % 8 == 0) ? (bx % 8) * (F.G / 8) + bx / 8 : bx; }
    F.ws = args.ws; F.ctl = (unsigned*)(args.ws + WS_CTL);
    volatile LAS unsigned* MISC = (volatile LAS unsigned*)(F.lds + MISC_OFF);
    if (F.tid < 64) MISC[F.tid] = 0u;
    __syncthreads();
#if ONE_LAUNCH
    XcdBarrier bar = xcd_barrier_post(F.ctl + CW_BAR, MISC + 8);
#define GRID_BAR() xcd_barrier(bar)
#define LOCAL_BAR() xcd_local_barrier(bar)
#else
#define GRID_BAR() do {} while (0)
#define LOCAL_BAR() do {} while (0)
#endif
    const int lo = args.ph_lo, hi = args.ph_hi;
#define IN(k) (lo <= (k) && (k) < hi)
#define SEAM(k) do { if (IN(k) && IN((k) + 1)) GRID_BAR(); } while (0)
#define LSEAM(k) do { if (IN(k) && IN((k) + 1)) { if (use_local) LOCAL_BAR(); else GRID_BAR(); } } while (0)
    int use_local = 0;

    if (PHON(0) && IN(0)) { phase_prologue(F, kargs()); __syncthreads(); if (REP2(0)) { phase_prologue(F, kargs()); __syncthreads(); } }
    if (threadIdx.x == 0 && !((F.G % 8 == 0) && xb_xcc_id() == (blockIdx.x & 7u))) (void)xb_add(F.ctl + 2048, 1u);
    SEAM(0);
    if (IN(0) && IN(1)) use_local = __builtin_amdgcn_readfirstlane((int)(xb_ld(F.ctl + 2048) == 0u));
    for (int l = 0; l < DEPTH; ++l) {
        const int p0 = 1 + l * PH_PER_LAYER;
        if (p0 + PH_PER_LAYER <= lo || p0 >= hi) continue;
        if (PHON(1) && IN(p0 + 0)) {
            pg8::Gemm g{(const bf16*)(F.ws + WS_XB), (const bf16*)(F.ws + WS_WIN) + (size_t)l * NP * DM, DM, DM, 0};
            pg8::DenseOrder S; S.init(NTOK, NP, F.G, (int)blockIdx.x);
            EpiInProj E{(bf16*)(F.ws + WS_P), (const f32x2*)(F.ws + WS_CS), (float*)(F.ws + WS_GB), (float*)(F.ws + WS_IW), (float*)(F.ws + WS_SSQ), kargs().in[I_DALOG] + l * 4, kargs().in[I_DDT] + l * 4};
            pg8::gemm_phase<false>(F.lds, g, S, E, F.wv);
            if (REP2(1)) pg8::gemm_phase<false>(F.lds, g, S, E, F.wv);
            if (PHON(2)) {
                unsigned long long own = 0ull; { pg8::Unit u; for (int i = 0; S.next(i, u); ++i) if (u.pn == PC_CKV / 256) own |= 1ull << u.pm; }
                pg8::Gemm gk{(const bf16*)(F.ws + WS_P) + PC_CKV, (const bf16*)(F.ws + WS_WKV) + (size_t)l * 1024 * 256, NP, 256, 0};
                pg8::OwnOrder S2{own, 4, 4 * (int)__builtin_popcountll(own)};
                EpiKvUp E2{(bf16*)(F.ws + WS_KN), (bf16*)(F.ws + WS_VAT), (const float*)(F.ws + WS_SSQ)};
                pg8::gemm_phase<false>(F.lds, gk, S2, E2, F.wv);
            }
        }
        LSEAM(p0 + 0);
        if (PHON(2) && IN(p0 + 1)) {
            phase_prep_mixers(F, kargs(), l, 0);
            if (REP2(2)) phase_prep_mixers(F, kargs(), l, 32);
        }
        LSEAM(p0 + 1);
        if (PHON(3) && IN(p0 + 2)) { phase_mix(F, kargs(), l, 0); if (REP2(3)) phase_mix(F, kargs(), l, 32); }
        LSEAM(p0 + 2);
        if (PHON(5) && IN(p0 + 3)) {
            pg8::Gemm g{(const bf16*)(F.ws + WS_HEADS), (const bf16*)(F.ws + WS_WOUT) + (size_t)l * DM * DM, DM, DM, 0};
            pg8::DenseOrder S; S.init(NTOK, DM, F.G, (int)blockIdx.x);
            EpiOutProj E{(const bf16*)(F.ws + WS_XB), (bf16*)(F.ws + WS_R)};
            pg8::gemm_phase<false>(F.lds, g, S, E, F.wv);
            if (REP2(5)) pg8::gemm_phase<false>(F.lds, g, S, E, F.wv);
        }
        LSEAM(p0 + 3);
        if (PHON(6) && IN(p0 + 4)) phase_ln1_router(F, kargs(), l);
        SEAM(p0 + 4);
        if (PHON(7) && IN(p0 + 5)) {
            LAS int* pstart = (LAS int*)(F.lds + RING_BYTES); LAS unsigned short* tord = (LAS unsigned short*)(F.lds + RING_BYTES + 512);
            const int* ecnt = (const int*)(F.ctl + CW_ECNT + l * 64);
            const int ntiles = __builtin_amdgcn_readfirstlane(moe_tables(F, ecnt, pstart, tord));
            pg8::Gemm g{(const bf16*)(F.ws + WS_HB), (const bf16*)(F.ws + WS_WGU) + (size_t)l * NE * 1024 * DM, DM, DM, (size_t)1024 * DM * 2};
            MoeOrder<true> S{4, ntiles * 4, F.G, F.vcu, tord, pstart, ecnt, (const int*)(F.ws + WS_LTOK), (F.G == 256 && ntiles < 288) ? 1 : 0};
            EpiGU E{(bf16*)(F.ws + WS_ACT), kargs().in[I_BGU] + (size_t)l * NE * 1024};
            pg8::gemm_phase<true>(F.lds, g, S, E, F.wv);
            if (REP2(7)) pg8::gemm_phase<true>(F.lds, g, S, E, F.wv);
        }
        if (IN(p0 + 5) && IN(p0 + 6)) { const int nt2 = __builtin_amdgcn_readfirstlane(((const LAS int*)(F.lds + RING_BYTES))[NE]) / 256;
            if (use_local && F.G == 256 && nt2 < 288) LOCAL_BAR(); else GRID_BAR(); }
        if (PHON(8) && IN(p0 + 6)) {
            LAS int* pstart = (LAS int*)(F.lds + RING_BYTES); LAS unsigned short* tord = (LAS unsigned short*)(F.lds + RING_BYTES + 512);
            const int* ecnt = (const int*)(F.ctl + CW_ECNT + l * 64);
            const int ntiles = __builtin_amdgcn_readfirstlane(moe_tables(F, ecnt, pstart, tord));
            pg8::Gemm g{(const bf16*)(F.ws + WS_ACT), (const bf16*)(F.ws + WS_WDN) + (size_t)l * NE * DM * DFF, DFF, DFF, (size_t)DM * DFF * 2};
            MoeOrder<false> S{8, ntiles * 8, F.G, F.vcu, tord, pstart, ecnt, nullptr, (F.G == 256 && ntiles < 288) ? 1 : 0};
            EpiDN E{(bf16*)(F.ws + WS_Y), kargs().in[I_BDN] + (size_t)l * NE * DM, (const float*)(F.ws + WS_LGATE), ecnt, pstart};
            pg8::gemm_phase<false>(F.lds, g, S, E, F.wv);
            if (REP2(8)) pg8::gemm_phase<false>(F.lds, g, S, E, F.wv);
        }
        SEAM(p0 + 6);
        if (PHON(9) && IN(p0 + 7)) { phase_ln2(F, kargs(), l); if (REP2(9)) phase_ln2(F, kargs(), l); }
        LSEAM(p0 + 7);
    }
#undef IN
#undef SEAM
}

extern "C" void kernel_launch(void* const* d_in, const int* in_sizes, int n_in, void* d_out, int out_size, void* d_ws, size_t ws_size, hipStream_t stream) {
    static int grid = 0;
    if (grid == 0) {
        if (n_in != 23 || out_size != NTOK * DM || ws_size < WS_END) { fprintf(stderr, "kernel_launch: unexpected shapes (n_in %d out %d ws %zu need %zu)\n", n_in, out_size, ws_size, (size_t)WS_END); grid = -1; return; }
        int dev = 0, cus = 0, per_cu = 0;
        if (hipGetDevice(&dev) != hipSuccess || hipDeviceGetAttribute(&cus, hipDeviceAttributeMultiprocessorCount, dev) != hipSuccess) { grid = -1; return; }
        if (hipFuncSetAttribute((const void*)mega_fwd, hipFuncAttributeMaxDynamicSharedMemorySize, LDS_BYTES) != hipSuccess) { fprintf(stderr, "kernel_launch: hipFuncSetAttribute failed\n"); grid = -1; return; }
        if (hipOccupancyMaxActiveBlocksPerMultiprocessor(&per_cu, (const void*)mega_fwd, NTHR, LDS_BYTES) != hipSuccess || per_cu < 1) fprintf(stderr, "kernel_launch: occupancy query says %d\n", per_cu);
        (void)hipGetLastError();
        grid = cus;
    }
    if (grid < 0) return;
    (void)hipMemsetAsync((char*)d_ws + WS_CTL, 0, CTL_ZERO_BYTES, stream);
    Args a{};
    for (int i = 0; i < 23; ++i) a.in[i] = (const float*)d_in[i];
    a.out = (float*)d_out; a.ws = (unsigned char*)d_ws;
#if ONE_LAUNCH
    a.ph_lo = 0; a.ph_hi = N_PHASES;
    hipLaunchKernelGGL(mega_fwd, dim3(grid), dim3(NTHR), LDS_BYTES, stream, a);
#else
    for (int p = 0; p < N_PHASES; ++p) { a.ph_lo = p; a.ph_hi = p + 1; hipLaunchKernelGGL(mega_fwd, dim3(grid), dim3(NTHR), LDS_BYTES, stream, a); }
#endif
}
```
